# Optimizing an MI355X kernel written in HIP

```python
import jax, jax.numpy as jnp
from jax import lax
import numpy as np

D_MODEL = 2048
BATCH = 1
SEQ = 8192
DEPTH = 1
DEC_BATCH = 32
DEC_SEQ = 8
PAST_LEN = 8192
PAGE_SIZE = 128

HEAD_DIM = 64
NSA_HEADS = 16
NSA_KV_HEADS = 4
NSA_GROUP = NSA_HEADS // NSA_KV_HEADS
NSA_WIDTH = NSA_HEADS * HEAD_DIM
NSA_BRANCHES = 3
CMP_LEN = 32
CMP_STRIDE = 16
CMP_HIDDEN = 2 * HEAD_DIM
SEL_BLOCK = 64
N_SELECT = 16
N_LOCAL = 2
WINDOW = 512
Q_BLOCK = 128
GLA_HEADS = 4
GLA_DK = 128
GLA_DV = 256
GLA_KEY_WIDTH = GLA_HEADS * GLA_DK
GLA_WIDTH = GLA_HEADS * GLA_DV
GLA_RANK = 16
GLA_TAU = 16.0
GLA_CHUNK = 64
ROPE_THETA = 10000.0
EPS = 1e-6
NEG = -1e30
BIG = 1e30
TINY = 1e-30

IN_SPLIT = (NSA_WIDTH,
            NSA_BRANCHES * 2 * NSA_KV_HEADS * HEAD_DIM,
            NSA_HEADS * NSA_BRANCHES,
            NSA_WIDTH,
            GLA_KEY_WIDTH, GLA_KEY_WIDTH, GLA_WIDTH,
            GLA_RANK,
            GLA_WIDTH,
            D_MODEL, D_MODEL)
IN_WIDTH = sum(IN_SPLIT)

kernel_name = 'nsa_gla_gated_hybrid_step'


def rms_norm(x, w):
    xf = x.astype(jnp.float32)
    y = xf * lax.rsqrt(jnp.mean(xf * xf, axis=-1, keepdims=True) + EPS)
    return (y * w.astype(jnp.float32)).astype(x.dtype)


def rope(x, pos):
    half = x.shape[-1] // 2
    inv = ROPE_THETA ** (-jnp.arange(half, dtype=jnp.float32) / half)
    ang = pos.astype(jnp.float32)[:, None] * inv[None, :]
    cos = jnp.cos(ang)[:, None, :]
    sin = jnp.sin(ang)[:, None, :]
    xf = x.astype(jnp.float32)
    x1, x2 = xf[..., :half], xf[..., half:]
    return jnp.concatenate([x1 * cos - x2 * sin, x2 * cos + x1 * sin], axis=-1).astype(x.dtype)


def masked_softmax(s, mask):
    s = jnp.where(mask, s.astype(jnp.float32), NEG)
    p = jnp.exp(s - jnp.max(s, axis=-1, keepdims=True)) * mask
    return p / jnp.maximum(jnp.sum(p, axis=-1, keepdims=True), TINY)


def compress_blocks(kv, cmp_pos, cmp_w1, cmp_b1, cmp_w2, cmp_b2):
    b, t = kv.shape[:2]
    r = CMP_LEN // CMP_STRIDE
    n_chunk = -(-t // CMP_STRIDE)
    kv = jnp.pad(kv, ((0, 0), (0, n_chunk * CMP_STRIDE - t), (0, 0), (0, 0), (0, 0)))
    ch = kv.reshape(b, n_chunk, CMP_STRIDE, 2, NSA_KV_HEADS, HEAD_DIM)
    w1 = cmp_w1.reshape(2, r, CMP_STRIDE, HEAD_DIM, CMP_HIDDEN)
    part = jnp.einsum('bnpxhd,xjpde->jbnxhe', ch, w1)
    nc = n_chunk - r + 1
    hid = part[0][:, :nc]
    for j in range(1, r):
        hid = hid + part[j][:, j:j + nc]
    pos_bias = jnp.einsum('xld,xlde->xe', cmp_pos, cmp_w1) + cmp_b1
    hid = jax.nn.silu(hid + pos_bias[:, None, :])
    out = jnp.einsum('bnxhe,xed->bnxhd', hid, cmp_w2) + cmp_b2[:, None, :]
    c_end = jnp.arange(nc, dtype=jnp.int32) * CMP_STRIDE + (CMP_LEN - 1)
    return out, c_end


def cmp_to_sel(nc, nb):
    cs = jnp.arange(nc)[:, None] * CMP_STRIDE
    js = jnp.arange(nb)[None, :] * SEL_BLOCK
    return ((cs < js + SEL_BLOCK) & (cs + CMP_LEN > js)).astype(jnp.float32)


def to_sel_blocks(kv):
    b, t = kv.shape[:2]
    nb = -(-t // SEL_BLOCK)
    kv = jnp.pad(kv, ((0, 0), (0, nb * SEL_BLOCK - t), (0, 0), (0, 0), (0, 0)))
    return kv.reshape(b, nb, SEL_BLOCK, 2, NSA_KV_HEADS, HEAD_DIM)


def nsa_attend(q, q_pos, kv_c, c_end, kv_s, kv_w, w_pos):
    b, nq = q.shape[:2]
    nc, nb = kv_c.shape[1], kv_s.shape[1]
    s_c = jnp.einsum('bqhgd,bchd->bhgqc', q, kv_c[:, :, 0])
    p_c = masked_softmax(s_c, c_end[None, :] <= q_pos[:, None])
    o_c = jnp.einsum('bhgqc,bchd->bqhgd', p_c.astype(q.dtype), kv_c[:, :, 1])
    imp = jnp.einsum('bhgqc,cn->bhqn', p_c, cmp_to_sel(nc, nb))
    blk = jnp.arange(nb, dtype=jnp.int32)[None, :]
    cur = (q_pos // SEL_BLOCK)[:, None]
    forced = (blk == 0) | ((blk <= cur) & (blk > cur - N_LOCAL))
    imp = jnp.where(forced, BIG, imp)
    imp = jnp.where(blk > cur, -BIG, imp)
    top_v, top_i = lax.top_k(imp, min(N_SELECT, nb))
    n_sel = top_i.shape[-1]
    sel_ok = top_v > -0.5 * BIG
    kv_sh = jnp.moveaxis(kv_s, 4, 1)
    g = jax.vmap(jax.vmap(lambda a, i: a[i]))(kv_sh, top_i)
    key_pos = top_i[..., None] * SEL_BLOCK + jnp.arange(SEL_BLOCK, dtype=jnp.int32)
    m_s = sel_ok[..., None] & (key_pos <= q_pos[:, None, None])
    s_s = jnp.einsum('bqhgd,bhqnsd->bhgqns', q, g[..., 0, :])
    nk = n_sel * SEL_BLOCK
    p_s = masked_softmax(s_s.reshape(b, NSA_KV_HEADS, NSA_GROUP, nq, nk),
                         m_s.reshape(b, NSA_KV_HEADS, nq, nk)[:, :, None])
    o_s = jnp.einsum('bhgqk,bhqkd->bqhgd', p_s.astype(q.dtype),
                     g[..., 1, :].reshape(b, NSA_KV_HEADS, nq, nk, HEAD_DIM))
    s_w = jnp.einsum('bqhgd,bkhd->bhgqk', q, kv_w[:, :, 0])
    m_w = ((w_pos[None, :] <= q_pos[:, None]) & (w_pos[None, :] > q_pos[:, None] - WINDOW)
           & (w_pos[None, :] >= 0))
    p_w = masked_softmax(s_w, m_w)
    o_w = jnp.einsum('bhgqk,bkhd->bqhgd', p_w.astype(q.dtype), kv_w[:, :, 1])
    return o_c, o_s, o_w


def nsa_prompt(q, kvc, kvs, kvw, cmp_pos, cmp_w1, cmp_b1, cmp_w2, cmp_b2):
    b, t = q.shape[:2]
    kv_c, c_end = compress_blocks(kvc, cmp_pos, cmp_w1, cmp_b1, cmp_w2, cmp_b2)
    kv_s = to_sel_blocks(kvs)
    kvw_pad = jnp.pad(kvw, ((0, 0), (WINDOW, 0), (0, 0), (0, 0), (0, 0)))

    def one_block(i):
        s = i * Q_BLOCK
        qb = lax.dynamic_slice_in_dim(q, s, Q_BLOCK, axis=1)
        qp = s + jnp.arange(Q_BLOCK, dtype=jnp.int32)
        kwb = lax.dynamic_slice_in_dim(kvw_pad, s, WINDOW + Q_BLOCK, axis=1)
        wp = s - WINDOW + jnp.arange(WINDOW + Q_BLOCK, dtype=jnp.int32)
        return nsa_attend(qb, qp, kv_c, c_end, kv_s, kwb, wp)

    o_c, o_s, o_w = lax.map(one_block, jnp.arange(t // Q_BLOCK, dtype=jnp.int32))
    shp = (b, t, NSA_KV_HEADS, NSA_GROUP, HEAD_DIM)
    return (jnp.moveaxis(o_c, 0, 1).reshape(shp), jnp.moveaxis(o_s, 0, 1).reshape(shp),
            jnp.moveaxis(o_w, 0, 1).reshape(shp))


def gather_pages(pool, page_table):
    rows = pool[page_table]
    return rows.reshape(page_table.shape[0], page_table.shape[1] * pool.shape[1], *pool.shape[2:])


def nsa_sample(q, kvc, kvs, kvw, cache_c, cache_s, cache_w, page_table,
               cmp_pos, cmp_w1, cmp_b1, cmp_w2, cmp_b2):
    nq = q.shape[1]
    past = page_table.shape[1] * cache_c.shape[1]
    full_c = jnp.concatenate([gather_pages(cache_c, page_table), kvc], axis=1)
    full_s = jnp.concatenate([gather_pages(cache_s, page_table), kvs], axis=1)
    kv_c, c_end = compress_blocks(full_c, cmp_pos, cmp_w1, cmp_b1, cmp_w2, cmp_b2)
    kv_s = to_sel_blocks(full_s)
    wb = cache_w.shape[1]
    kv_w = jnp.concatenate([cache_w, kvw], axis=1)
    w_pos = past - wb + jnp.arange(wb + nq, dtype=jnp.int32)
    q_pos = past + jnp.arange(nq, dtype=jnp.int32)
    return nsa_attend(q, q_pos, kv_c, c_end, kv_s, kv_w, w_pos)


def gla_scan(q, k, v, log_a, s0):
    b, t, h, _ = q.shape
    c = min(GLA_CHUNK, t)
    n = -(-t // c)
    pad = n * c - t

    def prep(a):
        a = jnp.pad(a.astype(jnp.float32), ((0, 0), (0, pad), (0, 0), (0, 0)))
        return jnp.moveaxis(a.reshape(b, n, c, h, a.shape[-1]), 1, 0)

    causal = jnp.tril(jnp.ones((c, c), bool))[None, :, :, None, None]

    def step(S, inp):
        qc, kc, vc, lc = inp
        cum = jnp.cumsum(lc, axis=1)
        o_inter = jnp.einsum('bthk,bhkv->bthv', qc * jnp.exp(cum), S)
        decay = jnp.exp(jnp.where(causal, cum[:, :, None] - cum[:, None, :], NEG))
        att = jnp.einsum('bthk,bshk,btshk->bhts', qc, kc, decay)
        o_intra = jnp.einsum('bhts,bshv->bthv', att, vc)
        c_last = cum[:, -1]
        S = (jnp.exp(c_last)[..., None] * S
             + jnp.einsum('bshk,bshv->bhkv', kc * jnp.exp(c_last[:, None] - cum), vc))
        return S, o_inter + o_intra

    S, o = lax.scan(step, s0.astype(jnp.float32), (prep(q), prep(k), prep(v), prep(log_a)))
    o = jnp.moveaxis(o, 0, 1).reshape(b, n * c, h, GLA_DV)[:, :t]
    return o, S


def sublayer(x, c, pos, s0, nsa_fn, norm_w, w_ada, b_ada, w_in, w_a2, b_a, gla_norm_w,
             w_o_nsa, w_o_gla, w_out):
    b, t, _ = x.shape
    mod = jnp.einsum('bd,de->be', c, w_ada) + b_ada
    shift, scale, gate = jnp.split(mod, 3, axis=-1)
    h = rms_norm(x, norm_w) * (1.0 + scale[:, None, :]) + shift[:, None, :]
    cuts = np.cumsum(IN_SPLIT)[:-1].tolist()
    (q_n, kv_n, g_n, z_n, q_g, k_g, v_g, a_g, z_g, m_n, m_g) = jnp.split(
        jnp.einsum('btd,de->bte', h, w_in), cuts, axis=-1)
    q = rope(q_n.reshape(b, t, NSA_HEADS, HEAD_DIM), pos) * (HEAD_DIM ** -0.5)
    q = q.reshape(b, t, NSA_KV_HEADS, NSA_GROUP, HEAD_DIM)
    kv = kv_n.reshape(b, t, NSA_BRANCHES, 2, NSA_KV_HEADS, HEAD_DIM)
    k = rope(kv[:, :, :, 0].reshape(b, t, NSA_BRANCHES * NSA_KV_HEADS, HEAD_DIM), pos)
    k = k.reshape(b, t, NSA_BRANCHES, NSA_KV_HEADS, HEAD_DIM)
    kv = jnp.stack([k, kv[:, :, :, 1]], axis=3)
    kvc, kvs, kvw = kv[:, :, 0], kv[:, :, 1], kv[:, :, 2]
    o_c, o_s, o_w = nsa_fn(q, kvc, kvs, kvw)
    gb = jax.nn.sigmoid(g_n).reshape(b, t, NSA_KV_HEADS, NSA_GROUP, NSA_BRANCHES)
    o_nsa = (gb[..., 0:1] * o_c + gb[..., 1:2] * o_s + gb[..., 2:3] * o_w).reshape(b, t, NSA_WIDTH)
    o_nsa = o_nsa * jax.nn.silu(z_n)
    qg = q_g.reshape(b, t, GLA_HEADS, GLA_DK) * (GLA_DK ** -0.5)
    kg = k_g.reshape(b, t, GLA_HEADS, GLA_DK)
    vg = v_g.reshape(b, t, GLA_HEADS, GLA_DV)
    log_a = jax.nn.log_sigmoid((jnp.einsum('btr,re->bte', a_g, w_a2) + b_a).astype(jnp.float32)) / GLA_TAU
    o_g, s_new = gla_scan(qg, kg, vg, log_a.reshape(b, t, GLA_HEADS, GLA_DK), s0)
    o_gla = rms_norm(o_g, gla_norm_w).astype(x.dtype).reshape(b, t, GLA_WIDTH) * jax.nn.silu(z_g)
    merged = (jax.nn.sigmoid(m_n) * jnp.einsum('bte,ed->btd', o_nsa, w_o_nsa)
              + jax.nn.sigmoid(m_g) * jnp.einsum('bte,ed->btd', o_gla, w_o_gla))
    y = x + gate[:, None, :] * jnp.einsum('btd,de->bte', merged, w_out)
    return y, kvc, kvs, kvw, s_new


def setup_inputs(seed: int = 0) -> dict:
    key = jax.random.key(seed)
    ks = jax.random.split(key, 25)
    n_pages = PAST_LEN // PAGE_SIZE
    n_pool = (DEC_BATCH * n_pages * 5) // 4
    win_buf = min(WINDOW, PAST_LEN)
    kv_row = (2, NSA_KV_HEADS, HEAD_DIM)

    def nrm(k, shape, scale):
        return scale * jax.random.normal(k, shape, jnp.float32)

    page_table = jax.random.permutation(ks[6], n_pool)[: DEC_BATCH * n_pages]
    page_table = page_table.reshape(DEC_BATCH, n_pages).astype(jnp.int32)
    return {
        'x_prompt': nrm(ks[0], (BATCH, SEQ, D_MODEL), 1.0),
        'x_sample': nrm(ks[1], (DEC_BATCH, DEC_SEQ, D_MODEL), 1.0),
        'cache_kv_cmp': nrm(ks[2], (DEPTH, n_pool, PAGE_SIZE) + kv_row, 1.0),
        'cache_kv_sel': nrm(ks[3], (DEPTH, n_pool, PAGE_SIZE) + kv_row, 1.0),
        'cache_kv_win': nrm(ks[4], (DEPTH, DEC_BATCH, win_buf) + kv_row, 1.0),
        'state_gla': nrm(ks[5], (DEPTH, DEC_BATCH, GLA_HEADS, GLA_DK, GLA_DV), 1.0),
        'page_table': page_table,
        'c_prompt': nrm(ks[7], (BATCH, D_MODEL), 1.0),
        'c_sample': nrm(ks[8], (DEC_BATCH, D_MODEL), 1.0),
        'norm_w': 1.0 + nrm(ks[9], (DEPTH, D_MODEL), 0.02),
        'w_ada': nrm(ks[10], (DEPTH, D_MODEL, 3 * D_MODEL), 0.5 * D_MODEL ** -0.5),
        'b_ada': nrm(ks[11], (DEPTH, 3 * D_MODEL), 0.01),
        'w_in': nrm(ks[12], (DEPTH, D_MODEL, IN_WIDTH), D_MODEL ** -0.5),
        'cmp_pos': nrm(ks[13], (DEPTH, 2, CMP_LEN, HEAD_DIM), 0.1),
        'cmp_w1': nrm(ks[14], (DEPTH, 2, CMP_LEN, HEAD_DIM, CMP_HIDDEN), (CMP_LEN * HEAD_DIM) ** -0.5),
        'cmp_b1': nrm(ks[15], (DEPTH, 2, CMP_HIDDEN), 0.01),
        'cmp_w2': nrm(ks[16], (DEPTH, 2, CMP_HIDDEN, HEAD_DIM), CMP_HIDDEN ** -0.5),
        'cmp_b2': nrm(ks[17], (DEPTH, 2, HEAD_DIM), 0.01),
        'w_a2': nrm(ks[18], (DEPTH, GLA_RANK, GLA_KEY_WIDTH), GLA_RANK ** -0.5),
        'b_a': nrm(ks[19], (DEPTH, GLA_KEY_WIDTH), 0.1),
        'gla_norm_w': 1.0 + nrm(ks[20], (DEPTH, GLA_DV), 0.02),
        'w_o_nsa': nrm(ks[21], (DEPTH, NSA_WIDTH, D_MODEL), NSA_WIDTH ** -0.5),
        'w_o_gla': nrm(ks[22], (DEPTH, GLA_WIDTH, D_MODEL), GLA_WIDTH ** -0.5),
        'w_out': nrm(ks[23], (DEPTH, D_MODEL, D_MODEL), D_MODEL ** -0.5),
        'final_norm_w': 1.0 + nrm(ks[24], (D_MODEL,), 0.02),
    }


def reference(x_prompt, x_sample, cache_kv_cmp, cache_kv_sel, cache_kv_win, state_gla, page_table,
              c_prompt, c_sample, norm_w, w_ada, b_ada, w_in, cmp_pos, cmp_w1, cmp_b1, cmp_w2, cmp_b2,
              w_a2, b_a, gla_norm_w, w_o_nsa, w_o_gla, w_out, final_norm_w):
    t_p = x_prompt.shape[1]
    t_s = x_sample.shape[1]
    past = page_table.shape[1] * cache_kv_cmp.shape[2]
    wb = cache_kv_win.shape[2]
    pos_p = jnp.arange(t_p, dtype=jnp.int32)
    pos_s = past + jnp.arange(t_s, dtype=jnp.int32)
    s0_p = jnp.zeros((x_prompt.shape[0], GLA_HEADS, GLA_DK, GLA_DV), jnp.float32)
    xp, xs = x_prompt, x_sample
    cmp_p, cmp_s, sel_p, sel_s, win_p, win_s, st_p, st_s = [], [], [], [], [], [], [], []
    for l in range(DEPTH):
        cmp_l = (cmp_pos[l], cmp_w1[l], cmp_b1[l], cmp_w2[l], cmp_b2[l])
        shared = (norm_w[l], w_ada[l], b_ada[l], w_in[l], w_a2[l], b_a[l], gla_norm_w[l],
                  w_o_nsa[l], w_o_gla[l], w_out[l])
        nsa_p = lambda q, kc, ks, kw: nsa_prompt(q, kc, ks, kw, *cmp_l)
        xp, kvc_p, kvs_p, kvw_p, sp = sublayer(xp, c_prompt, pos_p, s0_p, nsa_p, *shared)
        nsa_s = lambda q, kc, ks, kw: nsa_sample(q, kc, ks, kw, cache_kv_cmp[l], cache_kv_sel[l],
                                                 cache_kv_win[l], page_table, *cmp_l)
        xs, kvc_s, kvs_s, kvw_s, ss = sublayer(xs, c_sample, pos_s, state_gla[l], nsa_s, *shared)
        cmp_p.append(kvc_p)
        cmp_s.append(kvc_s)
        sel_p.append(kvs_p)
        sel_s.append(kvs_s)
        win_p.append(kvw_p[:, t_p - min(WINDOW, t_p):])
        win_s.append(jnp.concatenate([cache_kv_win[l], kvw_s], axis=1)[:, t_s:])
        st_p.append(sp.astype(state_gla.dtype))
        st_s.append(ss.astype(state_gla.dtype))
    y_prompt = rms_norm(xp, final_norm_w)
    y_sample = rms_norm(xs, final_norm_w)
    kv_cmp_prompt = jnp.stack(cmp_p, axis=0)
    kv_cmp_sample = jnp.stack(cmp_s, axis=0)
    kv_sel_prompt = jnp.stack(sel_p, axis=0)
    kv_sel_sample = jnp.stack(sel_s, axis=0)
    kv_win_prompt = jnp.stack(win_p, axis=0)
    kv_win_sample = jnp.stack(win_s, axis=0)
    gla_state_prompt = jnp.stack(st_p, axis=0)
    gla_state_sample = jnp.stack(st_s, axis=0)
    return (y_prompt, y_sample, kv_cmp_prompt, kv_cmp_sample, kv_sel_prompt, kv_sel_sample,
            kv_win_prompt, kv_win_sample, gla_state_prompt, gla_state_sample)
```

```cpp
#include <hip/hip_runtime.h>
#include <cstdio>
#include <cstdint>
#define MK_N_LAUNCHES 1
namespace pg8 {
#define PG8_LAS __attribute__((address_space(3)))
typedef unsigned short bf16_t;
typedef short bf16x8 __attribute__((ext_vector_type(8)));
typedef float f32x4 __attribute__((ext_vector_type(4)));
typedef unsigned u32x4 __attribute__((ext_vector_type(4)));
constexpr int BM = 256, BK = 64, HALF = 128, HTB = HALF * BK * 2  , STAGE_BYTES = 8 * HTB, NXCD = 8, WGM = 8;

__host__ __device__ __forceinline__ int lds_byte(int r, int c) { const int st = (r >> 4) * 2 + (c >> 5), rr = r & 15, cc = c & 31, ob = rr * 64 + cc * 2; return st * 1024 + (ob ^ (((ob >> 9) & 1) << 5)); }
__host__ __device__ __forceinline__ void stage_rc(int b, int& R, int& C) { const int st = b / 1024, sb = b % 1024, swz = sb ^ (((sb >> 9) & 1) << 5); R = (st >> 1) * 16 + swz / 64; C = (st & 1) * 32 + (swz % 64) / 2; }
__host__ __device__ __forceinline__ int perm32(int rho) { const int n = rho >> 4, i = rho & 15; return 8 * (i >> 2) + 4 * n + (i & 3); }

struct Unit { int pm, pn; };
struct Gemm { const bf16_t* A; const bf16_t* Bt; int M, N, K; };

struct StaticOrder {
    int nM, nN, nwg, G, c;
    __host__ __device__ void init(int M, int N, int G_, int c_) { nM = M / BM; nN = N / BM; nwg = nM * nN; G = G_; c = c_; }
    __host__ __device__ bool next(int i, Unit& u) const {
        const long L = (long)i * G + c; if (L >= nwg) return false;
        int wgid = (int)L; { const int q = nwg / NXCD, r = nwg % NXCD, xcd = wgid % NXCD, off = wgid / NXCD; wgid = (xcd < r ? xcd * (q + 1) : r * (q + 1) + (xcd - r) * q) + off; }
        const int nig = WGM * nN, gid = wgid / nig, fm = gid * WGM, gsz = (nM - fm) < WGM ? (nM - fm) : WGM;
        u.pm = fm + ((wgid % nig) % gsz); u.pn = (wgid % nig) / gsz; return true;
    }
    __device__ __forceinline__ void a_ready(const Unit&) const {}
    __device__ __forceinline__ void done(const Unit&) const {}
};

__device__ __forceinline__ unsigned cvt_pk_bf16(float lo, float hi) { unsigned r; asm volatile("v_cvt_pk_bf16_f32 %0, %1, %2" : "=v"(r) : "v"(lo), "v"(hi)); return r; }
typedef float f32x2 __attribute__((ext_vector_type(2)));

template <class Epi, class Sched, bool ALIGN_EPI = false, bool SP2 = false>
__device__ __forceinline__ void gemm_phase(PG8_LAS unsigned char* lds, const Gemm g, const Sched& S, const Epi& E) {
    const int tid = threadIdx.x, wid = __builtin_amdgcn_readfirstlane(tid >> 6), lane = tid & 63, wr = wid >> 2, wc = wid & 3, fr = lane & 15, fq = lane >> 4;
    const int K = g.K, nt = K / BK;
    unsigned voffA[2], voffB[2];
#pragma unroll
    for (int i = 0; i < 2; ++i) { int R, C; stage_rc(tid * 16 + i * 8192, R, C); const int Rb = Epi::PERM ? ((R & ~31) + perm32(R & 31)) : R;
        voffA[i] = (unsigned)(R * K + C) * 2u; voffB[i] = (unsigned)(Rb * K + C) * 2u; }
    const size_t kstep = (size_t)(BK * 2);
    const size_t hstep = (size_t)HALF * K * 2;
    const size_t tstep = 2 * hstep;
    const unsigned ldsw = (unsigned)wid * 1024u;
    const int aoff = lds_byte(wr * 64 + fr, fq * 8), boff = lds_byte(wc * 32 + fr, fq * 8);
#define PG8_SA(b, h) (((b) * 2 + (h)) * HTB)
#define PG8_SB(b, h) ((4 + (b) * 2 + (h)) * HTB)
#define PG8_STAGE(bufoff, gbase, voff) do { _Pragma("unroll") for (int _i = 0; _i < 2; ++_i) \
        __builtin_amdgcn_global_load_lds((const unsigned*)((const char*)(gbase) + (voff)[_i]), (PG8_LAS unsigned*)(lds + (bufoff) + ldsw + _i * 8192), 16, 0, 0); } while (0)
#define PG8_LDA(dst, b, h) do { _Pragma("unroll") for (int m = 0; m < 4; ++m) _Pragma("unroll") for (int k = 0; k < 2; ++k) dst[m][k] = *(const PG8_LAS bf16x8*)(lds + PG8_SA(b, h) + aoff + m * 2048 + k * 1024); } while (0)
#define PG8_LDB(dst, b, h) do { _Pragma("unroll") for (int n = 0; n < 2; ++n) _Pragma("unroll") for (int k = 0; k < 2; ++k) dst[n][k] = *(const PG8_LAS bf16x8*)(lds + PG8_SB(b, h) + boff + n * 2048 + k * 1024); } while (0)
#define PG8_MMA(ai, bj, At, Bt) do { __builtin_amdgcn_s_setprio(1); _Pragma("unroll") for (int m = 0; m < 4; ++m) _Pragma("unroll") for (int n = 0; n < 2; ++n) _Pragma("unroll") for (int k = 0; k < 2; ++k) \
        acc[ai][bj][m][n] = __builtin_amdgcn_mfma_f32_16x16x32_bf16(Bt[n][k], At[m][k], acc[ai][bj][m][n], 0, 0, 0); __builtin_amdgcn_s_setprio(0); } while (0)
#define PG8_WAIT_V(n) asm volatile("s_waitcnt vmcnt(" #n ")" ::: "memory")
#define PG8_WAIT_L(n) asm volatile("s_waitcnt lgkmcnt(" #n ")" ::: "memory")
#define PG8_BAR __builtin_amdgcn_s_barrier()
#define PG8_SCHED __builtin_amdgcn_sched_barrier(0)
    Unit cur, nxt; int ui = 0;
    if (!S.next(0, cur)) return;
    f32x4 acc[2][2][4][2];
#pragma unroll
    for (int a = 0; a < 2; ++a)
#pragma unroll
        for (int b = 0; b < 2; ++b)
#pragma unroll
            for (int m = 0; m < 4; ++m)
#pragma unroll
                for (int n = 0; n < 2; ++n) acc[a][b][m][n] = (f32x4){0.f, 0.f, 0.f, 0.f};
    bf16x8 At[4][2], B0[2][2], B1[2][2];
    const char* cA = (const char*)g.A + (size_t)cur.pm * tstep; const char* cB = (const char*)g.Bt + (size_t)cur.pn * tstep;
    S.a_ready(cur);
    if constexpr (SP2) {
        PG8_STAGE(PG8_SB(0, 0), cB, voffB); PG8_STAGE(PG8_SB(0, 1), cB + hstep, voffB); PG8_STAGE(PG8_SA(0, 0), cA, voffA); PG8_STAGE(PG8_SA(0, 1), cA + hstep, voffA);
        if (wr == 1) PG8_BAR;
        PG8_WAIT_V(2); PG8_BAR;
        PG8_STAGE(PG8_SB(1, 0), cB + kstep, voffB); PG8_STAGE(PG8_SA(1, 0), cA + kstep, voffA); PG8_STAGE(PG8_SB(1, 1), cB + hstep + kstep, voffB);
        PG8_WAIT_V(6); PG8_BAR;
    } else {
        PG8_STAGE(PG8_SB(0, 0), cB, voffB); PG8_STAGE(PG8_SA(0, 0), cA, voffA); PG8_STAGE(PG8_SB(0, 1), cB + hstep, voffB); PG8_STAGE(PG8_SA(0, 1), cA + hstep, voffA);
        if (wr == 1) PG8_BAR;
        PG8_WAIT_V(4); PG8_BAR;
        PG8_STAGE(PG8_SB(1, 0), cB + kstep, voffB); PG8_STAGE(PG8_SA(1, 0), cA + kstep, voffA); PG8_STAGE(PG8_SB(1, 1), cB + hstep + kstep, voffB);
        PG8_WAIT_V(6); PG8_BAR;
    }
    for (;;) {
        const bool has_next = S.next(ui + 1, nxt);
        const char* nA = has_next ? (const char*)g.A + (size_t)nxt.pm * tstep : cA; const char* nB = has_next ? (const char*)g.Bt + (size_t)nxt.pn * tstep : cB;
        for (int t = 0; t < nt; t += 2) {
            const bool last = (t == nt - 2);
            const char* a1 = cA + (size_t)(t + 1) * kstep;
            const char* a2 = last ? nA : cA + (size_t)(t + 2) * kstep; const char* b2 = last ? nB : cB + (size_t)(t + 2) * kstep;
            const char* a3 = a2 + kstep; const char* b3 = b2 + kstep;
            if (last && has_next) S.a_ready(nxt);
            if constexpr (SP2) {
            PG8_LDB(B0, 0, 0); PG8_LDB(B1, 0, 1); PG8_SCHED; PG8_LDA(At, 0, 0); PG8_STAGE(PG8_SA(1, 1), a1 + hstep, voffA);
            PG8_WAIT_V(8); PG8_WAIT_L(0); PG8_BAR; PG8_MMA(0, 0, At, B0); PG8_MMA(0, 1, At, B1); PG8_BAR; PG8_SCHED;
            PG8_LDA(At, 0, 1); PG8_STAGE(PG8_SB(0, 0), b2, voffB); PG8_STAGE(PG8_SB(0, 1), b2 + hstep, voffB); PG8_STAGE(PG8_SA(0, 0), a2, voffA);
            PG8_WAIT_V(8); PG8_WAIT_L(0); PG8_BAR; PG8_MMA(1, 0, At, B0); PG8_MMA(1, 1, At, B1); PG8_BAR; PG8_SCHED;
            PG8_LDB(B0, 1, 0); PG8_LDB(B1, 1, 1); PG8_SCHED; PG8_LDA(At, 1, 0); PG8_STAGE(PG8_SA(0, 1), a2 + hstep, voffA);
            PG8_WAIT_V(8); PG8_WAIT_L(0); PG8_BAR; PG8_MMA(0, 0, At, B0); PG8_MMA(0, 1, At, B1); PG8_BAR; PG8_SCHED;
            PG8_LDA(At, 1, 1); PG8_STAGE(PG8_SB(1, 0), b3, voffB); PG8_STAGE(PG8_SB(1, 1), b3 + hstep, voffB); PG8_STAGE(PG8_SA(1, 0), a3, voffA);
            PG8_WAIT_V(8); PG8_WAIT_L(0); PG8_BAR; PG8_MMA(1, 0, At, B0); PG8_MMA(1, 1, At, B1); PG8_BAR; PG8_SCHED;
            } else {
            PG8_LDB(B0, 0, 0); PG8_SCHED; PG8_LDA(At, 0, 0); PG8_STAGE(PG8_SA(1, 1), a1 + hstep, voffA);
            PG8_WAIT_L(8); PG8_BAR; PG8_WAIT_L(0); PG8_MMA(0, 0, At, B0); PG8_BAR; PG8_SCHED;
            PG8_LDB(B1, 0, 1); PG8_STAGE(PG8_SB(0, 0), b2, voffB);
            PG8_BAR; PG8_WAIT_L(0); PG8_MMA(0, 1, At, B1); PG8_BAR;
            PG8_LDA(At, 0, 1); PG8_STAGE(PG8_SA(0, 0), a2, voffA);
            PG8_BAR; PG8_WAIT_L(0); PG8_MMA(1, 0, At, B0); PG8_BAR; PG8_SCHED;
            PG8_STAGE(PG8_SB(0, 1), b2 + hstep, voffB);
            PG8_WAIT_V(6); PG8_BAR; PG8_MMA(1, 1, At, B1); PG8_BAR;
            PG8_LDB(B0, 1, 0); PG8_SCHED; PG8_LDA(At, 1, 0); PG8_STAGE(PG8_SA(0, 1), a2 + hstep, voffA);
            PG8_WAIT_L(8); PG8_BAR; PG8_WAIT_L(0); PG8_MMA(0, 0, At, B0); PG8_BAR; PG8_SCHED;
            PG8_LDB(B1, 1, 1); PG8_STAGE(PG8_SB(1, 0), b3, voffB);
            PG8_BAR; PG8_WAIT_L(0); PG8_MMA(0, 1, At, B1); PG8_BAR;
            PG8_LDA(At, 1, 1); PG8_STAGE(PG8_SA(1, 0), a3, voffA);
            PG8_BAR; PG8_WAIT_L(0); PG8_MMA(1, 0, At, B0); PG8_BAR; PG8_SCHED;
            PG8_STAGE(PG8_SB(1, 1), b3 + hstep, voffB);
            PG8_WAIT_V(6); PG8_BAR; PG8_MMA(1, 1, At, B1); PG8_BAR;
            }
        }
        if constexpr (ALIGN_EPI) { if (wr == 0) PG8_BAR; }
        if constexpr (!Epi::AFTER_DRAIN) { E(acc, cur, wr, wc, fr, fq); S.done(cur); }
        if (!has_next) break;
#pragma unroll
        for (int a = 0; a < 2; ++a)
#pragma unroll
            for (int b = 0; b < 2; ++b)
#pragma unroll
                for (int m = 0; m < 4; ++m)
#pragma unroll
                    for (int n = 0; n < 2; ++n) acc[a][b][m][n] = (f32x4){0.f, 0.f, 0.f, 0.f};
        cur = nxt; cA = nA; cB = nB; ++ui;
        if constexpr (ALIGN_EPI) { if (wr == 1) PG8_BAR; }
    }
    PG8_WAIT_V(0);
    if constexpr (!ALIGN_EPI) { if (wr == 0) PG8_BAR; }
    PG8_BAR;
    if constexpr (Epi::AFTER_DRAIN) { E.fused(acc, cur, wr, wc, fr, fq, lds, wid, lane); S.done(cur); }
#undef PG8_SA
#undef PG8_SB
#undef PG8_STAGE
#undef PG8_LDA
#undef PG8_LDB
#undef PG8_MMA
#undef PG8_WAIT_V
#undef PG8_WAIT_L
#undef PG8_BAR
#undef PG8_SCHED
}
}

constexpr int NWAVES = 8;
constexpr int DM = 2048, TP = 8192, TS = 256, MROWS = TP + TS, NINP = 11008, NMOD = 6144;
constexpr int NBATCH_S = 32, TSEQ_S = 8, NPAGE = 64;
constexpr float QSCALE = 0.125f * 1.4426950408889634f;
constexpr float GQSCALE = 0.08838834764831845f;
constexpr size_t O_YP = 0, O_YS = 16777216, O_CMPP = 17301504, O_CMPS = 21495808, O_SELP = 21626880, O_SELS = 25821184,
                 O_WINP = 25952256, O_WINS = 26214400, O_STP = 34603008, O_STS = 34734080, O_TOTAL = 38928384;
constexpr size_t MiB = 1u << 20;
constexpr size_t WS_CTL = 0, CTL_ZERO_BYTES = 1 * MiB;
constexpr size_t WS_MOD = 1 * MiB;
constexpr size_t WS_ROPE = 2 * MiB;
constexpr size_t WS_POSB = 5 * MiB;
constexpr size_t WS_W1T = 6 * MiB;
constexpr size_t WS_WIN = 7 * MiB;
constexpr size_t WS_WON = 50 * MiB, WS_WOG = 54 * MiB, WS_WOUT = 58 * MiB;
constexpr size_t WS_H = 66 * MiB;
constexpr size_t WS_QB = 99 * MiB;
constexpr size_t WS_KVB = 116 * MiB;
constexpr size_t WS_CB = 132 * MiB;
constexpr size_t CB_X = (size_t)33 * 4 * 8192 * 64;
constexpr size_t WS_PART = 397 * MiB;
constexpr int CROWS = 33 * 4 * 512;
constexpr size_t WS_KC = 464 * MiB;
constexpr size_t WS_ZN = 481 * MiB, WS_ZG = 498 * MiB;
constexpr size_t WS_MN = 515 * MiB, WS_MG = 548 * MiB;
constexpr size_t WS_QG = 581 * MiB, WS_KG = 590 * MiB;
constexpr size_t WS_VGT = 599 * MiB;
constexpr size_t WS_VGS = 615 * MiB;
constexpr size_t WS_AG = 616 * MiB;
constexpr size_t WS_GB = 617 * MiB;
constexpr size_t WS_LT = 619 * MiB;
constexpr size_t WS_DC = 683 * MiB;
constexpr size_t WS_ST = 684 * MiB;
constexpr size_t WS_ONSA = 716 * MiB, WS_OGLA = 733 * MiB;
constexpr size_t WS_MERGED = 750 * MiB;
constexpr size_t WS_RSS = 783 * MiB;
constexpr size_t WS_END = 785 * MiB;
constexpr int CW_BAR = 4096;
constexpr int CW_Q5 = 8192;
constexpr int RING_BYTES = 131072;
constexpr int LDSCTL_OFF = RING_BYTES;
constexpr int LDS_BYTES = 147456;

#define GAS __attribute__((address_space(1)))
#define LAS __attribute__((address_space(3)))
typedef unsigned short bf16;
typedef short bf16x8 __attribute__((ext_vector_type(8)));
typedef short s16x4 __attribute__((ext_vector_type(4)));
typedef float f32x4 __attribute__((ext_vector_type(4)));
typedef float f32x2 __attribute__((ext_vector_type(2)));
typedef float f32x16 __attribute__((ext_vector_type(16)));
typedef unsigned u32x4 __attribute__((ext_vector_type(4)));
typedef unsigned u32x2 __attribute__((ext_vector_type(2)));
typedef GAS unsigned gu32;
#define RLX_AGENT __ATOMIC_RELAXED, __HIP_MEMORY_SCOPE_AGENT
#define LDS_WAIT() asm volatile("s_waitcnt lgkmcnt(0)" ::: "memory")

__device__ __forceinline__ unsigned f2bf(float f) { unsigned u = __builtin_bit_cast(unsigned, f); return (u + 0x7fffu + ((u >> 16) & 1u)) >> 16; }
__device__ __forceinline__ unsigned pk2(float lo, float hi) { return f2bf(lo) | (f2bf(hi) << 16); }
__device__ __forceinline__ float bf2f(unsigned b) { return __builtin_bit_cast(float, b << 16); }
__device__ __forceinline__ float bflo(unsigned w) { return __builtin_bit_cast(float, w << 16); }
__device__ __forceinline__ float bfhi(unsigned w) { return __builtin_bit_cast(float, w & 0xffff0000u); }
__device__ __forceinline__ float sigm(float x) { return 1.f / (1.f + __expf(-x)); }
__device__ __forceinline__ float silu(float x) { return x / (1.f + __expf(-x)); }
__device__ __forceinline__ float ex2(float x) { return __builtin_amdgcn_exp2f(x); }
__device__ __forceinline__ float wave_sum(float v) {
#pragma unroll
    for (int o = 1; o < 64; o <<= 1) v += __shfl_xor(v, o);
    return v;
}
#define XB_TMO      128
#define XB_XCNT(j)  (256  + 64 * (j))
#define XB_XSUB(j)  (1280 + 64 * (j))
#define XB_XGEN(j)  (2304 + 64 * (j))
#define XB_TOP      3328
#define XB_TOPGEN   3392
#define XCD_BAR_WORDS 3456
#define XB_SPIN_CAP (1u << 18)

__device__ __forceinline__ unsigned xb_ld(unsigned* p)              { return __hip_atomic_load(p, __ATOMIC_RELAXED, __HIP_MEMORY_SCOPE_AGENT); }
__device__ __forceinline__ unsigned xb_add(unsigned* p, unsigned v) { return __hip_atomic_fetch_add(p, v, __ATOMIC_RELAXED, __HIP_MEMORY_SCOPE_AGENT); }
__device__ __forceinline__ unsigned xb_xcc_id() { return (unsigned)__builtin_amdgcn_s_getreg((3 << 11) | 20) & 0xFu; }
#define XB_SPIN(cond, bar) do { unsigned _sp = 0; while (cond) { __builtin_amdgcn_s_sleep(1); \
    if ((++_sp & 255u) == 0u) { if (xb_ld(&(bar)[XB_TMO])) break; if (_sp > XB_SPIN_CAP) { atomicAdd(&(bar)[XB_TMO], 1u); break; } } } } while (0)

struct XcdBarrier {
    unsigned* bar; unsigned x;
    volatile LAS unsigned* st;
};

__device__ __forceinline__ XcdBarrier xcd_barrier_post(unsigned* bar, volatile LAS unsigned* st) {
    XcdBarrier b; b.bar = bar; b.x = xb_xcc_id(); b.st = st;
    if (threadIdx.x == 0) (void)xb_add(&bar[XB_XCNT(b.x)], 1u);
    return b;
}
__device__ __forceinline__ void xcd_barrier_complete(unsigned* bar, unsigned x, unsigned& nloc, unsigned& nx) {
    const unsigned G = gridDim.x * gridDim.y * gridDim.z;
    unsigned sum, cnt, mine, sp = 0u;
    for (;;) {
        sum = 0u; cnt = 0u; mine = 0u;
#pragma unroll
        for (unsigned j = 0; j < 16; ++j) { const unsigned c = xb_ld(&bar[XB_XCNT(j)]); sum += c; cnt += (c > 0u) ? 1u : 0u; mine = (j == x) ? c : mine; }
        if (sum == G) break;
        __builtin_amdgcn_s_sleep(1);
        if ((++sp & 255u) == 0u) { if (xb_ld(&bar[XB_TMO])) break; if (sp > XB_SPIN_CAP) { atomicAdd(&bar[XB_TMO], 1u); break; } }
    }
    nloc = mine > 0u ? mine : 1u; nx = cnt > 0u ? cnt : 1u;
}

__device__ __forceinline__ void xcd_barrier(const XcdBarrier& b) {
    asm volatile("s_waitcnt vmcnt(0)" ::: "memory");
    __syncthreads();
    if (threadIdx.x == 0) {
        unsigned* bar = b.bar;
        __builtin_amdgcn_s_waitcnt(0);
        unsigned nloc = b.st[0], nx = b.st[1];
        if (nloc == 0u) { xcd_barrier_complete(bar, b.x, nloc, nx); b.st[0] = nloc; b.st[1] = nx; }
        const unsigned old = xb_add(&bar[XB_XSUB(b.x)], 1u);
        const unsigned gen = old / nloc;
        if (old + 1u == (gen + 1u) * nloc) {
            __builtin_amdgcn_fence(__ATOMIC_RELEASE, "agent");
            asm volatile("s_waitcnt vmcnt(0)" ::: "memory");
            const unsigned og = xb_add(&bar[XB_TOP], 1u);
            const unsigned tg = og / nx;
            if (og + 1u == (tg + 1u) * nx) xb_add(&bar[XB_TOPGEN], 1u);
            else XB_SPIN(xb_ld(&bar[XB_TOPGEN]) == tg, bar);
            __builtin_amdgcn_fence(__ATOMIC_ACQUIRE, "agent");
            xb_add(&bar[XB_XGEN(b.x)], 1u);
            asm volatile("s_waitcnt vmcnt(0)" ::: "memory");
        } else {
            XB_SPIN(xb_ld(&bar[XB_XGEN(b.x)]) == gen, bar);
            __builtin_amdgcn_fence(__ATOMIC_ACQUIRE, "agent");
            asm volatile("s_waitcnt vmcnt(0)" ::: "memory");
        }
    }
    __syncthreads();
}

struct Frame {
    LAS unsigned char* lds;
    volatile LAS unsigned* MISC;
    gu32* ctl;
    int tid, lane, wave, G, gw, NGW;
    const float *x_p, *x_s, *c_cmp, *c_sel, *c_win, *state, *c_p, *c_s, *norm_w, *w_ada, *b_ada, *w_in, *cmp_pos, *cmp_w1, *cmp_b1, *cmp_w2, *cmp_b2,
                *w_a2, *b_a, *gnw, *w_on, *w_og, *w_out, *fnw;
    const int* ptab;
    float* out;
    unsigned char* ws;
};
#define WSP(T, off) ((T*)(F.ws + (off)))

__device__ __forceinline__ int ropeperm(int pp) { const int j8 = pp >> 3, e = pp & 7; return e < 4 ? 4 * j8 + e : 32 + 4 * j8 + (e - 4); }
__device__ __forceinline__ int in_col(int n) {
    const int tile = n >> 8, pc = n & 255;
    if (tile < 4) return (tile * 4 + (pc >> 6)) * 64 + ropeperm(pc & 63);
    if (tile < 10) { const int t = tile - 4, br = t >> 1, x = t & 1, pp = pc & 63; return 1024 + br * 512 + x * 256 + (pc >> 6) * 64 + (x == 0 ? ropeperm(pp) : pp); }
    if (tile < 14) return 2608 + (n - 10 * 256);
    if (tile < 16) return 3632 + (n - 14 * 256);
    if (tile < 18) return 4144 + (n - 16 * 256);
    if (tile < 22) return 4656 + (n - 18 * 256);
    if (tile < 26) return 5696 + (n - 22 * 256);
    if (tile < 34) return 6720 + (n - 26 * 256);
    if (tile < 42) return 8768 + (n - 34 * 256);
    if (pc < 48) return 2560 + pc;
    if (pc < 64) return 5680 + (pc - 48);
    return -1;
}
template <bool MAPPED>
__device__ __forceinline__ void transpose_item(const float* __restrict__ W, int ldw, int K, bf16* WT, int row_off, LAS float* scr, int k0, int n0, int lane) {
    int col = n0 + (lane & 31);
    if (MAPPED) col = in_col(col);
#pragma unroll 8
    for (int i = 0; i < 32; ++i) { const int kk = 2 * i + (lane >> 5); scr[kk * 33 + (lane & 31)] = (col >= 0) ? W[(size_t)(k0 + kk) * ldw + col] : 0.f; }
    LDS_WAIT(); asm volatile("" ::: "memory");
    const int c = lane & 7;
#pragma unroll
    for (int j = 0; j < 4; ++j) { const int n = (lane >> 3) + 8 * j; const LAS float* s = scr + (8 * c) * 33 + n;
        u32x4 o; o.x = pk2(s[0 * 33], s[1 * 33]); o.y = pk2(s[2 * 33], s[3 * 33]); o.z = pk2(s[4 * 33], s[5 * 33]); o.w = pk2(s[6 * 33], s[7 * 33]);
        *(u32x4*)(WT + (size_t)(row_off + n0 + n) * K + k0 + 8 * c) = o; }
    LDS_WAIT(); asm volatile("" ::: "memory");
}
__device__ const float INVF[32] = {1.000000000e+00f, 7.498942018e-01f, 5.623413324e-01f, 4.216965139e-01f, 3.162277639e-01f, 2.371373773e-01f, 1.778279394e-01f, 1.333521456e-01f,
    1.000000015e-01f, 7.498942316e-02f, 5.623413250e-02f, 4.216964915e-02f, 3.162277490e-02f, 2.371373773e-02f, 1.778279431e-02f, 1.333521400e-02f,
    9.999999776e-03f, 7.498942316e-03f, 5.623413250e-03f, 4.216964822e-03f, 3.162277630e-03f, 2.371373819e-03f, 1.778279431e-03f, 1.333521446e-03f,
    1.000000047e-03f, 7.498941850e-04f, 5.623413017e-04f, 4.216965172e-04f, 3.162277571e-04f, 2.371373703e-04f, 1.778279402e-04f, 1.333521504e-04f};
__device__ __forceinline__ void sincos_acc(float a, float& s, float& c) {
    const double x = (double)a;
    const double kq = __builtin_rint(x * 0.63661977236758134308);
    double r = __builtin_fma(-kq, 1.5707963267948966192, x); r = __builtin_fma(-kq, 6.123233995736766e-17, r);
    const int q = ((int)kq) & 3;
    const double z = r * r;
    double sp = 1.0 / 6227020800.0; sp = sp * z - 1.0 / 39916800.0; sp = sp * z + 1.0 / 362880.0; sp = sp * z - 1.0 / 5040.0; sp = sp * z + 1.0 / 120.0; sp = sp * z - 1.0 / 6.0; sp = sp * z + 1.0; sp *= r;
    double cp = 1.0 / 479001600.0; cp = cp * z - 1.0 / 3628800.0; cp = cp * z + 1.0 / 40320.0; cp = cp * z - 1.0 / 720.0; cp = cp * z + 1.0 / 24.0; cp = cp * z - 0.5; cp = cp * z + 1.0;
    const double ss = (q == 0) ? sp : (q == 1) ? cp : (q == 2) ? -sp : -cp;
    const double cc = (q == 0) ? cp : (q == 1) ? -sp : (q == 2) ? -cp : sp;
    s = (float)ss; c = (float)cc;
}

__device__ __forceinline__ void p0_prologue(Frame& F) {
    LAS float* scr = (LAS float*)(F.lds + F.wave * 16384);
    const int lane = F.lane;
    constexpr int I_IN = 32 * 344, I_ON = 16 * 64, I_OUT = 32 * 64, I_W1 = 4 * 16 * 4, I_W2 = 2 * 2 * 2;
    constexpr int NITEMS = I_IN + 2 * I_ON + I_OUT + I_W1 + I_W2;
    for (int it = F.gw; it < NITEMS; it += F.NGW) {
        int r = it;
        if (r < I_IN) { transpose_item<true>(F.w_in, 10816, 2048, WSP(bf16, WS_WIN), 0, scr, 64 * (r / 344), 32 * (r % 344), lane); continue; } r -= I_IN;
        if (r < I_ON) { transpose_item<false>(F.w_on, 2048, 1024, WSP(bf16, WS_WON), 0, scr, 64 * (r / 64), 32 * (r % 64), lane); continue; } r -= I_ON;
        if (r < I_ON) { transpose_item<false>(F.w_og, 2048, 1024, WSP(bf16, WS_WOG), 0, scr, 64 * (r / 64), 32 * (r % 64), lane); continue; } r -= I_ON;
        if (r < I_OUT) { transpose_item<false>(F.w_out, 2048, 2048, WSP(bf16, WS_WOUT), 0, scr, 64 * (r / 64), 32 * (r % 64), lane); continue; } r -= I_OUT;
        if (r < I_W1) { const int xj = r / 64, rr = r % 64;
            transpose_item<false>(F.cmp_w1 + (size_t)xj * 1024 * 128, 128, 1024, WSP(bf16, WS_W1T) + (size_t)(xj >> 1) * 256 * 1024, (xj & 1) * 128, scr, 64 * (rr / 4), 32 * (rr % 4), lane); continue; } r -= I_W1;
        { const int x = r / 4, rr = r % 4;
            transpose_item<false>(F.cmp_w2 + (size_t)x * 128 * 64, 64, 128, WSP(bf16, WS_POSB + 4096) + (size_t)x * 64 * 128, 0, scr, 64 * (rr / 2), 32 * (rr % 2), lane); }
    }
    for (int it = F.gw; it < 256; it += F.NGW) {
        const int x = it >> 7, e = it & 127; float s = 0.f;
        for (int i = 0; i < 32; ++i) { const int ld = i * 64 + lane; s += F.cmp_pos[x * 2048 + ld] * F.cmp_w1[((size_t)x * 2048 + ld) * 128 + e]; }
        s = wave_sum(s);
        if (lane == 0) WSP(float, WS_POSB)[it] = s + F.cmp_b1[it];
    }
    for (int i = F.gw * 64 + lane; i < 8200 * 32; i += F.NGW * 64) {
        const int pos = i >> 5, j = i & 31; const float ang = (float)pos * INVF[j]; float s, c; sincos_acc(ang, s, c);
        WSP(float, WS_ROPE)[pos * 64 + j] = c; WSP(float, WS_ROPE)[pos * 64 + 32 + j] = s;
    }
    for (int cg = F.gw; cg < NMOD / 4; cg += F.NGW) {
        f32x4 acc[33];
#pragma unroll
        for (int r = 0; r < 33; ++r) acc[r] = (f32x4){0.f, 0.f, 0.f, 0.f};
        for (int it = 0; it < 32; ++it) {
            const int k = it * 64 + lane;
            const f32x4 w = *(const f32x4*)(F.w_ada + (size_t)k * NMOD + cg * 4);
            acc[0] += w * F.c_p[k];
#pragma unroll
            for (int r = 0; r < 32; ++r) acc[1 + r] += w * F.c_s[r * 2048 + k];
        }
        const f32x4 bb = *(const f32x4*)(F.b_ada + cg * 4);
#pragma unroll
        for (int r = 0; r < 33; ++r) {
            f32x4 v = acc[r]; v.x = wave_sum(v.x); v.y = wave_sum(v.y); v.z = wave_sum(v.z); v.w = wave_sum(v.w);
            if (lane == 0) *(f32x4*)(WSP(float, WS_MOD) + (size_t)r * NMOD + cg * 4) = v + bb;
        }
    }
    {
        bf16* CB = WSP(bf16, WS_CB);
        const int x = lane >> 5, h = (lane >> 3) & 3, d0 = (lane & 7) * 8;
#pragma unroll 4
        for (int ri = F.gw; ri < NBATCH_S * 8192; ri += F.NGW) {
            const int b = ri >> 13, pos = ri & 8191;
            const int page = F.ptab[b * NPAGE + (pos >> 7)];
            const float* src = F.c_cmp + ((size_t)page * 128 + (pos & 127)) * 512 + lane * 8;
            const f32x4 a = *(const f32x4*)src, c = *(const f32x4*)(src + 4);
            u32x4 o; o.x = pk2(a.x, a.y); o.y = pk2(a.z, a.w); o.z = pk2(c.x, c.y); o.w = pk2(c.z, c.w);
            *(u32x4*)(CB + (size_t)x * CB_X + ((size_t)(b * 4 + h) * 8192 + pos) * 64 + d0) = o;
        }
    }
    {
        const f32x4* src = (const f32x4*)F.c_win; f32x4* dst = (f32x4*)(F.out + O_WINS);
        for (int i = F.gw * 64 + lane; i < NBATCH_S * 504 * 128; i += F.NGW * 64) {
            const int b = i / (504 * 128), o = i % (504 * 128);
            dst[(size_t)b * 512 * 128 + o] = src[(size_t)b * 512 * 128 + 8 * 128 + o];
        }
    }
}

__device__ __forceinline__ void p1_modnorm(Frame& F) {
    const float* MOD = WSP(float, WS_MOD);
    bf16* H = WSP(bf16, WS_H);
    for (int r = F.gw; r < MROWS; r += F.NGW) {
        const float* xr = (r < TP) ? F.x_p + (size_t)r * DM : F.x_s + (size_t)(r - TP) * DM;
        const float* mr = MOD + (size_t)((r < TP) ? 0 : 1 + ((r - TP) >> 3)) * NMOD;
        f32x4 v[8]; float ss = 0.f;
#pragma unroll
        for (int j = 0; j < 8; ++j) { v[j] = *(const f32x4*)(xr + (j * 64 + F.lane) * 4); ss += (v[j].x * v[j].x + v[j].y * v[j].y) + (v[j].z * v[j].z + v[j].w * v[j].w); }
        const float rstd = 1.f / sqrtf(wave_sum(ss) * (1.f / DM) + 1e-6f);
#pragma unroll
        for (int j = 0; j < 8; ++j) {
            const int c = (j * 64 + F.lane) * 4;
            const f32x4 nw = *(const f32x4*)(F.norm_w + c), sh = *(const f32x4*)(mr + c), sc = *(const f32x4*)(mr + 2048 + c);
            const f32x4 hv = (v[j] * rstd) * nw * (sc + 1.0f) + sh;
            u32x2 o; o.x = pk2(hv.x, hv.y); o.y = pk2(hv.z, hv.w);
            *(u32x2*)(H + (size_t)r * DM + c) = o;
        }
    }
}

__device__ __forceinline__ u32x4 pack8(const f32x4 a, const f32x4 b) { u32x4 o; o.x = pk2(a.x, a.y); o.y = pk2(a.z, a.w); o.z = pk2(b.x, b.y); o.w = pk2(b.z, b.w); return o; }
__device__ __forceinline__ u32x2 pack4(const f32x4 a) { u32x2 o; o.x = pk2(a.x, a.y); o.y = pk2(a.z, a.w); return o; }

struct EpiPlainBf16 {
    static constexpr bool PERM = true, AFTER_DRAIN = false;
    bf16* O; int ldc;
    __device__ __forceinline__ void operator()(const f32x4 (&acc)[2][2][4][2], const pg8::Unit& u, int wr, int wc, int fr, int fq) const {
#pragma unroll
        for (int ai = 0; ai < 2; ++ai)
#pragma unroll
            for (int m = 0; m < 4; ++m) { const size_t row = (size_t)u.pm * 256 + ai * 128 + wr * 64 + m * 16 + fr;
#pragma unroll
                for (int bj = 0; bj < 2; ++bj) { const int col = u.pn * 256 + bj * 128 + wc * 32 + fq * 8;
                    *(u32x4*)(O + row * ldc + col) = pack8(acc[ai][bj][m][0], acc[ai][bj][m][1]); } }
    }
};

struct EpiIn {
    static constexpr bool PERM = true, AFTER_DRAIN = false;
    float* out; unsigned char* ws;
    __device__ __forceinline__ void operator()(const f32x4 (&acc)[2][2][4][2], const pg8::Unit& u, int wr, int wc, int fr, int fq) const {
        const int tile = u.pn;
        const float* ROPE = (const float*)(ws + WS_ROPE);
#pragma unroll
        for (int ai = 0; ai < 2; ++ai)
#pragma unroll
            for (int m = 0; m < 4; ++m) {
                const int row = u.pm * 256 + ai * 128 + wr * 64 + m * 16 + fr;
                const int pos = (row < TP) ? row : TP + ((row - TP) & 7);
#pragma unroll
                for (int bj = 0; bj < 2; ++bj) {
                    const int pc = bj * 128 + wc * 32 + fq * 8;
                    f32x4 v0 = acc[ai][bj][m][0], v1 = acc[ai][bj][m][1];
                    if (tile < 10) {
                        const int hh = pc >> 6, pp = pc & 63, j8 = pp >> 3;
                        const bool is_q = tile < 4; const int t = tile - 4, br = t >> 1, x = t & 1;
                        int d0, d1;
                        if (is_q || x == 0) {
                            const f32x4 cs = *(const f32x4*)(ROPE + (size_t)pos * 64 + 4 * j8), sn = *(const f32x4*)(ROPE + (size_t)pos * 64 + 32 + 4 * j8);
                            const f32x4 lo = v0 * cs - v1 * sn, hi = v1 * cs + v0 * sn; v0 = lo; v1 = hi; d0 = 4 * j8; d1 = 32 + 4 * j8;
                        } else { d0 = pp; d1 = pp + 4; }
                        if (is_q) {
                            bf16* q = (bf16*)(ws + WS_QB) + (size_t)row * 1024 + (tile * 4 + hh) * 64;
                            *(u32x2*)(q + d0) = pack4(v0 * QSCALE); *(u32x2*)(q + d1) = pack4(v1 * QSCALE);
                        } else {
                            const int co = x * 256 + hh * 64;
                            float* o = nullptr;
                            if (row < TP) {
                                if (br == 0) o = out + O_CMPP + (size_t)row * 512 + co;
                                else if (br == 1) o = out + O_SELP + (size_t)row * 512 + co;
                                else if (row >= TP - 512) o = out + O_WINP + (size_t)(row - (TP - 512)) * 512 + co;
                                bf16* kb = (br == 0) ? (bf16*)(ws + WS_CB) + (size_t)x * CB_X + ((size_t)(32 * 4 + hh) * 8192 + row) * 64
                                                     : (bf16*)(ws + WS_KVB) + ((size_t)(((br - 1) * 2 + x) * 4 + hh) * 8192 + row) * 64;
                                *(u32x2*)(kb + d0) = pack4(v0); *(u32x2*)(kb + d1) = pack4(v1);
                            } else {
                                const int sr = row - TP;
                                if (br == 0) o = out + O_CMPS + (size_t)sr * 512 + co;
                                else if (br == 1) o = out + O_SELS + (size_t)sr * 512 + co;
                                else o = out + O_WINS + ((size_t)(sr >> 3) * 512 + 504 + (sr & 7)) * 512 + co;
                            }
                            if (o) { *(f32x4*)(o + d0) = v0; *(f32x4*)(o + d1) = v1; }
                        }
                    } else if (tile < 14) {
                        const int col = (tile - 10) * 256 + pc;
                        v0 = (f32x4){silu(v0.x), silu(v0.y), silu(v0.z), silu(v0.w)}; v1 = (f32x4){silu(v1.x), silu(v1.y), silu(v1.z), silu(v1.w)};
                        *(u32x4*)((bf16*)(ws + WS_ZN) + (size_t)row * 1024 + col) = pack8(v0, v1);
                    } else if (tile < 16) {
                        *(u32x4*)((bf16*)(ws + WS_QG) + (size_t)row * 512 + (tile - 14) * 256 + pc) = pack8(v0 * GQSCALE, v1 * GQSCALE);
                    } else if (tile < 18) {
                        *(u32x4*)((bf16*)(ws + WS_KG) + (size_t)row * 512 + (tile - 16) * 256 + pc) = pack8(v0, v1);
                    } else if (tile < 22) {
                        const int col = (tile - 18) * 256 + pc;
                        if (row < TP) {
                            bf16* vt = (bf16*)(ws + WS_VGT) + ((size_t)(row >> 6) * 1024 + col) * 64 + (row & 63);
                            vt[0 * 64] = (bf16)f2bf(v0.x); vt[1 * 64] = (bf16)f2bf(v0.y); vt[2 * 64] = (bf16)f2bf(v0.z); vt[3 * 64] = (bf16)f2bf(v0.w);
                            vt[4 * 64] = (bf16)f2bf(v1.x); vt[5 * 64] = (bf16)f2bf(v1.y); vt[6 * 64] = (bf16)f2bf(v1.z); vt[7 * 64] = (bf16)f2bf(v1.w);
                        } else {
                            float* vs = (float*)(ws + WS_VGS) + (size_t)(row - TP) * 1024 + col;
                            *(f32x4*)vs = v0; *(f32x4*)(vs + 4) = v1;
                        }
                    } else if (tile < 26) {
                        const int col = (tile - 22) * 256 + pc;
                        v0 = (f32x4){silu(v0.x), silu(v0.y), silu(v0.z), silu(v0.w)}; v1 = (f32x4){silu(v1.x), silu(v1.y), silu(v1.z), silu(v1.w)};
                        *(u32x4*)((bf16*)(ws + WS_ZG) + (size_t)row * 1024 + col) = pack8(v0, v1);
                    } else if (tile < 42) {
                        const bool mn = tile < 34; const int col = (tile - (mn ? 26 : 34)) * 256 + pc;
                        v0 = (f32x4){sigm(v0.x), sigm(v0.y), sigm(v0.z), sigm(v0.w)}; v1 = (f32x4){sigm(v1.x), sigm(v1.y), sigm(v1.z), sigm(v1.w)};
                        *(u32x4*)((bf16*)(ws + (mn ? WS_MN : WS_MG)) + (size_t)row * 2048 + col) = pack8(v0, v1);
                    } else {
                        if (pc < 48) {
                            v0 = (f32x4){sigm(v0.x), sigm(v0.y), sigm(v0.z), sigm(v0.w)}; v1 = (f32x4){sigm(v1.x), sigm(v1.y), sigm(v1.z), sigm(v1.w)};
                            float* g = (float*)(ws + WS_GB) + (size_t)row * 48 + pc; *(f32x4*)g = v0; *(f32x4*)(g + 4) = v1;
                        } else if (pc < 64) {
                            float* a = (float*)(ws + WS_AG) + (size_t)row * 16 + (pc - 48); *(f32x4*)a = v0; *(f32x4*)(a + 4) = v1;
                        }
                    }
                }
            }
    }
};

template <bool SECOND> struct EpiMerge {
    static constexpr bool PERM = true, AFTER_DRAIN = false;
    const bf16* G; bf16* O;
    __device__ __forceinline__ void operator()(const f32x4 (&acc)[2][2][4][2], const pg8::Unit& u, int wr, int wc, int fr, int fq) const {
#pragma unroll
        for (int ai = 0; ai < 2; ++ai)
#pragma unroll
            for (int m = 0; m < 4; ++m) { const size_t row = (size_t)u.pm * 256 + ai * 128 + wr * 64 + m * 16 + fr;
#pragma unroll
                for (int bj = 0; bj < 2; ++bj) { const int col = u.pn * 256 + bj * 128 + wc * 32 + fq * 8;
                    const u32x4 g = *(const u32x4*)(G + row * 2048 + col);
                    f32x4 v0 = acc[ai][bj][m][0] * (f32x4){bflo(g.x), bfhi(g.x), bflo(g.y), bfhi(g.y)};
                    f32x4 v1 = acc[ai][bj][m][1] * (f32x4){bflo(g.z), bfhi(g.z), bflo(g.w), bfhi(g.w)};
                    if (SECOND) { const u32x4 p = *(const u32x4*)(O + row * 2048 + col);
                        v0 += (f32x4){bflo(p.x), bfhi(p.x), bflo(p.y), bfhi(p.y)}; v1 += (f32x4){bflo(p.z), bfhi(p.z), bflo(p.w), bfhi(p.w)}; }
                    *(u32x4*)(O + row * 2048 + col) = pack8(v0, v1); } }
    }
};
struct EpiOut {
    static constexpr bool PERM = true, AFTER_DRAIN = false;
    const float* x_p; const float* x_s; const float* MOD; float* out; float* RSS;
    __device__ __forceinline__ void operator()(const f32x4 (&acc)[2][2][4][2], const pg8::Unit& u, int wr, int wc, int fr, int fq) const {
#pragma unroll
        for (int ai = 0; ai < 2; ++ai)
#pragma unroll
            for (int m = 0; m < 4; ++m) { const int row = u.pm * 256 + ai * 128 + wr * 64 + m * 16 + fr;
                const float* xr = (row < TP) ? x_p + (size_t)row * DM : x_s + (size_t)(row - TP) * DM;
                const float* gr = MOD + (size_t)((row < TP) ? 0 : 1 + ((row - TP) >> 3)) * NMOD + 4096;
                float* yr = out + ((row < TP) ? O_YP + (size_t)row * DM : O_YS + (size_t)(row - TP) * DM);
                float ss = 0.f;
#pragma unroll
                for (int bj = 0; bj < 2; ++bj) { const int col = u.pn * 256 + bj * 128 + wc * 32 + fq * 8;
#pragma unroll
                    for (int n = 0; n < 2; ++n) { const f32x4 y = *(const f32x4*)(xr + col + 4 * n) + *(const f32x4*)(gr + col + 4 * n) * acc[ai][bj][m][n];
                        *(f32x4*)(yr + col + 4 * n) = y; ss += (y.x * y.x + y.y * y.y) + (y.z * y.z + y.w * y.w); } }
                ss += __shfl_xor(ss, 16); ss += __shfl_xor(ss, 32);
                if (fq == 0) RSS[(size_t)row * 32 + u.pn * 4 + wc] = ss; }
    }
};

__device__ __forceinline__ void compress_l2(Frame& F) {
    const int lane = F.lane, c32 = lane & 31, h = lane >> 5;
    const float* POSB = WSP(float, WS_POSB);
    for (int x = 0; x < 2; ++x) {
        const bf16* W2T = WSP(bf16, WS_POSB + 4096) + (size_t)x * 64 * 128;
        const bf16* PART = WSP(bf16, WS_PART) + (size_t)x * CROWS * 256;
        bf16* KC = WSP(bf16, WS_KC) + (size_t)x * CROWS * 64;
        bf16x8 bfr[2][8];
#pragma unroll
        for (int dt = 0; dt < 2; ++dt)
#pragma unroll
            for (int ks = 0; ks < 8; ++ks) bfr[dt][ks] = *(const bf16x8*)(W2T + (size_t)(32 * dt + c32) * 128 + 16 * ks + 8 * h);
        const float b2a = F.cmp_b2[x * 64 + c32], b2b = F.cmp_b2[x * 64 + 32 + c32];
        for (int it = F.gw; it < CROWS / 32; it += F.NGW) {
            const size_t row = (size_t)it * 32 + c32;
            f32x16 o0, o1;
#pragma unroll
            for (int r = 0; r < 16; ++r) { o0[r] = 0.f; o1[r] = 0.f; }
#pragma unroll
            for (int ks = 0; ks < 8; ++ks) {
                const int e0 = 16 * ks + 8 * h;
                const u32x4 p0 = *(const u32x4*)(PART + row * 256 + e0), p1 = *(const u32x4*)(PART + (row + 1) * 256 + 128 + e0);
                const f32x4 ba = *(const f32x4*)(POSB + x * 128 + e0), bb = *(const f32x4*)(POSB + x * 128 + e0 + 4);
                f32x4 a = (f32x4){bflo(p0.x) + bflo(p1.x), bfhi(p0.x) + bfhi(p1.x), bflo(p0.y) + bflo(p1.y), bfhi(p0.y) + bfhi(p1.y)} + ba;
                f32x4 b = (f32x4){bflo(p0.z) + bflo(p1.z), bfhi(p0.z) + bfhi(p1.z), bflo(p0.w) + bflo(p1.w), bfhi(p0.w) + bfhi(p1.w)} + bb;
                a = (f32x4){silu(a.x), silu(a.y), silu(a.z), silu(a.w)}; b = (f32x4){silu(b.x), silu(b.y), silu(b.z), silu(b.w)};
                const u32x4 hp = pack8(a, b); const bf16x8 hf = __builtin_bit_cast(bf16x8, hp);
                o0 = __builtin_amdgcn_mfma_f32_32x32x16_bf16(hf, bfr[0][ks], o0, 0, 0, 0);
                o1 = __builtin_amdgcn_mfma_f32_32x32x16_bf16(hf, bfr[1][ks], o1, 0, 0, 0);
            }
#pragma unroll
            for (int r = 0; r < 16; ++r) {
                const size_t orow = (size_t)it * 32 + (r & 3) + 8 * (r >> 2) + 4 * h;
                const bool dead = (orow & 511) == 511;
                KC[orow * 64 + c32] = dead ? (bf16)0 : (bf16)f2bf(o0[r] + b2a);
                KC[orow * 64 + 32 + c32] = dead ? (bf16)0 : (bf16)f2bf(o1[r] + b2b);
            }
        }
    }
}

__device__ __forceinline__ void final_norm(Frame& F) {
    const float* RSS = WSP(float, WS_RSS);
    for (int r = F.gw; r < MROWS; r += F.NGW) {
        float* yr = F.out + ((r < TP) ? O_YP + (size_t)r * DM : O_YS + (size_t)(r - TP) * DM);
        float ss = (F.lane < 32) ? RSS[(size_t)r * 32 + F.lane] : 0.f;
        const float rstd = 1.f / sqrtf(wave_sum(ss) * (1.f / DM) + 1e-6f);
#pragma unroll
        for (int j = 0; j < 8; ++j) { const int c = (j * 64 + F.lane) * 4;
            const f32x4 v = *(const f32x4*)(yr + c) * rstd * *(const f32x4*)(F.fnw + c); *(f32x4*)(yr + c) = v; }
    }
}

constexpr int KTLD = 72;
typedef short v4i16_t __attribute__((ext_vector_type(4)));
__device__ __forceinline__ s16x4 tr_read(const LAS bf16* p) { return __builtin_bit_cast(s16x4, __builtin_amdgcn_ds_read_tr16_b64_v4i16((LAS v4i16_t*)p)); }
__device__ __forceinline__ unsigned cvtpk(float lo, float hi) { unsigned r; asm("v_cvt_pk_bf16_f32 %0, %1, %2" : "=v"(r) : "v"(lo), "v"(hi)); return r; }

template <int NKT>
__device__ __forceinline__ void qk_scores(f32x16 (&s)[NKT], const LAS bf16* Kt, const bf16x8 (&qf)[4], int lane) {
    const int c = lane & 31, h = lane >> 5;
#pragma unroll
    for (int kt = 0; kt < NKT; ++kt) {
#pragma unroll
        for (int r = 0; r < 16; ++r) s[kt][r] = 0.f;
#pragma unroll
        for (int ks = 0; ks < 4; ++ks) {
            const bf16x8 a = *(const LAS bf16x8*)(Kt + (32 * kt + c) * KTLD + 16 * ks + 8 * h);
            s[kt] = __builtin_amdgcn_mfma_f32_32x32x16_bf16(a, qf[ks], s[kt], 0, 0, 0);
        }
    }
}
template <int NKT>
__device__ __forceinline__ void pv_accum(f32x16 (&o)[2], const f32x16 (&p)[NKT], const LAS bf16* Vt, int lane) {
    const int i16 = lane & 15, g16 = lane >> 4, h = lane >> 5;
    const LAS bf16* vb = Vt + (4 * h + (i16 >> 2)) * KTLD + 16 * (g16 & 1) + 4 * (i16 & 3);
#pragma unroll
    for (int kt = 0; kt < NKT; ++kt)
#pragma unroll
        for (int s2 = 0; s2 < 2; ++s2) {
            u32x4 pw; pw.x = cvtpk(p[kt][8 * s2 + 0], p[kt][8 * s2 + 1]); pw.y = cvtpk(p[kt][8 * s2 + 2], p[kt][8 * s2 + 3]);
            pw.z = cvtpk(p[kt][8 * s2 + 4], p[kt][8 * s2 + 5]); pw.w = cvtpk(p[kt][8 * s2 + 6], p[kt][8 * s2 + 7]);
            const bf16x8 pf = __builtin_bit_cast(bf16x8, pw);
#pragma unroll
            for (int dt = 0; dt < 2; ++dt) {
                const s16x4 lo = tr_read(vb + (32 * kt + 16 * s2) * KTLD + 32 * dt), hi = tr_read(vb + (32 * kt + 16 * s2 + 8) * KTLD + 32 * dt);
                const bf16x8 vf = (bf16x8){lo[0], lo[1], lo[2], lo[3], hi[0], hi[1], hi[2], hi[3]};
                o[dt] = __builtin_amdgcn_mfma_f32_32x32x16_bf16(vf, pf, o[dt], 0, 0, 0);
            }
            __builtin_amdgcn_sched_barrier(0);
        }
}
template <int NKT>
__device__ __forceinline__ float mask_max(f32x16 (&s)[NKT], int lo, int hi, int h) {
    const int lo2 = lo - 4 * h, hi2 = hi - 4 * h; float mx = -1e30f;
#pragma unroll
    for (int kt = 0; kt < NKT; ++kt)
#pragma unroll
        for (int r = 0; r < 16; ++r) { const int ko = 32 * kt + (r & 3) + 8 * (r >> 2); const bool v = (ko >= lo2) && (ko <= hi2);
            const float x = v ? s[kt][r] : -1e30f; s[kt][r] = x; mx = fmaxf(mx, x); }
    return fmaxf(mx, __shfl_xor(mx, 32));
}
struct FlashSt { float m, l; f32x16 o[2]; };
__device__ __forceinline__ void flash_init(FlashSt& st) { st.m = -1e30f; st.l = 0.f;
#pragma unroll
    for (int r = 0; r < 16; ++r) { st.o[0][r] = 0.f; st.o[1][r] = 0.f; } }
template <int NKT>
__device__ __forceinline__ void flash_tile(FlashSt& st, const LAS bf16* Kt, const LAS bf16* Vt, const bf16x8 (&qf)[4], int lo, int hi, int lane) {
    f32x16 s[NKT];
    qk_scores<NKT>(s, Kt, qf, lane);
    const float mx = mask_max<NKT>(s, lo, hi, lane >> 5);
    const float mn = fmaxf(st.m, mx), alpha = ex2(st.m - mn); st.m = mn;
    float ps = 0.f;
#pragma unroll
    for (int kt = 0; kt < NKT; ++kt)
#pragma unroll
        for (int r = 0; r < 16; ++r) { const float x = s[kt][r]; const float p = (x > -1e29f) ? ex2(x - mn) : 0.f; s[kt][r] = p; ps += p; }
    st.l = st.l * alpha + ps;
#pragma unroll
    for (int r = 0; r < 16; ++r) { st.o[0][r] *= alpha; st.o[1][r] *= alpha; }
    pv_accum<NKT>(st.o, s, Vt, lane);
}
template <int NKT>
__device__ __forceinline__ void stats_tile(float& m, float& l, const LAS bf16* Kt, const bf16x8 (&qf)[4], int lo, int hi, int lane) {
    f32x16 s[NKT];
    qk_scores<NKT>(s, Kt, qf, lane);
    const float mx = mask_max<NKT>(s, lo, hi, lane >> 5);
    const float mn = fmaxf(m, mx), alpha = ex2(m - mn); m = mn;
    float ps = 0.f;
#pragma unroll
    for (int kt = 0; kt < NKT; ++kt)
#pragma unroll
        for (int r = 0; r < 16; ++r) { const float x = s[kt][r]; ps += (x > -1e29f) ? ex2(x - mn) : 0.f; }
    l = l * alpha + ps;
}
template <int NKT>
__device__ __forceinline__ void cmp2_tile(f32x16 (&o)[2], const LAS bf16* Kt, const LAS bf16* Vt, const bf16x8 (&qf)[4], int lo, int hi, float M, float invL,
                                          LAS float* impA, LAS float* impB, int q, int impld, int n_base, int lane) {
    f32x16 s[NKT];
    qk_scores<NKT>(s, Kt, qf, lane);
    (void)mask_max<NKT>(s, lo, hi, lane >> 5);
#pragma unroll
    for (int kt = 0; kt < NKT; ++kt)
#pragma unroll
        for (int r = 0; r < 16; ++r) { const float x = s[kt][r]; s[kt][r] = (x > -1e29f) ? ex2(x - M) * invL : 0.f; }
    const int h = lane >> 5;
#pragma unroll
    for (int kt = 0; kt < NKT; ++kt)
#pragma unroll
        for (int k4 = 0; k4 < 4; ++k4) {
            float s4 = (s[kt][4 * k4] + s[kt][4 * k4 + 1]) + (s[kt][4 * k4 + 2] + s[kt][4 * k4 + 3]), p3 = s[kt][4 * k4 + 3];
            s4 += __shfl_xor(s4, 8); s4 += __shfl_xor(s4, 16); p3 += __shfl_xor(p3, 8); p3 += __shfl_xor(p3, 16);
            if ((lane & 24) == 0) { const int n0 = n_base + 8 * kt + 2 * k4 + h; impA[q * impld + n0] = s4; impB[q * impld + n0 + 1] = p3; }
        }
    pv_accum<NKT>(o, s, Vt, lane);
}

constexpr int IMPLD = 130;
__device__ __forceinline__ void nsa_prompt_unit(Frame& F, int qt, int kvh) {
    const int tid = F.tid, lane = F.lane, w = F.wave, c = lane & 31, h = lane >> 5, qi = c & 7, g = c >> 3;
    LAS bf16* Kt0 = (LAS bf16*)(F.lds);
    LAS bf16* Vt0 = (LAS bf16*)(F.lds + 18432);
    LAS float* impA = (LAS float*)(F.lds + 36864);
    LAS float* impB = (LAS float*)(F.lds + 36864 + 33280);
    LAS unsigned* selb = (LAS unsigned*)(F.lds + 36864 + 66560);
    const int q_off = 8 * w + qi, token = 64 * qt + q_off, head = kvh * 4 + g;
    const bf16* QB = WSP(bf16, WS_QB);
    bf16x8 qf[4];
#pragma unroll
    for (int ks = 0; ks < 4; ++ks) qf[ks] = *(const bf16x8*)(QB + (size_t)token * 1024 + head * 64 + 16 * ks + 8 * h);
    const float* gbp = WSP(float, WS_GB) + (size_t)token * 48 + head * 3;
    const float gb_c = gbp[0], gb_s = gbp[1], gb_w = gbp[2];
    f32x16 oacc[2];
#pragma unroll
    for (int r = 0; r < 16; ++r) { oacc[0][r] = 0.f; oacc[1][r] = 0.f; }
    const int srow = tid >> 3, sch = tid & 7;
    const int lds_st = srow * KTLD + sch * 8;

    {
        const bf16* KCk = WSP(bf16, WS_KC) + ((size_t)(32 * 4 + kvh) * 512) * 64;
        const bf16* KCv = WSP(bf16, WS_KC) + (size_t)CROWS * 64 + ((size_t)(32 * 4 + kvh) * 512) * 64;
        int cmax = (token - 31) >> 4; if (cmax > 510) cmax = 510;
        const int nT = ((4 * qt + 2) >> 6) + 1;
        float m = -1e30f, l = 0.f;
        u32x4 kreg = *(const u32x4*)(KCk + (size_t)srow * 64 + sch * 8), vreg;
        for (int t = 0; t < nT; ++t) {
            LAS bf16* Kt = Kt0 + (t & 1) * 64 * KTLD;
            *(LAS u32x4*)(Kt + lds_st) = kreg;
            __syncthreads();
            if (t + 1 < nT) kreg = *(const u32x4*)(KCk + (size_t)((t + 1) * 64 + srow) * 64 + sch * 8);
            int hi = cmax - 64 * t; if (hi > 63) hi = 63;
            stats_tile<2>(m, l, Kt, qf, 0, hi, lane);
        }
        l += __shfl_xor(l, 32);
        const float invL = (l > 0.f) ? 1.f / l : 0.f;
        __syncthreads();
        kreg = *(const u32x4*)(KCk + (size_t)srow * 64 + sch * 8); vreg = *(const u32x4*)(KCv + (size_t)srow * 64 + sch * 8);
        f32x16 o[2];
#pragma unroll
        for (int r = 0; r < 16; ++r) { o[0][r] = 0.f; o[1][r] = 0.f; }
        for (int t = 0; t < nT; ++t) {
            LAS bf16* Kt = Kt0 + (t & 1) * 64 * KTLD; LAS bf16* Vt = Vt0 + (t & 1) * 64 * KTLD;
            *(LAS u32x4*)(Kt + lds_st) = kreg; *(LAS u32x4*)(Vt + lds_st) = vreg;
            __syncthreads();
            if (t + 1 < nT) { kreg = *(const u32x4*)(KCk + (size_t)((t + 1) * 64 + srow) * 64 + sch * 8); vreg = *(const u32x4*)(KCv + (size_t)((t + 1) * 64 + srow) * 64 + sch * 8); }
            int hi = cmax - 64 * t; if (hi > 63) hi = 63;
            cmp2_tile<2>(o, Kt, Vt, qf, 0, hi, m, invL, impA, impB, q_off, IMPLD, 16 * t, lane);
        }
#pragma unroll
        for (int r = 0; r < 16; ++r) { oacc[0][r] += gb_c * o[0][r]; oacc[1][r] += gb_c * o[1][r]; }
    }
    __syncthreads();
    if (tid < 256) selb[tid] = 0u;
    __syncthreads();
    if (qt <= 15) {
        if (tid < 64) selb[tid * 4] = (1u << (qt + 1)) - 1u;
    } else {
        const int q = tid >> 3, sub = tid & 7, nhi = qt - 2;
#pragma unroll 1
        for (int i = 0; i < 16; ++i) { const int n = sub + 8 * i; if (n >= 1 && n <= nhi) impA[q * IMPLD + n] += impB[q * IMPLD + n]; }
        __syncthreads();
#pragma unroll 1
        for (int i = 0; i < 16; ++i) {
            const int n = sub + 8 * i; bool sel;
            if (n >= 1 && n <= nhi) {
                const float v = impA[q * IMPLD + n]; int rank = 0;
#pragma unroll 4
                for (int mm = 1; mm <= nhi; ++mm) { const float vm = impA[q * IMPLD + mm]; rank += (vm > v || (vm == v && mm < n)) ? 1 : 0; }
                sel = rank < 13;
            } else sel = (n == 0 || n == qt || n == qt - 1);
            if (sel) atomicOr((unsigned*)&selb[q * 4 + (n >> 5)], 1u << (n & 31));
        }
    }
    __syncthreads();
    {
        const bf16* Kg = WSP(bf16, WS_KVB) + ((size_t)((0 * 2 + 0) * 4 + kvh) * 8192) * 64;
        const bf16* Vg = WSP(bf16, WS_KVB) + ((size_t)((0 * 2 + 1) * 4 + kvh) * 8192) * 64;
        const unsigned sw0 = selb[q_off * 4 + 0], sw1 = selb[q_off * 4 + 1], sw2 = selb[q_off * 4 + 2], sw3 = selb[q_off * 4 + 3];
        FlashSt st; flash_init(st);
        u32x4 kreg = *(const u32x4*)(Kg + (size_t)srow * 64 + sch * 8), vreg = *(const u32x4*)(Vg + (size_t)srow * 64 + sch * 8);
        for (int blk = 0; blk <= qt; ++blk) {
            LAS bf16* Kt = Kt0 + (blk & 1) * 64 * KTLD; LAS bf16* Vt = Vt0 + (blk & 1) * 64 * KTLD;
            *(LAS u32x4*)(Kt + lds_st) = kreg; *(LAS u32x4*)(Vt + lds_st) = vreg;
            __syncthreads();
            if (blk < qt) { kreg = *(const u32x4*)(Kg + (size_t)((blk + 1) * 64 + srow) * 64 + sch * 8); vreg = *(const u32x4*)(Vg + (size_t)((blk + 1) * 64 + srow) * 64 + sch * 8); }
            const unsigned swd = (blk < 32) ? sw0 : (blk < 64) ? sw1 : (blk < 96) ? sw2 : sw3;
            const bool sq = (swd >> (blk & 31)) & 1u;
            const int lo = sq ? 0 : 1, hi = sq ? ((blk == qt) ? q_off : 63) : 0;
            flash_tile<2>(st, Kt, Vt, qf, lo, hi, lane);
        }
        const float lt = st.l + __shfl_xor(st.l, 32); const float sc = (lt > 0.f) ? gb_s / lt : 0.f;
#pragma unroll
        for (int r = 0; r < 16; ++r) { oacc[0][r] += sc * st.o[0][r]; oacc[1][r] += sc * st.o[1][r]; }
    }
    __syncthreads();
    {
        const bf16* Kg = WSP(bf16, WS_KVB) + ((size_t)((1 * 2 + 0) * 4 + kvh) * 8192) * 64;
        const bf16* Vg = WSP(bf16, WS_KVB) + ((size_t)((1 * 2 + 1) * 4 + kvh) * 8192) * 64;
        const int b0 = (qt >= 8) ? qt - 8 : 0;
        FlashSt st; flash_init(st);
        u32x4 kreg = *(const u32x4*)(Kg + (size_t)(b0 * 64 + srow) * 64 + sch * 8), vreg = *(const u32x4*)(Vg + (size_t)(b0 * 64 + srow) * 64 + sch * 8);
        for (int blk = b0; blk <= qt; ++blk) {
            LAS bf16* Kt = Kt0 + (blk & 1) * 64 * KTLD; LAS bf16* Vt = Vt0 + (blk & 1) * 64 * KTLD;
            *(LAS u32x4*)(Kt + lds_st) = kreg; *(LAS u32x4*)(Vt + lds_st) = vreg;
            __syncthreads();
            if (blk < qt) { kreg = *(const u32x4*)(Kg + (size_t)((blk + 1) * 64 + srow) * 64 + sch * 8); vreg = *(const u32x4*)(Vg + (size_t)((blk + 1) * 64 + srow) * 64 + sch * 8); }
            const int lo = (blk == qt - 8) ? q_off + 1 : 0, hi = (blk == qt) ? q_off : 63;
            flash_tile<2>(st, Kt, Vt, qf, lo, hi, lane);
        }
        const float lt = st.l + __shfl_xor(st.l, 32); const float sc = (lt > 0.f) ? gb_w / lt : 0.f;
#pragma unroll
        for (int r = 0; r < 16; ++r) { oacc[0][r] += sc * st.o[0][r]; oacc[1][r] += sc * st.o[1][r]; }
    }
    __syncthreads();
    {
        const bf16* zn = WSP(bf16, WS_ZN) + (size_t)token * 1024 + head * 64;
        bf16* on = WSP(bf16, WS_ONSA) + (size_t)token * 1024 + head * 64;
#pragma unroll
        for (int dt = 0; dt < 2; ++dt)
#pragma unroll
            for (int k4 = 0; k4 < 4; ++k4) { const int d = 32 * dt + 8 * k4 + 4 * h;
                const u32x2 z = *(const u32x2*)(zn + d);
                const f32x4 v = (f32x4){oacc[dt][4 * k4] * bflo(z.x), oacc[dt][4 * k4 + 1] * bfhi(z.x), oacc[dt][4 * k4 + 2] * bflo(z.y), oacc[dt][4 * k4 + 3] * bfhi(z.y)};
                *(u32x2*)(on + d) = pack4(v); }
    }
}

__device__ __forceinline__ void stage_half_f32(LAS bf16* dst, const float* base, int nvalid, int lane) {
    const int row = lane >> 1, hf = lane & 1;
    const float* s = base + (size_t)row * 512 + hf * 32;
#pragma unroll
    for (int i = 0; i < 4; ++i) {
        u32x4 o = (u32x4){0u, 0u, 0u, 0u};
        if (row < nvalid) { const f32x4 a = *(const f32x4*)(s + 8 * i), b2 = *(const f32x4*)(s + 8 * i + 4); o = pack8(a, b2); }
        *(LAS u32x4*)(dst + row * KTLD + hf * 32 + 8 * i) = o;
    }
}
__device__ __forceinline__ void stage_half_bf16(LAS bf16* dst, const bf16* base, int lane) {
    const int row = lane >> 1, hf = lane & 1;
#pragma unroll
    for (int i = 0; i < 4; ++i) *(LAS u32x4*)(dst + row * KTLD + hf * 32 + 8 * i) = *(const u32x4*)(base + (size_t)row * 64 + hf * 32 + 8 * i);
}
__device__ __forceinline__ void merge_partials(const LAS float* mlb, const LAS float* comb, int lane, f32x16 (&o)[2], float& L) {
    const int c = lane & 31;
    float M = -1e30f;
#pragma unroll
    for (int ww = 0; ww < 8; ++ww) M = fmaxf(M, mlb[(ww * 64 + lane) * 2]);
    L = 0.f;
#pragma unroll
    for (int r = 0; r < 16; ++r) { o[0][r] = 0.f; o[1][r] = 0.f; }
#pragma unroll 1
    for (int ww = 0; ww < 8; ++ww) {
        const float f = ex2(mlb[(ww * 64 + lane) * 2] - M);
        L += (mlb[(ww * 64 + c) * 2 + 1] + mlb[(ww * 64 + c + 32) * 2 + 1]) * f;
#pragma unroll
        for (int r = 0; r < 16; ++r) { o[0][r] += comb[(ww * 32 + r) * 64 + lane] * f; o[1][r] += comb[(ww * 32 + 16 + r) * 64 + lane] * f; }
    }
}
__device__ __forceinline__ void nsa_sample_unit(Frame& F, int b, int kvh) {
    const int tid = F.tid, lane = F.lane, w = F.wave, c = lane & 31, h = lane >> 5, qi = c & 7, g = c >> 3;
    LAS bf16* Kw = (LAS bf16*)(F.lds + w * 9216); LAS bf16* Vw = Kw + 32 * KTLD;
    LAS float* comb = (LAS float*)F.lds;
    LAS float* mlb = (LAS float*)(F.lds + 65536);
    LAS float* impA = (LAS float*)(F.lds + 73728);
    LAS float* impB = impA + 8 * IMPLD;
    LAS unsigned* selb = (LAS unsigned*)(impB + 8 * IMPLD);
    const int token = TP + 8 * b + qi, head = kvh * 4 + g;
    const bf16* QB = WSP(bf16, WS_QB);
    bf16x8 qf[4];
#pragma unroll
    for (int ks = 0; ks < 4; ++ks) qf[ks] = *(const bf16x8*)(QB + (size_t)token * 1024 + head * 64 + 16 * ks + 8 * h);
    const float* gbp = WSP(float, WS_GB) + (size_t)token * 48 + head * 3;
    const float gb_c = gbp[0], gb_s = gbp[1], gb_w = gbp[2];
    f32x16 oacc[2];
#pragma unroll
    for (int r = 0; r < 16; ++r) { oacc[0][r] = 0.f; oacc[1][r] = 0.f; }
    __syncthreads();
    {
        const bf16* KCk = WSP(bf16, WS_KC) + ((size_t)(b * 4 + kvh) * 512) * 64;
        const bf16* KCv = KCk + (size_t)CROWS * 64;
        float m = -1e30f, l = 0.f;
        for (int ti = w; ti < 16; ti += 8) {
            stage_half_bf16(Kw, KCk + (size_t)ti * 32 * 64, lane);
            int hi = 510 - 32 * ti; if (hi > 31) hi = 31;
            stats_tile<1>(m, l, Kw, qf, 0, hi, lane);
        }
        __syncthreads();
        mlb[(w * 64 + lane) * 2] = m; mlb[(w * 64 + lane) * 2 + 1] = l;
        __syncthreads();
        float M = -1e30f;
#pragma unroll
        for (int ww = 0; ww < 8; ++ww) M = fmaxf(M, mlb[(ww * 64 + lane) * 2]);
        float L = 0.f;
#pragma unroll
        for (int ww = 0; ww < 8; ++ww) L += (mlb[(ww * 64 + c) * 2 + 1] + mlb[(ww * 64 + c + 32) * 2 + 1]) * ex2(mlb[(ww * 64 + lane) * 2] - M);
        const float invL = (L > 0.f) ? 1.f / L : 0.f;
        __syncthreads();
        f32x16 o[2];
#pragma unroll
        for (int r = 0; r < 16; ++r) { o[0][r] = 0.f; o[1][r] = 0.f; }
        for (int ti = w; ti < 16; ti += 8) {
            stage_half_bf16(Kw, KCk + (size_t)ti * 32 * 64, lane); stage_half_bf16(Vw, KCv + (size_t)ti * 32 * 64, lane);
            int hi = 510 - 32 * ti; if (hi > 31) hi = 31;
            cmp2_tile<1>(o, Kw, Vw, qf, 0, hi, M, invL, impA, impB, qi, IMPLD, 8 * ti, lane);
        }
        __syncthreads();
#pragma unroll
        for (int r = 0; r < 16; ++r) { comb[(w * 32 + r) * 64 + lane] = o[0][r]; comb[(w * 32 + 16 + r) * 64 + lane] = o[1][r]; }
        __syncthreads();
        if (w == 0) {
#pragma unroll 1
            for (int ww = 0; ww < 8; ++ww)
#pragma unroll
                for (int r = 0; r < 16; ++r) { oacc[0][r] += gb_c * comb[(ww * 32 + r) * 64 + lane]; oacc[1][r] += gb_c * comb[(ww * 32 + 16 + r) * 64 + lane]; }
        }
    }
    __syncthreads();
    if (tid < 64) selb[tid] = 0u;
    {
        const int q = w;
#pragma unroll 1
        for (int i = 0; i < 2; ++i) { const int n = lane + 64 * i; if (n >= 1 && n <= 126) impA[q * IMPLD + n] += impB[q * IMPLD + n]; }
        __syncthreads();
#pragma unroll 1
        for (int i = 0; i < 2; ++i) {
            const int n = lane + 64 * i; bool sel = true;
            if (n >= 1 && n <= 126) {
                const float v = impA[q * IMPLD + n]; int rank = 0;
#pragma unroll 4
                for (int mm = 1; mm <= 126; ++mm) { const float vm = impA[q * IMPLD + mm]; rank += (vm > v || (vm == v && mm < n)) ? 1 : 0; }
                sel = rank < 13;
            }
            if (sel) atomicOr((unsigned*)&selb[q * 8 + (n >> 5)], 1u << (n & 31));
        }
        if (lane == 0) atomicOr((unsigned*)&selb[q * 8 + 4], 1u);
    }
    __syncthreads();
    {
        FlashSt st; flash_init(st);
        int cnt = 0;
        for (int blk = 0; blk <= 128; ++blk) {
            unsigned uw = 0u;
#pragma unroll
            for (int q = 0; q < 8; ++q) uw |= selb[q * 8 + (blk >> 5)];
            uw = __builtin_amdgcn_readfirstlane(uw);
            if (!((uw >> (blk & 31)) & 1u)) continue;
            const int nh = (blk == 128) ? 1 : 2;
            for (int hf = 0; hf < nh; ++hf) {
                if (((cnt++) & 7) != w) continue;
                const float* base; int nvalid;
                if (blk < 128) { const int page = F.ptab[b * NPAGE + (blk >> 1)]; base = F.c_sel + ((size_t)page * 128 + (blk & 1) * 64 + hf * 32) * 512 + kvh * 64; nvalid = 32; }
                else { base = F.out + O_SELS + (size_t)(b * 8) * 512 + kvh * 64; nvalid = 8; }
                stage_half_f32(Kw, base, nvalid, lane); stage_half_f32(Vw, base + 256, nvalid, lane);
                const bool sq = (selb[qi * 8 + (blk >> 5)] >> (blk & 31)) & 1u;
                const int lo = sq ? 0 : 1, hi = sq ? ((blk == 128) ? qi : 31) : 0;
                flash_tile<1>(st, Kw, Vw, qf, lo, hi, lane);
            }
        }
        __syncthreads();
        mlb[(w * 64 + lane) * 2] = st.m; mlb[(w * 64 + lane) * 2 + 1] = st.l;
#pragma unroll
        for (int r = 0; r < 16; ++r) { comb[(w * 32 + r) * 64 + lane] = st.o[0][r]; comb[(w * 32 + 16 + r) * 64 + lane] = st.o[1][r]; }
        __syncthreads();
        if (w == 0) { f32x16 o[2]; float L; merge_partials(mlb, comb, lane, o, L); const float sc = (L > 0.f) ? gb_s / L : 0.f;
#pragma unroll
            for (int r = 0; r < 16; ++r) { oacc[0][r] += sc * o[0][r]; oacc[1][r] += sc * o[1][r]; } }
    }
    __syncthreads();
    {
        FlashSt st; flash_init(st);
        for (int ti = w; ti < 17; ti += 8) {
            const float* base; int nvalid;
            if (ti < 16) { base = F.c_win + ((size_t)b * 512 + 32 * ti) * 512 + kvh * 64; nvalid = 32; }
            else { base = F.out + O_WINS + ((size_t)b * 512 + 504) * 512 + kvh * 64; nvalid = 8; }
            stage_half_f32(Kw, base, nvalid, lane); stage_half_f32(Vw, base + 256, nvalid, lane);
            const int lo = (ti == 0) ? 1 + qi : 0, hi = (ti == 16) ? qi : 31;
            flash_tile<1>(st, Kw, Vw, qf, lo, hi, lane);
        }
        __syncthreads();
        mlb[(w * 64 + lane) * 2] = st.m; mlb[(w * 64 + lane) * 2 + 1] = st.l;
#pragma unroll
        for (int r = 0; r < 16; ++r) { comb[(w * 32 + r) * 64 + lane] = st.o[0][r]; comb[(w * 32 + 16 + r) * 64 + lane] = st.o[1][r]; }
        __syncthreads();
        if (w == 0) { f32x16 o[2]; float L; merge_partials(mlb, comb, lane, o, L); const float sc = (L > 0.f) ? gb_w / L : 0.f;
#pragma unroll
            for (int r = 0; r < 16; ++r) { oacc[0][r] += sc * o[0][r]; oacc[1][r] += sc * o[1][r]; } }
    }
    if (w == 0) {
        const bf16* zn = WSP(bf16, WS_ZN) + (size_t)token * 1024 + head * 64;
        bf16* on = WSP(bf16, WS_ONSA) + (size_t)token * 1024 + head * 64;
#pragma unroll
        for (int dt = 0; dt < 2; ++dt)
#pragma unroll
            for (int k4 = 0; k4 < 4; ++k4) { const int d = 32 * dt + 8 * k4 + 4 * h;
                const u32x2 z = *(const u32x2*)(zn + d);
                const f32x4 v = (f32x4){oacc[dt][4 * k4] * bflo(z.x), oacc[dt][4 * k4 + 1] * bfhi(z.x), oacc[dt][4 * k4 + 2] * bflo(z.y), oacc[dt][4 * k4 + 3] * bfhi(z.y)};
                *(u32x2*)(on + d) = pack4(v); }
    }
    __syncthreads();
}

__device__ __forceinline__ float log_sigmoid(float z) { return (z < 0.f) ? z - log1pf(__expf(z)) : -log1pf(__expf(-z)); }
__device__ __forceinline__ void gla_cum(Frame& F, int ch, int hd, LAS float* cum, LAS float* qs, LAS float* agt) {
    const int tid = F.tid, k = tid & 127, tq = tid >> 7;
    const float* AG = WSP(float, WS_AG) + (size_t)(64 * ch) * 16;
    for (int i = tid; i < 64 * 16; i += 512) agt[i] = AG[i];
    float wv[16];
#pragma unroll
    for (int r = 0; r < 16; ++r) wv[r] = F.w_a2[r * 512 + hd * 128 + k];
    const float bias = F.b_a[hd * 128 + k];
    __syncthreads();
    float run = 0.f;
    for (int tt = 0; tt < 16; ++tt) {
        const int t = 16 * tq + tt; float z = bias;
#pragma unroll
        for (int r = 0; r < 16; ++r) z += agt[t * 16 + r] * wv[r];
        run += log_sigmoid(z) * (1.f / 16.f); cum[t * 128 + k] = run;
    }
    qs[tq * 128 + k] = run;
    __syncthreads();
    float off = 0.f;
    for (int j = 0; j < tq; ++j) off += qs[j * 128 + k];
    if (tq > 0) for (int tt = 0; tt < 16; ++tt) cum[(16 * tq + tt) * 128 + k] += off;
    __syncthreads();
}
__device__ __forceinline__ void gla_pass1_unit(Frame& F, int ch, int hd) {
    LAS float* cum = (LAS float*)F.lds; LAS float* qs = cum + 64 * 128; LAS float* agt = qs + 512;
    LAS bf16* KhT = (LAS bf16*)(F.lds + 40960);
    gla_cum(F, ch, hd, cum, qs, agt);
    const int tid = F.tid, k = tid & 127, tq = tid >> 7, lane = F.lane, c = lane & 31, h = lane >> 5, w = F.wave;
    const float cl = cum[63 * 128 + k];
    const bf16* KG = WSP(bf16, WS_KG) + (size_t)(64 * ch) * 512 + hd * 128 + k;
    unsigned pk[8];
#pragma unroll
    for (int j = 0; j < 8; ++j) { const int s = 16 * tq + 2 * j;
        const float v0 = bf2f(KG[(size_t)s * 512]) * __expf(cl - cum[s * 128 + k]), v1 = bf2f(KG[(size_t)(s + 1) * 512]) * __expf(cl - cum[(s + 1) * 128 + k]);
        pk[j] = pk2(v0, v1); }
    *(LAS u32x4*)(KhT + k * 72 + 16 * tq) = (u32x4){pk[0], pk[1], pk[2], pk[3]};
    *(LAS u32x4*)(KhT + k * 72 + 16 * tq + 8) = (u32x4){pk[4], pk[5], pk[6], pk[7]};
    if (tq == 0) WSP(float, WS_DC)[(ch * 4 + hd) * 128 + k] = __expf(cl);
    __syncthreads();
    const bf16* VGT = WSP(bf16, WS_VGT) + ((size_t)ch * 1024 + hd * 256 + 32 * w + c) * 64;
    bf16x8 af[4];
#pragma unroll
    for (int ss = 0; ss < 4; ++ss) af[ss] = *(const bf16x8*)(VGT + 16 * ss + 8 * h);
    float* LT = WSP(float, WS_LT) + ((size_t)(ch * 4 + hd) * 256 + 32 * w) * 128;
#pragma unroll
    for (int kt = 0; kt < 4; ++kt) {
        f32x16 acc;
#pragma unroll
        for (int r = 0; r < 16; ++r) acc[r] = 0.f;
#pragma unroll
        for (int ss = 0; ss < 4; ++ss) { const bf16x8 bv = *(const LAS bf16x8*)(KhT + (32 * kt + c) * 72 + 16 * ss + 8 * h); acc = __builtin_amdgcn_mfma_f32_32x32x16_bf16(af[ss], bv, acc, 0, 0, 0); }
#pragma unroll
        for (int r = 0; r < 16; ++r) LT[(size_t)((r & 3) + 8 * (r >> 2) + 4 * h) * 128 + 32 * kt + c] = acc[r];
    }
    __syncthreads();
}
__device__ __forceinline__ void gla_pass2(Frame& F) {
    const float* __restrict__ LT = WSP(float, WS_LT); const float* __restrict__ DC = WSP(float, WS_DC); bf16* __restrict__ ST = WSP(bf16, WS_ST);
    for (int e = blockIdx.x * 512 + F.tid; e < 4 * 256 * 128; e += F.G * 512) {
        const int k = e & 127, v = (e >> 7) & 255, hd = e >> 15;
        float S = 0.f;
#pragma unroll 8
        for (int cc = 0; cc < 128; ++cc) { const size_t idx = ((size_t)(cc * 4 + hd) * 256 + v) * 128 + k; ST[idx] = (bf16)f2bf(S); S = DC[(cc * 4 + hd) * 128 + k] * S + LT[idx]; }
        F.out[O_STP + ((size_t)hd * 128 + k) * 256 + v] = S;
    }
}
__device__ __forceinline__ void gla_pass3_unit(Frame& F, int ch, int hd) {
    LAS float* cum = (LAS float*)F.lds; LAS float* qs = cum + 64 * 128; LAS float* agt = qs + 512;
    LAS bf16* Qt = (LAS bf16*)(F.lds + 40960);
    LAS bf16* Kt2 = Qt + 64 * 136;
    LAS bf16* Att = Kt2 + 64 * 136;
    LAS float* red = (LAS float*)(F.lds + 84992);
    LAS float* rstdv = red + 512;
    gla_cum(F, ch, hd, cum, qs, agt);
    const int tid = F.tid, k = tid & 127, tq = tid >> 7, lane = F.lane, c = lane & 31, h = lane >> 5, w = F.wave;
    {
        const bf16* QG = WSP(bf16, WS_QG) + (size_t)(64 * ch) * 512 + hd * 128 + k;
        const bf16* KG = WSP(bf16, WS_KG) + (size_t)(64 * ch) * 512 + hd * 128 + k;
        for (int tt = 0; tt < 16; ++tt) { const int t = 16 * tq + tt; const float cu = cum[t * 128 + k];
            Qt[t * 136 + k] = (bf16)f2bf(bf2f(QG[(size_t)t * 512]) * __expf(cu)); Kt2[t * 136 + k] = (bf16)f2bf(bf2f(KG[(size_t)t * 512]) * __expf(-cu)); }
    }
    __syncthreads();
    if (w < 3) {
        const int tt = (w + 1) >> 1, st = w >> 1;
        f32x16 acc;
#pragma unroll
        for (int r = 0; r < 16; ++r) acc[r] = 0.f;
#pragma unroll
        for (int ks = 0; ks < 8; ++ks) { const bf16x8 a = *(const LAS bf16x8*)(Qt + (32 * tt + c) * 136 + 16 * ks + 8 * h), bv = *(const LAS bf16x8*)(Kt2 + (32 * st + c) * 136 + 16 * ks + 8 * h);
            acc = __builtin_amdgcn_mfma_f32_32x32x16_bf16(a, bv, acc, 0, 0, 0); }
#pragma unroll
        for (int r = 0; r < 16; ++r) { const int t = 32 * tt + (r & 3) + 8 * (r >> 2) + 4 * h, s = 32 * st + c; Att[t * 72 + s] = (s <= t) ? (bf16)f2bf(acc[r]) : (bf16)0; }
    } else if (w == 3) {
#pragma unroll
        for (int r = 0; r < 16; ++r) { const int t = (r & 3) + 8 * (r >> 2) + 4 * h; Att[t * 72 + 32 + c] = (bf16)0; }
    }
    __syncthreads();
    f32x16 acc[2];
    {
        const bf16* VGT = WSP(bf16, WS_VGT) + ((size_t)ch * 1024 + hd * 256 + 32 * w + c) * 64;
        const bf16* STp = WSP(bf16, WS_ST) + ((size_t)(ch * 4 + hd) * 256 + 32 * w + c) * 128;
        bf16x8 bv[4], bs[8];
#pragma unroll
        for (int ss = 0; ss < 4; ++ss) bv[ss] = *(const bf16x8*)(VGT + 16 * ss + 8 * h);
#pragma unroll
        for (int ks = 0; ks < 8; ++ks) bs[ks] = *(const bf16x8*)(STp + 16 * ks + 8 * h);
#pragma unroll
        for (int tt = 0; tt < 2; ++tt) {
#pragma unroll
            for (int r = 0; r < 16; ++r) acc[tt][r] = 0.f;
#pragma unroll
            for (int ss = 0; ss < 4; ++ss) { if (tt == 0 && ss >= 2) continue;
                const bf16x8 a = *(const LAS bf16x8*)(Att + (32 * tt + c) * 72 + 16 * ss + 8 * h); acc[tt] = __builtin_amdgcn_mfma_f32_32x32x16_bf16(a, bv[ss], acc[tt], 0, 0, 0); }
#pragma unroll
            for (int ks = 0; ks < 8; ++ks) { const bf16x8 a = *(const LAS bf16x8*)(Qt + (32 * tt + c) * 136 + 16 * ks + 8 * h); acc[tt] = __builtin_amdgcn_mfma_f32_32x32x16_bf16(a, bs[ks], acc[tt], 0, 0, 0); }
        }
    }
#pragma unroll
    for (int tt = 0; tt < 2; ++tt)
#pragma unroll
        for (int r = 0; r < 16; ++r) { float sq = acc[tt][r] * acc[tt][r];
            sq += __shfl_xor(sq, 1); sq += __shfl_xor(sq, 2); sq += __shfl_xor(sq, 4); sq += __shfl_xor(sq, 8); sq += __shfl_xor(sq, 16);
            if (c == 0) red[w * 64 + 32 * tt + (r & 3) + 8 * (r >> 2) + 4 * h] = sq; }
    __syncthreads();
    if (tid < 64) { float s = 0.f;
#pragma unroll
        for (int ww = 0; ww < 8; ++ww) s += red[ww * 64 + tid];
        rstdv[tid] = 1.f / sqrtf(s * (1.f / 256.f) + 1e-6f); }
    __syncthreads();
    {
        const int col = hd * 256 + 32 * w + c; const float gw = F.gnw[32 * w + c];
        const bf16* ZG = WSP(bf16, WS_ZG); bf16* OG = WSP(bf16, WS_OGLA);
#pragma unroll
        for (int tt = 0; tt < 2; ++tt)
#pragma unroll
            for (int r = 0; r < 16; ++r) { const int t = 32 * tt + (r & 3) + 8 * (r >> 2) + 4 * h; const size_t row = (size_t)(64 * ch + t);
                OG[row * 1024 + col] = (bf16)f2bf(acc[tt][r] * rstdv[t] * gw * bf2f(ZG[row * 1024 + col])); }
    }
    __syncthreads();
}
__device__ __forceinline__ void gla_sample_unit(Frame& F, int b, int hd) {
    LAS float* cumS = (LAS float*)F.lds; LAS float* qtl = cumS + 1024; LAS float* khl = qtl + 1024; LAS float* ktl = khl + 1024;
    LAS float* att = ktl + 1024; LAS float* oih = att + 64; LAS float* red = oih + 2048;
    const int tid = F.tid, lane = F.lane, w = F.wave, row0 = TP + 8 * b;
    if (tid < 128) {
        const int k = tid; float wv[16];
#pragma unroll
        for (int r = 0; r < 16; ++r) wv[r] = F.w_a2[r * 512 + hd * 128 + k];
        const float bias = F.b_a[hd * 128 + k]; float run = 0.f;
        const float* AG = WSP(float, WS_AG) + (size_t)row0 * 16;
        for (int t = 0; t < 8; ++t) { float z = bias;
#pragma unroll
            for (int r = 0; r < 16; ++r) z += AG[t * 16 + r] * wv[r];
            run += log_sigmoid(z) * (1.f / 16.f); cumS[t * 128 + k] = run; }
    }
    __syncthreads();
    for (int i = tid; i < 1024; i += 512) { const int t = i >> 7, k = i & 127; const float cu = cumS[i], cl = cumS[7 * 128 + k];
        const float q = bf2f(WSP(bf16, WS_QG)[(size_t)(row0 + t) * 512 + hd * 128 + k]), kk = bf2f(WSP(bf16, WS_KG)[(size_t)(row0 + t) * 512 + hd * 128 + k]);
        qtl[i] = q * __expf(cu); khl[i] = kk * __expf(cl - cu); ktl[i] = kk * __expf(-cu); }
    __syncthreads();
    if (tid < 64) { const int t = tid >> 3, s = tid & 7; float a = 0.f;
        if (s <= t) for (int k = 0; k < 128; ++k) a += qtl[t * 128 + k] * ktl[s * 128 + k];
        att[tid] = a; }
    __syncthreads();
    const int v = tid & 255, kh = tid >> 8;
    float vv[8], oi[8];
#pragma unroll
    for (int s = 0; s < 8; ++s) { vv[s] = WSP(float, WS_VGS)[(size_t)(8 * b + s) * 1024 + hd * 256 + v]; oi[s] = 0.f; }
    const float* S0 = F.state + ((size_t)(b * 4 + hd) * 128) * 256; float* SN = F.out + O_STS + ((size_t)(b * 4 + hd) * 128) * 256;
#pragma unroll 4
    for (int kk = 0; kk < 64; ++kk) { const int k = kh * 64 + kk; const float s0 = S0[(size_t)k * 256 + v]; float sn = __expf(cumS[7 * 128 + k]) * s0;
#pragma unroll
        for (int s = 0; s < 8; ++s) { sn += khl[s * 128 + k] * vv[s]; oi[s] += qtl[s * 128 + k] * s0; }
        SN[(size_t)k * 256 + v] = sn; }
    if (kh == 1) {
#pragma unroll
        for (int t = 0; t < 8; ++t) oih[t * 256 + v] = oi[t]; }
    __syncthreads();
    if (kh == 0) {
#pragma unroll
        for (int t = 0; t < 8; ++t) { float o = oi[t] + oih[t * 256 + v];
#pragma unroll
            for (int s = 0; s < 8; ++s) if (s <= t) o += att[t * 8 + s] * vv[s];
            oi[t] = o; } }
#pragma unroll
    for (int t = 0; t < 8; ++t) { float sq = (kh == 0) ? oi[t] * oi[t] : 0.f; sq = wave_sum(sq); if (lane == 0) red[w * 8 + t] = sq; }
    __syncthreads();
    if (kh == 0) { const float gw = F.gnw[v];
#pragma unroll
        for (int t = 0; t < 8; ++t) { const float ssum = (red[t] + red[8 + t]) + (red[16 + t] + red[24 + t]); const float rstd = 1.f / sqrtf(ssum * (1.f / 256.f) + 1e-6f);
            const size_t row = (size_t)(row0 + t);
            WSP(bf16, WS_OGLA)[row * 1024 + hd * 256 + v] = (bf16)f2bf(oi[t] * rstd * gw * bf2f(WSP(bf16, WS_ZG)[row * 1024 + hd * 256 + v])); } }
    __syncthreads();
}

#ifndef MK_N_LAUNCHES
#define MK_N_LAUNCHES 1
#endif
constexpr int NPH = 10;
constexpr int N_LAUNCHES = MK_N_LAUNCHES;
struct Args { const void* in[25]; float* out; unsigned char* ws; int ph_lo, ph_hi; };

__global__ void __launch_bounds__(NWAVES * 64, 2) nsa_gla_fwd(Args args) {
    extern __shared__ __attribute__((aligned(16))) unsigned char lds[];
    Frame F;
    F.lds = (LAS unsigned char*)lds;
    F.MISC = (volatile LAS unsigned*)(F.lds + LDSCTL_OFF);
    F.tid = threadIdx.x; F.lane = F.tid & 63; F.wave = __builtin_amdgcn_readfirstlane(F.tid >> 6);
    F.G = gridDim.x; F.gw = blockIdx.x * NWAVES + F.wave; F.NGW = F.G * NWAVES;
    F.ws = args.ws; F.out = args.out; F.ctl = (gu32*)(args.ws + WS_CTL);
    F.x_p = (const float*)args.in[0]; F.x_s = (const float*)args.in[1]; F.c_cmp = (const float*)args.in[2]; F.c_sel = (const float*)args.in[3];
    F.c_win = (const float*)args.in[4]; F.state = (const float*)args.in[5]; F.ptab = (const int*)args.in[6]; F.c_p = (const float*)args.in[7];
    F.c_s = (const float*)args.in[8]; F.norm_w = (const float*)args.in[9]; F.w_ada = (const float*)args.in[10]; F.b_ada = (const float*)args.in[11];
    F.w_in = (const float*)args.in[12]; F.cmp_pos = (const float*)args.in[13]; F.cmp_w1 = (const float*)args.in[14]; F.cmp_b1 = (const float*)args.in[15];
    F.cmp_w2 = (const float*)args.in[16]; F.cmp_b2 = (const float*)args.in[17]; F.w_a2 = (const float*)args.in[18]; F.b_a = (const float*)args.in[19];
    F.gnw = (const float*)args.in[20]; F.w_on = (const float*)args.in[21]; F.w_og = (const float*)args.in[22]; F.w_out = (const float*)args.in[23];
    F.fnw = (const float*)args.in[24];
    for (int u = F.tid; u < (LDS_BYTES - LDSCTL_OFF) / 4; u += NWAVES * 64) ((LAS unsigned*)(F.lds + LDSCTL_OFF))[u] = 0u;
    __syncthreads();
    const int lo = args.ph_lo, hi = args.ph_hi;
    const bool use_bar = (hi - lo) > 1;
    XcdBarrier bar; bar.bar = (unsigned*)(F.ctl + CW_BAR); bar.x = 0; bar.st = nullptr;
    if (use_bar) bar = xcd_barrier_post((unsigned*)(F.ctl + CW_BAR), F.MISC + 8);
#ifndef PH_MASK
#define PH_MASK 0x3ff
#endif
#define IN(k) (((PH_MASK >> (k)) & 1) && lo <= (k) && (k) < hi)
#define SEAM(k) do { if (IN(k) && IN((k) + 1)) xcd_barrier(bar); } while (0)
    LAS unsigned char* ring = F.lds;

    if (IN(0)) { p0_prologue(F); }
    SEAM(0);
    if (IN(1)) { p1_modnorm(F); }
    SEAM(1);
    if (IN(2)) {
        pg8::Gemm g{WSP(const bf16, WS_H), WSP(const bf16, WS_WIN), MROWS, NINP, DM}; pg8::StaticOrder S; S.init(MROWS, NINP, F.G, (int)blockIdx.x);
        EpiIn E{F.out, F.ws};
        pg8::gemm_phase<EpiIn, pg8::StaticOrder, true, true>(ring, g, S, E);
    }
    SEAM(2);
    if (IN(3)) {
        for (int x = 0; x < 2; ++x) {
            pg8::Gemm g{WSP(const bf16, WS_CB) + (size_t)x * CB_X, WSP(const bf16, WS_W1T) + (size_t)x * 256 * 1024, CROWS, 256, 1024}; pg8::StaticOrder S; S.init(CROWS, 256, F.G, (int)blockIdx.x);
            EpiPlainBf16 E{WSP(bf16, WS_PART) + (size_t)x * CROWS * 256, 256};
            pg8::gemm_phase<EpiPlainBf16, pg8::StaticOrder, true, true>(ring, g, S, E);
            __syncthreads();
        }
        for (int u = blockIdx.x; u < 512; u += F.G) gla_pass1_unit(F, u >> 2, u & 3);
        for (int u = blockIdx.x; u < 128; u += F.G) gla_sample_unit(F, u >> 2, u & 3);
    }
    SEAM(3);
    if (IN(4)) { compress_l2(F); gla_pass2(F); }
    SEAM(4);
    if (IN(5)) {
#ifndef P5_MASK
#define P5_MASK 7
#endif
#define QUEUE_LOOP(word, N, BODY) for (;;) { if (F.tid == 0) F.MISC[0] = __hip_atomic_fetch_add((unsigned*)(F.ctl + (word)), 1u, RLX_AGENT); __syncthreads(); \
            const int idx = (int)F.MISC[0]; __syncthreads(); if (idx >= (N)) break; BODY; }
        if (P5_MASK & 1) { QUEUE_LOOP(CW_Q5, 128, nsa_sample_unit(F, idx >> 2, idx & 3)) }
        if (P5_MASK & 2) { QUEUE_LOOP(CW_Q5 + 64, 512, nsa_prompt_unit(F, 127 - (idx >> 2), idx & 3)) }
        if (P5_MASK & 4) { QUEUE_LOOP(CW_Q5 + 128, 512, gla_pass3_unit(F, idx >> 2, idx & 3)) }
#undef QUEUE_LOOP
    }
    SEAM(5);
    if (IN(6)) {
        pg8::Gemm g{WSP(const bf16, WS_ONSA), WSP(const bf16, WS_WON), MROWS, DM, 1024}; pg8::StaticOrder S; S.init(MROWS, DM, F.G, (int)blockIdx.x);
        EpiMerge<false> E{WSP(const bf16, WS_MN), WSP(bf16, WS_MERGED)};
        pg8::gemm_phase<EpiMerge<false>, pg8::StaticOrder, true, true>(ring, g, S, E);
    }
    SEAM(6);
    if (IN(7)) {
        pg8::Gemm g{WSP(const bf16, WS_OGLA), WSP(const bf16, WS_WOG), MROWS, DM, 1024}; pg8::StaticOrder S; S.init(MROWS, DM, F.G, (int)blockIdx.x);
        EpiMerge<true> E{WSP(const bf16, WS_MG), WSP(bf16, WS_MERGED)};
        pg8::gemm_phase<EpiMerge<true>, pg8::StaticOrder, true, true>(ring, g, S, E);
    }
    SEAM(7);
    if (IN(8)) {
        pg8::Gemm g{WSP(const bf16, WS_MERGED), WSP(const bf16, WS_WOUT), MROWS, DM, DM}; pg8::StaticOrder S; S.init(MROWS, DM, F.G, (int)blockIdx.x);
        EpiOut E{F.x_p, F.x_s, WSP(const float, WS_MOD), F.out, WSP(float, WS_RSS)};
        pg8::gemm_phase<EpiOut, pg8::StaticOrder, true, true>(ring, g, S, E);
    }
    SEAM(8);
    if (IN(9)) { final_norm(F); }
#undef IN
#undef SEAM
}

extern "C" void kernel_launch(void* const* d_in, const int* in_sizes, int n_in, void* d_out, int out_size, void* d_ws, size_t ws_size, hipStream_t stream) {
    static int grid = 0;
    if (grid == 0) {
        if (n_in != 25 || (size_t)out_size != O_TOTAL || ws_size < WS_END) {
            fprintf(stderr, "kernel_launch: built for 25 inputs, %zu outputs, >= %zu bytes of workspace; got n_in %d, out %d, ws %zu; nothing launched\n", (size_t)O_TOTAL, (size_t)WS_END, n_in, out_size, ws_size); grid = -1; return; }
        int dev = 0, cus = 0, per_cu = 0;
        if (hipGetDevice(&dev) != hipSuccess || hipDeviceGetAttribute(&cus, hipDeviceAttributeMultiprocessorCount, dev) != hipSuccess) { fprintf(stderr, "kernel_launch: device query failed\n"); grid = -1; return; }
        if (hipFuncSetAttribute((const void*)nsa_gla_fwd, hipFuncAttributeMaxDynamicSharedMemorySize, LDS_BYTES) != hipSuccess) { fprintf(stderr, "kernel_launch: hipFuncSetAttribute failed\n"); grid = -1; return; }
        if (hipOccupancyMaxActiveBlocksPerMultiprocessor(&per_cu, (const void*)nsa_gla_fwd, NWAVES * 64, LDS_BYTES) != hipSuccess || per_cu < 1)
            fprintf(stderr, "kernel_launch: note: occupancy query reports %d workgroups per CU\n", per_cu);
        (void)hipGetLastError();
        grid = cus;
    }
    if (grid < 0) return;
    if (hipMemsetAsync((char*)d_ws + WS_CTL, 0, CTL_ZERO_BYTES, stream) != hipSuccess) { fprintf(stderr, "kernel_launch: memset failed\n"); return; }
    Args a{};
    for (int i = 0; i < 25; ++i) a.in[i] = d_in[i];
    a.out = (float*)d_out; a.ws = (unsigned char*)d_ws;
    for (int li = 0; li < N_LAUNCHES; ++li) {
        if (N_LAUNCHES == 1) { a.ph_lo = 0; a.ph_hi = NPH; } else { a.ph_lo = li; a.ph_hi = li + 1; }
        hipLaunchKernelGGL(nsa_gla_fwd, dim3(grid), dim3(NWAVES * 64), LDS_BYTES, stream, a);
        const hipError_t le = hipPeekAtLastError();
        if (le != hipSuccess) { fprintf(stderr, "kernel_launch: launch %d failed: %s\n", li, hipGetErrorName(le)); break; }
    }
}
```

```cpp
#include <hip/hip_runtime.h>
#include <cstdio>
#include <cstdint>
#define MK_N_LAUNCHES 1
namespace pg8 {
#define PG8_LAS __attribute__((address_space(3)))
typedef unsigned short bf16_t;
typedef short bf16x8 __attribute__((ext_vector_type(8)));
typedef float f32x4 __attribute__((ext_vector_type(4)));
typedef unsigned u32x4 __attribute__((ext_vector_type(4)));
constexpr int BM = 256, BK = 64, HALF = 128, HTB = HALF * BK * 2  , STAGE_BYTES = 8 * HTB, NXCD = 8, WGM = 8;

__host__ __device__ __forceinline__ int lds_byte(int r, int c) { const int st = (r >> 4) * 2 + (c >> 5), rr = r & 15, cc = c & 31, ob = rr * 64 + cc * 2; return st * 1024 + (ob ^ (((ob >> 9) & 1) << 5)); }
__host__ __device__ __forceinline__ void stage_rc(int b, int& R, int& C) { const int st = b / 1024, sb = b % 1024, swz = sb ^ (((sb >> 9) & 1) << 5); R = (st >> 1) * 16 + swz / 64; C = (st & 1) * 32 + (swz % 64) / 2; }
__host__ __device__ __forceinline__ int perm32(int rho) { const int n = rho >> 4, i = rho & 15; return 8 * (i >> 2) + 4 * n + (i & 3); }

struct Unit { int pm, pn; };
struct Gemm { const bf16_t* A; const bf16_t* Bt; int M, N, K; };

struct StaticOrder {
    int nM, nN, nwg, G, c;
    __host__ __device__ void init(int M, int N, int G_, int c_) { nM = M / BM; nN = N / BM; nwg = nM * nN; G = G_; c = c_; }
    __host__ __device__ bool next(int i, Unit& u) const {
        const long L = (long)i * G + c; if (L >= nwg) return false;
        int wgid = (int)L; { const int q = nwg / NXCD, r = nwg % NXCD, xcd = wgid % NXCD, off = wgid / NXCD; wgid = (xcd < r ? xcd * (q + 1) : r * (q + 1) + (xcd - r) * q) + off; }
        const int nig = WGM * nN, gid = wgid / nig, fm = gid * WGM, gsz = (nM - fm) < WGM ? (nM - fm) : WGM;
        u.pm = fm + ((wgid % nig) % gsz); u.pn = (wgid % nig) / gsz; return true;
    }
    __device__ __forceinline__ void a_ready(const Unit&) const {}
    __device__ __forceinline__ void done(const Unit&) const {}
};

__device__ __forceinline__ unsigned cvt_pk_bf16(float lo, float hi) { unsigned r; asm volatile("v_cvt_pk_bf16_f32 %0, %1, %2" : "=v"(r) : "v"(lo), "v"(hi)); return r; }
typedef float f32x2 __attribute__((ext_vector_type(2)));

template <class Epi, class Sched, bool ALIGN_EPI = false, bool SP2 = false>
__device__ __forceinline__ void gemm_phase(PG8_LAS unsigned char* lds, const Gemm g, const Sched& S, const Epi& E) {
    const int tid = threadIdx.x, wid = __builtin_amdgcn_readfirstlane(tid >> 6), lane = tid & 63, wr = wid >> 2, wc = wid & 3, fr = lane & 15, fq = lane >> 4;
    const int K = g.K, nt = K / BK;
    unsigned voffA[2], voffB[2];
#pragma unroll
    for (int i = 0; i < 2; ++i) { int R, C; stage_rc(tid * 16 + i * 8192, R, C); const int Rb = Epi::PERM ? ((R & ~31) + perm32(R & 31)) : R;
        voffA[i] = (unsigned)(R * K + C) * 2u; voffB[i] = (unsigned)(Rb * K + C) * 2u; }
    const size_t kstep = (size_t)(BK * 2);
    const size_t hstep = (size_t)HALF * K * 2;
    const size_t tstep = 2 * hstep;
    const unsigned ldsw = (unsigned)wid * 1024u;
    const int aoff = lds_byte(wr * 64 + fr, fq * 8), boff = lds_byte(wc * 32 + fr, fq * 8);
#define PG8_SA(b, h) (((b) * 2 + (h)) * HTB)
#define PG8_SB(b, h) ((4 + (b) * 2 + (h)) * HTB)
#define PG8_STAGE(bufoff, gbase, voff) do { _Pragma("unroll") for (int _i = 0; _i < 2; ++_i) \
        __builtin_amdgcn_global_load_lds((const unsigned*)((const char*)(gbase) + (voff)[_i]), (PG8_LAS unsigned*)(lds + (bufoff) + ldsw + _i * 8192), 16, 0, 0); } while (0)
#define PG8_LDA(dst, b, h) do { _Pragma("unroll") for (int m = 0; m < 4; ++m) _Pragma("unroll") for (int k = 0; k < 2; ++k) dst[m][k] = *(const PG8_LAS bf16x8*)(lds + PG8_SA(b, h) + aoff + m * 2048 + k * 1024); } while (0)
#define PG8_LDB(dst, b, h) do { _Pragma("unroll") for (int n = 0; n < 2; ++n) _Pragma("unroll") for (int k = 0; k < 2; ++k) dst[n][k] = *(const PG8_LAS bf16x8*)(lds + PG8_SB(b, h) + boff + n * 2048 + k * 1024); } while (0)
#define PG8_MMA(ai, bj, At, Bt) do { __builtin_amdgcn_s_setprio(1); _Pragma("unroll") for (int m = 0; m < 4; ++m) _Pragma("unroll") for (int n = 0; n < 2; ++n) _Pragma("unroll") for (int k = 0; k < 2; ++k) \
        acc[ai][bj][m][n] = __builtin_amdgcn_mfma_f32_16x16x32_bf16(Bt[n][k], At[m][k], acc[ai][bj][m][n], 0, 0, 0); __builtin_amdgcn_s_setprio(0); } while (0)
#define PG8_WAIT_V(n) asm volatile("s_waitcnt vmcnt(" #n ")" ::: "memory")
#define PG8_WAIT_L(n) asm volatile("s_waitcnt lgkmcnt(" #n ")" ::: "memory")
#define PG8_BAR __builtin_amdgcn_s_barrier()
#define PG8_SCHED __builtin_amdgcn_sched_barrier(0)
    Unit cur, nxt; int ui = 0;
    if (!S.next(0, cur)) return;
    f32x4 acc[2][2][4][2];
#pragma unroll
    for (int a = 0; a < 2; ++a)
#pragma unroll
        for (int b = 0; b < 2; ++b)
#pragma unroll
            for (int m = 0; m < 4; ++m)
#pragma unroll
                for (int n = 0; n < 2; ++n) acc[a][b][m][n] = (f32x4){0.f, 0.f, 0.f, 0.f};
    bf16x8 At[4][2], B0[2][2], B1[2][2];
    const char* cA = (const char*)g.A + (size_t)cur.pm * tstep; const char* cB = (const char*)g.Bt + (size_t)cur.pn * tstep;
    S.a_ready(cur);
    if constexpr (SP2) {
        PG8_STAGE(PG8_SB(0, 0), cB, voffB); PG8_STAGE(PG8_SB(0, 1), cB + hstep, voffB); PG8_STAGE(PG8_SA(0, 0), cA, voffA); PG8_STAGE(PG8_SA(0, 1), cA + hstep, voffA);
        if (wr == 1) PG8_BAR;
        PG8_WAIT_V(2); PG8_BAR;
        PG8_STAGE(PG8_SB(1, 0), cB + kstep, voffB); PG8_STAGE(PG8_SA(1, 0), cA + kstep, voffA); PG8_STAGE(PG8_SB(1, 1), cB + hstep + kstep, voffB);
        PG8_WAIT_V(6); PG8_BAR;
    } else {
        PG8_STAGE(PG8_SB(0, 0), cB, voffB); PG8_STAGE(PG8_SA(0, 0), cA, voffA); PG8_STAGE(PG8_SB(0, 1), cB + hstep, voffB); PG8_STAGE(PG8_SA(0, 1), cA + hstep, voffA);
        if (wr == 1) PG8_BAR;
        PG8_WAIT_V(4); PG8_BAR;
        PG8_STAGE(PG8_SB(1, 0), cB + kstep, voffB); PG8_STAGE(PG8_SA(1, 0), cA + kstep, voffA); PG8_STAGE(PG8_SB(1, 1), cB + hstep + kstep, voffB);
        PG8_WAIT_V(6); PG8_BAR;
    }
    for (;;) {
        const bool has_next = S.next(ui + 1, nxt);
        const char* nA = has_next ? (const char*)g.A + (size_t)nxt.pm * tstep : cA; const char* nB = has_next ? (const char*)g.Bt + (size_t)nxt.pn * tstep : cB;
        for (int t = 0; t < nt; t += 2) {
            const bool last = (t == nt - 2);
            const char* a1 = cA + (size_t)(t + 1) * kstep;
            const char* a2 = last ? nA : cA + (size_t)(t + 2) * kstep; const char* b2 = last ? nB : cB + (size_t)(t + 2) * kstep;
            const char* a3 = a2 + kstep; const char* b3 = b2 + kstep;
            if (last && has_next) S.a_ready(nxt);
            if constexpr (SP2) {
            PG8_LDB(B0, 0, 0); PG8_LDB(B1, 0, 1); PG8_SCHED; PG8_LDA(At, 0, 0); PG8_STAGE(PG8_SA(1, 1), a1 + hstep, voffA);
            PG8_WAIT_V(8); PG8_WAIT_L(0); PG8_BAR; PG8_MMA(0, 0, At, B0); PG8_MMA(0, 1, At, B1); PG8_BAR; PG8_SCHED;
            PG8_LDA(At, 0, 1); PG8_STAGE(PG8_SB(0, 0), b2, voffB); PG8_STAGE(PG8_SB(0, 1), b2 + hstep, voffB); PG8_STAGE(PG8_SA(0, 0), a2, voffA);
            PG8_WAIT_V(8); PG8_WAIT_L(0); PG8_BAR; PG8_MMA(1, 0, At, B0); PG8_MMA(1, 1, At, B1); PG8_BAR; PG8_SCHED;
            PG8_LDB(B0, 1, 0); PG8_LDB(B1, 1, 1); PG8_SCHED; PG8_LDA(At, 1, 0); PG8_STAGE(PG8_SA(0, 1), a2 + hstep, voffA);
            PG8_WAIT_V(8); PG8_WAIT_L(0); PG8_BAR; PG8_MMA(0, 0, At, B0); PG8_MMA(0, 1, At, B1); PG8_BAR; PG8_SCHED;
            PG8_LDA(At, 1, 1); PG8_STAGE(PG8_SB(1, 0), b3, voffB); PG8_STAGE(PG8_SB(1, 1), b3 + hstep, voffB); PG8_STAGE(PG8_SA(1, 0), a3, voffA);
            PG8_WAIT_V(8); PG8_WAIT_L(0); PG8_BAR; PG8_MMA(1, 0, At, B0); PG8_MMA(1, 1, At, B1); PG8_BAR; PG8_SCHED;
            } else {
            PG8_LDB(B0, 0, 0); PG8_SCHED; PG8_LDA(At, 0, 0); PG8_STAGE(PG8_SA(1, 1), a1 + hstep, voffA);
            PG8_WAIT_L(8); PG8_BAR; PG8_WAIT_L(0); PG8_MMA(0, 0, At, B0); PG8_BAR; PG8_SCHED;
            PG8_LDB(B1, 0, 1); PG8_STAGE(PG8_SB(0, 0), b2, voffB);
            PG8_BAR; PG8_WAIT_L(0); PG8_MMA(0, 1, At, B1); PG8_BAR;
            PG8_LDA(At, 0, 1); PG8_STAGE(PG8_SA(0, 0), a2, voffA);
            PG8_BAR; PG8_WAIT_L(0); PG8_MMA(1, 0, At, B0); PG8_BAR; PG8_SCHED;
            PG8_STAGE(PG8_SB(0, 1), b2 + hstep, voffB);
            PG8_WAIT_V(6); PG8_BAR; PG8_MMA(1, 1, At, B1); PG8_BAR;
            PG8_LDB(B0, 1, 0); PG8_SCHED; PG8_LDA(At, 1, 0); PG8_STAGE(PG8_SA(0, 1), a2 + hstep, voffA);
            PG8_WAIT_L(8); PG8_BAR; PG8_WAIT_L(0); PG8_MMA(0, 0, At, B0); PG8_BAR; PG8_SCHED;
            PG8_LDB(B1, 1, 1); PG8_STAGE(PG8_SB(1, 0), b3, voffB);
            PG8_BAR; PG8_WAIT_L(0); PG8_MMA(0, 1, At, B1); PG8_BAR;
            PG8_LDA(At, 1, 1); PG8_STAGE(PG8_SA(1, 0), a3, voffA);
            PG8_BAR; PG8_WAIT_L(0); PG8_MMA(1, 0, At, B0); PG8_BAR; PG8_SCHED;
            PG8_STAGE(PG8_SB(1, 1), b3 + hstep, voffB);
            PG8_WAIT_V(6); PG8_BAR; PG8_MMA(1, 1, At, B1); PG8_BAR;
            }
        }
        if constexpr (ALIGN_EPI) { if (wr == 0) PG8_BAR; }
        if constexpr (!Epi::AFTER_DRAIN) { E(acc, cur, wr, wc, fr, fq); S.done(cur); }
        if (!has_next) break;
#pragma unroll
        for (int a = 0; a < 2; ++a)
#pragma unroll
            for (int b = 0; b < 2; ++b)
#pragma unroll
                for (int m = 0; m < 4; ++m)
#pragma unroll
                    for (int n = 0; n < 2; ++n) acc[a][b][m][n] = (f32x4){0.f, 0.f, 0.f, 0.f};
        cur = nxt; cA = nA; cB = nB; ++ui;
        if constexpr (ALIGN_EPI) { if (wr == 1) PG8_BAR; }
    }
    PG8_WAIT_V(0);
    if constexpr (!ALIGN_EPI) { if (wr == 0) PG8_BAR; }
    PG8_BAR;
    if constexpr (Epi::AFTER_DRAIN) { E.fused(acc, cur, wr, wc, fr, fq, lds, wid, lane); S.done(cur); }
#undef PG8_SA
#undef PG8_SB
#undef PG8_STAGE
#undef PG8_LDA
#undef PG8_LDB
#undef PG8_MMA
#undef PG8_WAIT_V
#undef PG8_WAIT_L
#undef PG8_BAR
#undef PG8_SCHED
}
}

constexpr int NWAVES = 8;
constexpr int DM = 2048, TP = 8192, TS = 256, MROWS = TP + TS, NINP = 11008, NMOD = 6144;
constexpr int NBATCH_S = 32, TSEQ_S = 8, NPAGE = 64;
constexpr float QSCALE = 0.125f * 1.4426950408889634f;
constexpr float GQSCALE = 0.08838834764831845f;
constexpr size_t O_YP = 0, O_YS = 16777216, O_CMPP = 17301504, O_CMPS = 21495808, O_SELP = 21626880, O_SELS = 25821184,
                 O_WINP = 25952256, O_WINS = 26214400, O_STP = 34603008, O_STS = 34734080, O_TOTAL = 38928384;
constexpr size_t MiB = 1u << 20;
constexpr size_t WS_CTL = 0, CTL_ZERO_BYTES = 1 * MiB;
constexpr size_t WS_MOD = 786 * MiB;
constexpr size_t MOD_BYTES = (size_t)33 * 6144 * 8;
constexpr float MOD_SCALE = 4294967296.f, MOD_INV = 1.f / 4294967296.f;
constexpr size_t WS_ROPE = 2 * MiB;
constexpr size_t WS_POSB = 5 * MiB;
constexpr size_t WS_W1T = 6 * MiB;
constexpr size_t WS_WIN = 7 * MiB;
constexpr size_t WS_WON = 50 * MiB, WS_WOG = 54 * MiB, WS_WOUT = 58 * MiB;
constexpr size_t WS_H = 66 * MiB;
constexpr size_t WS_QB = 99 * MiB;
constexpr size_t WS_KVB = 116 * MiB;
constexpr size_t WS_CB = 132 * MiB;
constexpr size_t CB_X = (size_t)33 * 4 * 8192 * 64;
constexpr size_t WS_PART = 397 * MiB;
constexpr int CROWS = 33 * 4 * 512;
constexpr size_t WS_KC = 464 * MiB;
constexpr size_t WS_ZN = 481 * MiB, WS_ZG = 498 * MiB;
constexpr size_t WS_MN = 515 * MiB, WS_MG = 548 * MiB;
constexpr size_t WS_QG = 581 * MiB, WS_KG = 590 * MiB;
constexpr size_t WS_VGT = 599 * MiB;
constexpr size_t WS_VGS = 615 * MiB;
constexpr size_t WS_AG = 616 * MiB;
constexpr size_t WS_GB = 617 * MiB;
constexpr size_t WS_LT = 619 * MiB;
constexpr size_t WS_DC = 683 * MiB;
constexpr size_t WS_ST = 684 * MiB;
constexpr size_t WS_ONSA = 716 * MiB, WS_OGLA = 733 * MiB;
constexpr size_t WS_MERGED = 750 * MiB;
constexpr size_t WS_RSS = 783 * MiB;
constexpr size_t WS_END = 788 * MiB;
constexpr int CW_BAR = 4096;
constexpr int CW_Q5 = 8192;
constexpr int RING_BYTES = 131072;
constexpr int LDSCTL_OFF = RING_BYTES;
constexpr int LDS_BYTES = 147456;

#define GAS __attribute__((address_space(1)))
#define LAS __attribute__((address_space(3)))
typedef unsigned short bf16;
typedef short bf16x8 __attribute__((ext_vector_type(8)));
typedef short s16x4 __attribute__((ext_vector_type(4)));
typedef float f32x4 __attribute__((ext_vector_type(4)));
typedef float f32x2 __attribute__((ext_vector_type(2)));
typedef float f32x16 __attribute__((ext_vector_type(16)));
typedef unsigned u32x4 __attribute__((ext_vector_type(4)));
typedef unsigned u32x2 __attribute__((ext_vector_type(2)));
typedef GAS unsigned gu32;
#define RLX_AGENT __ATOMIC_RELAXED, __HIP_MEMORY_SCOPE_AGENT
#define LDS_WAIT() asm volatile("s_waitcnt lgkmcnt(0)" ::: "memory")

__device__ __forceinline__ unsigned f2bf(float f) { unsigned u = __builtin_bit_cast(unsigned, f); return (u + 0x7fffu + ((u >> 16) & 1u)) >> 16; }
__device__ __forceinline__ unsigned pk2(float lo, float hi) { return f2bf(lo) | (f2bf(hi) << 16); }
__device__ __forceinline__ u32x4 pack8(const f32x4 a, const f32x4 b) { u32x4 o; o.x = pk2(a.x, a.y); o.y = pk2(a.z, a.w); o.z = pk2(b.x, b.y); o.w = pk2(b.z, b.w); return o; }
__device__ __forceinline__ u32x2 pack4(const f32x4 a) { u32x2 o; o.x = pk2(a.x, a.y); o.y = pk2(a.z, a.w); return o; }
__device__ __forceinline__ float bf2f(unsigned b) { return __builtin_bit_cast(float, b << 16); }
__device__ __forceinline__ float bflo(unsigned w) { return __builtin_bit_cast(float, w << 16); }
__device__ __forceinline__ float bfhi(unsigned w) { return __builtin_bit_cast(float, w & 0xffff0000u); }
__device__ __forceinline__ float sigm(float x) { return 1.f / (1.f + __expf(-x)); }
__device__ __forceinline__ float silu(float x) { return x / (1.f + __expf(-x)); }
__device__ __forceinline__ float ex2(float x) { return __builtin_amdgcn_exp2f(x); }
__device__ __forceinline__ float wave_sum(float v) {
#pragma unroll
    for (int o = 1; o < 64; o <<= 1) v += __shfl_xor(v, o);
    return v;
}
#define XB_TMO      128
#define XB_XCNT(j)  (256  + 64 * (j))
#define XB_XSUB(j)  (1280 + 64 * (j))
#define XB_XGEN(j)  (2304 + 64 * (j))
#define XB_TOP      3328
#define XB_TOPGEN   3392
#define XCD_BAR_WORDS 3456
#define XB_SPIN_CAP (1u << 18)

__device__ __forceinline__ unsigned xb_ld(unsigned* p)              { return __hip_atomic_load(p, __ATOMIC_RELAXED, __HIP_MEMORY_SCOPE_AGENT); }
__device__ __forceinline__ unsigned xb_add(unsigned* p, unsigned v) { return __hip_atomic_fetch_add(p, v, __ATOMIC_RELAXED, __HIP_MEMORY_SCOPE_AGENT); }
__device__ __forceinline__ unsigned xb_xcc_id() { return (unsigned)__builtin_amdgcn_s_getreg((3 << 11) | 20) & 0xFu; }
#define XB_SPIN(cond, bar) do { unsigned _sp = 0; while (cond) { __builtin_amdgcn_s_sleep(1); \
    if ((++_sp & 255u) == 0u) { if (xb_ld(&(bar)[XB_TMO])) break; if (_sp > XB_SPIN_CAP) { atomicAdd(&(bar)[XB_TMO], 1u); break; } } } } while (0)

struct XcdBarrier {
    unsigned* bar; unsigned x;
    volatile LAS unsigned* st;
};

__device__ __forceinline__ XcdBarrier xcd_barrier_post(unsigned* bar, volatile LAS unsigned* st) {
    XcdBarrier b; b.bar = bar; b.x = xb_xcc_id(); b.st = st;
    if (threadIdx.x == 0) (void)xb_add(&bar[XB_XCNT(b.x)], 1u);
    return b;
}
__device__ __forceinline__ void xcd_barrier_complete(unsigned* bar, unsigned x, unsigned& nloc, unsigned& nx) {
    const unsigned G = gridDim.x * gridDim.y * gridDim.z;
    unsigned sum, cnt, mine, sp = 0u;
    for (;;) {
        sum = 0u; cnt = 0u; mine = 0u;
#pragma unroll
        for (unsigned j = 0; j < 16; ++j) { const unsigned c = xb_ld(&bar[XB_XCNT(j)]); sum += c; cnt += (c > 0u) ? 1u : 0u; mine = (j == x) ? c : mine; }
        if (sum == G) break;
        __builtin_amdgcn_s_sleep(1);
        if ((++sp & 255u) == 0u) { if (xb_ld(&bar[XB_TMO])) break; if (sp > XB_SPIN_CAP) { atomicAdd(&bar[XB_TMO], 1u); break; } }
    }
    nloc = mine > 0u ? mine : 1u; nx = cnt > 0u ? cnt : 1u;
}

__device__ __forceinline__ void xcd_barrier(const XcdBarrier& b) {
    asm volatile("s_waitcnt vmcnt(0)" ::: "memory");
    __syncthreads();
    if (threadIdx.x == 0) {
        unsigned* bar = b.bar;
        __builtin_amdgcn_s_waitcnt(0);
        unsigned nloc = b.st[0], nx = b.st[1];
        if (nloc == 0u) { xcd_barrier_complete(bar, b.x, nloc, nx); b.st[0] = nloc; b.st[1] = nx; }
        const unsigned old = xb_add(&bar[XB_XSUB(b.x)], 1u);
        const unsigned gen = old / nloc;
        if (old + 1u == (gen + 1u) * nloc) {
            __builtin_amdgcn_fence(__ATOMIC_RELEASE, "agent");
            asm volatile("s_waitcnt vmcnt(0)" ::: "memory");
            const unsigned og = xb_add(&bar[XB_TOP], 1u);
            const unsigned tg = og / nx;
            if (og + 1u == (tg + 1u) * nx) xb_add(&bar[XB_TOPGEN], 1u);
            else XB_SPIN(xb_ld(&bar[XB_TOPGEN]) == tg, bar);
            __builtin_amdgcn_fence(__ATOMIC_ACQUIRE, "agent");
            xb_add(&bar[XB_XGEN(b.x)], 1u);
            asm volatile("s_waitcnt vmcnt(0)" ::: "memory");
        } else {
            XB_SPIN(xb_ld(&bar[XB_XGEN(b.x)]) == gen, bar);
            __builtin_amdgcn_fence(__ATOMIC_ACQUIRE, "agent");
            asm volatile("s_waitcnt vmcnt(0)" ::: "memory");
        }
    }
    __syncthreads();
}

struct Frame {
    LAS unsigned char* lds;
    volatile LAS unsigned* MISC;
    gu32* ctl;
    int tid, lane, wave, G, gw, NGW;
    const float *x_p, *x_s, *c_cmp, *c_sel, *c_win, *state, *c_p, *c_s, *norm_w, *w_ada, *b_ada, *w_in, *cmp_pos, *cmp_w1, *cmp_b1, *cmp_w2, *cmp_b2,
                *w_a2, *b_a, *gnw, *w_on, *w_og, *w_out, *fnw;
    const int* ptab;
    float* out;
    unsigned char* ws;
};
#define WSP(T, off) ((T*)(F.ws + (off)))

__device__ __forceinline__ int ropeperm(int pp) { const int j8 = pp >> 3, e = pp & 7; return e < 4 ? 4 * j8 + e : 32 + 4 * j8 + (e - 4); }
__device__ __forceinline__ int in_col(int n) {
    const int tile = n >> 8, pc = n & 255;
    if (tile < 4) return (tile * 4 + (pc >> 6)) * 64 + ropeperm(pc & 63);
    if (tile < 10) { const int t = tile - 4, br = t >> 1, x = t & 1, pp = pc & 63; return 1024 + br * 512 + x * 256 + (pc >> 6) * 64 + (x == 0 ? ropeperm(pp) : pp); }
    if (tile < 14) return 2608 + (n - 10 * 256);
    if (tile < 16) return 3632 + (n - 14 * 256);
    if (tile < 18) return 4144 + (n - 16 * 256);
    if (tile < 22) return 4656 + (n - 18 * 256);
    if (tile < 26) return 5696 + (n - 22 * 256);
    if (tile < 34) return 6720 + (n - 26 * 256);
    if (tile < 42) return 8768 + (n - 34 * 256);
    if (pc < 48) return 2560 + pc;
    if (pc < 64) return 5680 + (pc - 48);
    return -1;
}
template <bool MAPPED>
__device__ __forceinline__ void transpose_item(const float* __restrict__ W, int ldw, int K, bf16* WT, int row_off, LAS float* scr, int k0, int n0, int lane) {
    int col = n0 + (lane & 31);
    if (MAPPED) col = in_col(col);
#pragma unroll 8
    for (int i = 0; i < 32; ++i) { const int kk = 2 * i + (lane >> 5); scr[kk * 33 + (lane & 31)] = (col >= 0) ? W[(size_t)(k0 + kk) * ldw + col] : 0.f; }
    LDS_WAIT(); asm volatile("" ::: "memory");
    const int c = lane & 7;
#pragma unroll
    for (int j = 0; j < 4; ++j) { const int n = (lane >> 3) + 8 * j; const LAS float* s = scr + (8 * c) * 33 + n;
        u32x4 o; o.x = pk2(s[0 * 33], s[1 * 33]); o.y = pk2(s[2 * 33], s[3 * 33]); o.z = pk2(s[4 * 33], s[5 * 33]); o.w = pk2(s[6 * 33], s[7 * 33]);
        *(u32x4*)(WT + (size_t)(row_off + n0 + n) * K + k0 + 8 * c) = o; }
    LDS_WAIT(); asm volatile("" ::: "memory");
}
__device__ const float INVF[32] = {1.000000000e+00f, 7.498942018e-01f, 5.623413324e-01f, 4.216965139e-01f, 3.162277639e-01f, 2.371373773e-01f, 1.778279394e-01f, 1.333521456e-01f,
    1.000000015e-01f, 7.498942316e-02f, 5.623413250e-02f, 4.216964915e-02f, 3.162277490e-02f, 2.371373773e-02f, 1.778279431e-02f, 1.333521400e-02f,
    9.999999776e-03f, 7.498942316e-03f, 5.623413250e-03f, 4.216964822e-03f, 3.162277630e-03f, 2.371373819e-03f, 1.778279431e-03f, 1.333521446e-03f,
    1.000000047e-03f, 7.498941850e-04f, 5.623413017e-04f, 4.216965172e-04f, 3.162277571e-04f, 2.371373703e-04f, 1.778279402e-04f, 1.333521504e-04f};
__device__ __forceinline__ void sincos_acc(float a, float& s, float& c) {
    const double x = (double)a;
    const double kq = __builtin_rint(x * 0.63661977236758134308);
    double r = __builtin_fma(-kq, 1.5707963267948966192, x); r = __builtin_fma(-kq, 6.123233995736766e-17, r);
    const int q = ((int)kq) & 3;
    const double z = r * r;
    double sp = 1.0 / 6227020800.0; sp = sp * z - 1.0 / 39916800.0; sp = sp * z + 1.0 / 362880.0; sp = sp * z - 1.0 / 5040.0; sp = sp * z + 1.0 / 120.0; sp = sp * z - 1.0 / 6.0; sp = sp * z + 1.0; sp *= r;
    double cp = 1.0 / 479001600.0; cp = cp * z - 1.0 / 3628800.0; cp = cp * z + 1.0 / 40320.0; cp = cp * z - 1.0 / 720.0; cp = cp * z + 1.0 / 24.0; cp = cp * z - 0.5; cp = cp * z + 1.0;
    const double ss = (q == 0) ? sp : (q == 1) ? cp : (q == 2) ? -sp : -cp;
    const double cc = (q == 0) ? cp : (q == 1) ? -sp : (q == 2) ? -cp : sp;
    s = (float)ss; c = (float)cc;
}

__device__ __forceinline__ void p0_prologue(Frame& F, const int rep) {
    LAS float* scr = (LAS float*)(F.lds + F.wave * 16384);
    const int lane = F.lane;
    constexpr int I_IN = 32 * 344, I_ON = 16 * 64, I_OUT = 32 * 64, I_W1 = 4 * 16 * 4, I_W2 = 2 * 2 * 2;
    constexpr int NITEMS = I_IN + 2 * I_ON + I_OUT + I_W1 + I_W2;
    for (int it = F.gw; it < NITEMS; it += F.NGW) {
        int r = it;
        if (r < I_IN) { transpose_item<true>(F.w_in, 10816, 2048, WSP(bf16, WS_WIN), 0, scr, 64 * (r / 344), 32 * (r % 344), lane); continue; } r -= I_IN;
        if (r < I_ON) { transpose_item<false>(F.w_on, 2048, 1024, WSP(bf16, WS_WON), 0, scr, 64 * (r / 64), 32 * (r % 64), lane); continue; } r -= I_ON;
        if (r < I_ON) { transpose_item<false>(F.w_og, 2048, 1024, WSP(bf16, WS_WOG), 0, scr, 64 * (r / 64), 32 * (r % 64), lane); continue; } r -= I_ON;
        if (r < I_OUT) { transpose_item<false>(F.w_out, 2048, 2048, WSP(bf16, WS_WOUT), 0, scr, 64 * (r / 64), 32 * (r % 64), lane); continue; } r -= I_OUT;
        if (r < I_W1) { const int xj = r / 64, rr = r % 64;
            transpose_item<false>(F.cmp_w1 + (size_t)xj * 1024 * 128, 128, 1024, WSP(bf16, WS_W1T) + (size_t)(xj >> 1) * 256 * 1024, (xj & 1) * 128, scr, 64 * (rr / 4), 32 * (rr % 4), lane); continue; } r -= I_W1;
        { const int x = r / 4, rr = r % 4;
            transpose_item<false>(F.cmp_w2 + (size_t)x * 128 * 64, 64, 128, WSP(bf16, WS_POSB + 4096) + (size_t)x * 64 * 128, 0, scr, 64 * (rr / 2), 32 * (rr % 2), lane); }
    }
    for (int it = F.gw; it < 256; it += F.NGW) {
        const int x = it >> 7, e = it & 127; float s = 0.f;
        for (int i = 0; i < 32; ++i) { const int ld = i * 64 + lane; s += F.cmp_pos[x * 2048 + ld] * F.cmp_w1[((size_t)x * 2048 + ld) * 128 + e]; }
        s = wave_sum(s);
        if (lane == 0) WSP(float, WS_POSB)[it] = s + F.cmp_b1[it];
    }
    for (int i = F.gw * 64 + lane; i < 8200 * 32; i += F.NGW * 64) {
        const int pos = i >> 5, j = i & 31; const float ang = (float)pos * INVF[j]; float s, c; sincos_acc(ang, s, c);
        WSP(float, WS_ROPE)[pos * 64 + j] = c; WSP(float, WS_ROPE)[pos * 64 + 32 + j] = s;
    }
    for (int item = blockIdx.x; item < (rep ? 0 : 256); item += F.G) {
        const int cg = item & 31, ks = item >> 5;
        LAS float* cl = (LAS float*)(F.lds);
        LAS float* accl = (LAS float*)(F.lds + 33 * 256 * 4);
        __syncthreads();
        for (int i = F.tid; i < 33 * 256; i += 512) { const int r = i >> 8, kk = i & 255; cl[i] = (r == 0) ? F.c_p[ks * 256 + kk] : F.c_s[(r - 1) * 2048 + ks * 256 + kk]; }
        for (int i = F.tid; i < 33 * 192; i += 512) accl[i] = 0.f;
        __syncthreads();
        if (lane < 48) {
            f32x4 acc[33];
#pragma unroll
            for (int r = 0; r < 33; ++r) acc[r] = (f32x4){0.f, 0.f, 0.f, 0.f};
            const float* wp = F.w_ada + (size_t)(ks * 256 + F.wave * 32) * NMOD + cg * 192 + lane * 4;
#pragma unroll 1
            for (int kk0 = 0; kk0 < 32; kk0 += 4) {
                f32x4 w[4];
#pragma unroll
                for (int j = 0; j < 4; ++j) w[j] = *(const f32x4*)(wp + (size_t)(kk0 + j) * NMOD);
#pragma unroll
                for (int j = 0; j < 4; ++j) {
#pragma unroll
                    for (int r = 0; r < 33; ++r) acc[r] += w[j] * cl[r * 256 + F.wave * 32 + kk0 + j];
                    __builtin_amdgcn_sched_barrier(0);
                }
            }
#pragma unroll
            for (int r = 0; r < 33; ++r) { LAS float* a = accl + r * 192 + lane * 4;
                atomicAdd((float*)(a + 0), acc[r].x); atomicAdd((float*)(a + 1), acc[r].y); atomicAdd((float*)(a + 2), acc[r].z); atomicAdd((float*)(a + 3), acc[r].w); }
        }
        __syncthreads();
        for (int i = F.tid; i < 33 * 192; i += 512) { const int r = i / 192, cc = i % 192;
            const float v = accl[i] + ((ks == 0) ? F.b_ada[cg * 192 + cc] : 0.f);
            atomicAdd(WSP(unsigned long long, WS_MOD) + (size_t)r * NMOD + cg * 192 + cc, (unsigned long long)(long long)__builtin_rintf(v * MOD_SCALE)); }
        __syncthreads();
    }
    {
        bf16* CB = WSP(bf16, WS_CB);
        const int x = lane >> 5, h = (lane >> 3) & 3, d0 = (lane & 7) * 8;
        for (int it = F.gw; it < NBATCH_S * NPAGE; it += F.NGW) {
            const int b = it >> 6, pj = it & 63;
            const int page = F.ptab[it];
            const float* src = F.c_cmp + (size_t)page * 128 * 512 + lane * 8;
            bf16* dst = CB + (size_t)x * CB_X + ((size_t)(b * 4 + h) * 8192 + pj * 128) * 64 + d0;
#pragma unroll 1
            for (int r0 = 0; r0 < 128; r0 += 8) {
                f32x4 a[8], c[8];
#pragma unroll
                for (int j = 0; j < 8; ++j) { a[j] = *(const f32x4*)(src + (size_t)(r0 + j) * 512); c[j] = *(const f32x4*)(src + (size_t)(r0 + j) * 512 + 4); }
#pragma unroll
                for (int j = 0; j < 8; ++j) *(u32x4*)(dst + (size_t)(r0 + j) * 64) = pack8(a[j], c[j]);
            }
        }
    }
    {
        const f32x4* src = (const f32x4*)F.c_win; f32x4* dst = (f32x4*)(F.out + O_WINS);
        for (int i = F.gw * 64 + lane; i < NBATCH_S * 504 * 128; i += F.NGW * 64) {
            const int b = i / (504 * 128), o = i % (504 * 128);
            dst[(size_t)b * 512 * 128 + o] = src[(size_t)b * 512 * 128 + 8 * 128 + o];
        }
    }
}

__device__ __forceinline__ void p1_modnorm(Frame& F) {
    const long long* MOD = WSP(long long, WS_MOD);
    bf16* H = WSP(bf16, WS_H);
    for (int r = F.gw; r < MROWS; r += F.NGW) {
        const float* xr = (r < TP) ? F.x_p + (size_t)r * DM : F.x_s + (size_t)(r - TP) * DM;
        const long long* mr = MOD + (size_t)((r < TP) ? 0 : 1 + ((r - TP) >> 3)) * NMOD;
        f32x4 v[8]; float ss = 0.f;
#pragma unroll
        for (int j = 0; j < 8; ++j) { v[j] = *(const f32x4*)(xr + (j * 64 + F.lane) * 4); ss += (v[j].x * v[j].x + v[j].y * v[j].y) + (v[j].z * v[j].z + v[j].w * v[j].w); }
        const float rstd = 1.f / sqrtf(wave_sum(ss) * (1.f / DM) + 1e-6f);
#pragma unroll
        for (int j = 0; j < 8; ++j) {
            const int c = (j * 64 + F.lane) * 4;
            const f32x4 nw = *(const f32x4*)(F.norm_w + c);
            const f32x4 sh = (f32x4){(float)mr[c], (float)mr[c + 1], (float)mr[c + 2], (float)mr[c + 3]} * MOD_INV;
            const f32x4 sc = (f32x4){(float)mr[2048 + c], (float)mr[2048 + c + 1], (float)mr[2048 + c + 2], (float)mr[2048 + c + 3]} * MOD_INV;
            const f32x4 hv = (v[j] * rstd) * nw * (sc + 1.0f) + sh;
            u32x2 o; o.x = pk2(hv.x, hv.y); o.y = pk2(hv.z, hv.w);
            *(u32x2*)(H + (size_t)r * DM + c) = o;
        }
    }
}


struct EpiPlainBf16 {
    static constexpr bool PERM = true, AFTER_DRAIN = false;
    bf16* O; int ldc;
    __device__ __forceinline__ void operator()(const f32x4 (&acc)[2][2][4][2], const pg8::Unit& u, int wr, int wc, int fr, int fq) const {
#pragma unroll
        for (int ai = 0; ai < 2; ++ai)
#pragma unroll
            for (int m = 0; m < 4; ++m) { const size_t row = (size_t)u.pm * 256 + ai * 128 + wr * 64 + m * 16 + fr;
#pragma unroll
                for (int bj = 0; bj < 2; ++bj) { const int col = u.pn * 256 + bj * 128 + wc * 32 + fq * 8;
                    *(u32x4*)(O + row * ldc + col) = pack8(acc[ai][bj][m][0], acc[ai][bj][m][1]); } }
    }
};

struct EpiIn {
    static constexpr bool PERM = true, AFTER_DRAIN = false;
    float* out; unsigned char* ws;
    __device__ __forceinline__ void operator()(const f32x4 (&acc)[2][2][4][2], const pg8::Unit& u, int wr, int wc, int fr, int fq) const {
        const int tile = u.pn;
        const float* ROPE = (const float*)(ws + WS_ROPE);
#pragma unroll
        for (int ai = 0; ai < 2; ++ai)
#pragma unroll
            for (int m = 0; m < 4; ++m) {
                const int row = u.pm * 256 + ai * 128 + wr * 64 + m * 16 + fr;
                const int pos = (row < TP) ? row : TP + ((row - TP) & 7);
#pragma unroll
                for (int bj = 0; bj < 2; ++bj) {
                    const int pc = bj * 128 + wc * 32 + fq * 8;
                    f32x4 v0 = acc[ai][bj][m][0], v1 = acc[ai][bj][m][1];
                    if (tile < 10) {
                        const int hh = pc >> 6, pp = pc & 63, j8 = pp >> 3;
                        const bool is_q = tile < 4; const int t = tile - 4, br = t >> 1, x = t & 1;
                        int d0, d1;
                        if (is_q || x == 0) {
                            const f32x4 cs = *(const f32x4*)(ROPE + (size_t)pos * 64 + 4 * j8), sn = *(const f32x4*)(ROPE + (size_t)pos * 64 + 32 + 4 * j8);
                            const f32x4 lo = v0 * cs - v1 * sn, hi = v1 * cs + v0 * sn; v0 = lo; v1 = hi; d0 = 4 * j8; d1 = 32 + 4 * j8;
                        } else { d0 = pp; d1 = pp + 4; }
                        if (is_q) {
                            bf16* q = (bf16*)(ws + WS_QB) + (size_t)row * 1024 + (tile * 4 + hh) * 64;
                            *(u32x2*)(q + d0) = pack4(v0 * QSCALE); *(u32x2*)(q + d1) = pack4(v1 * QSCALE);
                        } else {
                            const int co = x * 256 + hh * 64;
                            float* o = nullptr;
                            if (row < TP) {
                                if (br == 0) o = out + O_CMPP + (size_t)row * 512 + co;
                                else if (br == 1) o = out + O_SELP + (size_t)row * 512 + co;
                                else if (row >= TP - 512) o = out + O_WINP + (size_t)(row - (TP - 512)) * 512 + co;
                                bf16* kb = (br == 0) ? (bf16*)(ws + WS_CB) + (size_t)x * CB_X + ((size_t)(32 * 4 + hh) * 8192 + row) * 64
                                                     : (bf16*)(ws + WS_KVB) + ((size_t)(((br - 1) * 2 + x) * 4 + hh) * 8192 + row) * 64;
                                *(u32x2*)(kb + d0) = pack4(v0); *(u32x2*)(kb + d1) = pack4(v1);
                            } else {
                                const int sr = row - TP;
                                if (br == 0) o = out + O_CMPS + (size_t)sr * 512 + co;
                                else if (br == 1) o = out + O_SELS + (size_t)sr * 512 + co;
                                else o = out + O_WINS + ((size_t)(sr >> 3) * 512 + 504 + (sr & 7)) * 512 + co;
                            }
                            if (o) { *(f32x4*)(o + d0) = v0; *(f32x4*)(o + d1) = v1; }
                        }
                    } else if (tile < 14) {
                        const int col = (tile - 10) * 256 + pc;
                        v0 = (f32x4){silu(v0.x), silu(v0.y), silu(v0.z), silu(v0.w)}; v1 = (f32x4){silu(v1.x), silu(v1.y), silu(v1.z), silu(v1.w)};
                        *(u32x4*)((bf16*)(ws + WS_ZN) + (size_t)row * 1024 + col) = pack8(v0, v1);
                    } else if (tile < 16) {
                        *(u32x4*)((bf16*)(ws + WS_QG) + (size_t)row * 512 + (tile - 14) * 256 + pc) = pack8(v0 * GQSCALE, v1 * GQSCALE);
                    } else if (tile < 18) {
                        *(u32x4*)((bf16*)(ws + WS_KG) + (size_t)row * 512 + (tile - 16) * 256 + pc) = pack8(v0, v1);
                    } else if (tile < 22) {
                        const int col = (tile - 18) * 256 + pc;
                        if (row < TP) {
                            bf16* vt = (bf16*)(ws + WS_VGT) + ((size_t)(row >> 6) * 1024 + col) * 64 + (row & 63);
                            vt[0 * 64] = (bf16)f2bf(v0.x); vt[1 * 64] = (bf16)f2bf(v0.y); vt[2 * 64] = (bf16)f2bf(v0.z); vt[3 * 64] = (bf16)f2bf(v0.w);
                            vt[4 * 64] = (bf16)f2bf(v1.x); vt[5 * 64] = (bf16)f2bf(v1.y); vt[6 * 64] = (bf16)f2bf(v1.z); vt[7 * 64] = (bf16)f2bf(v1.w);
                        } else {
                            float* vs = (float*)(ws + WS_VGS) + (size_t)(row - TP) * 1024 + col;
                            *(f32x4*)vs = v0; *(f32x4*)(vs + 4) = v1;
                        }
                    } else if (tile < 26) {
                        const int col = (tile - 22) * 256 + pc;
                        v0 = (f32x4){silu(v0.x), silu(v0.y), silu(v0.z), silu(v0.w)}; v1 = (f32x4){silu(v1.x), silu(v1.y), silu(v1.z), silu(v1.w)};
                        *(u32x4*)((bf16*)(ws + WS_ZG) + (size_t)row * 1024 + col) = pack8(v0, v1);
                    } else if (tile < 42) {
                        const bool mn = tile < 34; const int col = (tile - (mn ? 26 : 34)) * 256 + pc;
                        v0 = (f32x4){sigm(v0.x), sigm(v0.y), sigm(v0.z), sigm(v0.w)}; v1 = (f32x4){sigm(v1.x), sigm(v1.y), sigm(v1.z), sigm(v1.w)};
                        *(u32x4*)((bf16*)(ws + (mn ? WS_MN : WS_MG)) + (size_t)row * 2048 + col) = pack8(v0, v1);
                    } else {
                        if (pc < 48) {
                            v0 = (f32x4){sigm(v0.x), sigm(v0.y), sigm(v0.z), sigm(v0.w)}; v1 = (f32x4){sigm(v1.x), sigm(v1.y), sigm(v1.z), sigm(v1.w)};
                            float* g = (float*)(ws + WS_GB) + (size_t)row * 48 + pc; *(f32x4*)g = v0; *(f32x4*)(g + 4) = v1;
                        } else if (pc < 64) {
                            float* a = (float*)(ws + WS_AG) + (size_t)row * 16 + (pc - 48); *(f32x4*)a = v0; *(f32x4*)(a + 4) = v1;
                        }
                    }
                }
            }
    }
};

template <bool SECOND> struct EpiMerge {
    static constexpr bool PERM = true, AFTER_DRAIN = false;
    const bf16* G; bf16* O;
    __device__ __forceinline__ void operator()(const f32x4 (&acc)[2][2][4][2], const pg8::Unit& u, int wr, int wc, int fr, int fq) const {
#pragma unroll
        for (int ai = 0; ai < 2; ++ai)
#pragma unroll
            for (int m = 0; m < 4; ++m) { const size_t row = (size_t)u.pm * 256 + ai * 128 + wr * 64 + m * 16 + fr;
#pragma unroll
                for (int bj = 0; bj < 2; ++bj) { const int col = u.pn * 256 + bj * 128 + wc * 32 + fq * 8;
                    const u32x4 g = *(const u32x4*)(G + row * 2048 + col);
                    f32x4 v0 = acc[ai][bj][m][0] * (f32x4){bflo(g.x), bfhi(g.x), bflo(g.y), bfhi(g.y)};
                    f32x4 v1 = acc[ai][bj][m][1] * (f32x4){bflo(g.z), bfhi(g.z), bflo(g.w), bfhi(g.w)};
                    if (SECOND) { const u32x4 p = *(const u32x4*)(O + row * 2048 + col);
                        v0 += (f32x4){bflo(p.x), bfhi(p.x), bflo(p.y), bfhi(p.y)}; v1 += (f32x4){bflo(p.z), bfhi(p.z), bflo(p.w), bfhi(p.w)}; }
                    *(u32x4*)(O + row * 2048 + col) = pack8(v0, v1); } }
    }
};
struct EpiOut {
    static constexpr bool PERM = true, AFTER_DRAIN = false;
    const float* x_p; const float* x_s; const long long* MOD; float* out; float* RSS;
    __device__ __forceinline__ void operator()(const f32x4 (&acc)[2][2][4][2], const pg8::Unit& u, int wr, int wc, int fr, int fq) const {
#pragma unroll
        for (int ai = 0; ai < 2; ++ai)
#pragma unroll
            for (int m = 0; m < 4; ++m) { const int row = u.pm * 256 + ai * 128 + wr * 64 + m * 16 + fr;
                const float* xr = (row < TP) ? x_p + (size_t)row * DM : x_s + (size_t)(row - TP) * DM;
                const long long* gr = MOD + (size_t)((row < TP) ? 0 : 1 + ((row - TP) >> 3)) * NMOD + 4096;
                float* yr = out + ((row < TP) ? O_YP + (size_t)row * DM : O_YS + (size_t)(row - TP) * DM);
                float ss = 0.f;
#pragma unroll
                for (int bj = 0; bj < 2; ++bj) { const int col = u.pn * 256 + bj * 128 + wc * 32 + fq * 8;
#pragma unroll
                    for (int n = 0; n < 2; ++n) { const long long* gp = gr + col + 4 * n; const f32x4 gt = (f32x4){(float)gp[0], (float)gp[1], (float)gp[2], (float)gp[3]} * MOD_INV;
                        const f32x4 y = *(const f32x4*)(xr + col + 4 * n) + gt * acc[ai][bj][m][n];
                        *(f32x4*)(yr + col + 4 * n) = y; ss += (y.x * y.x + y.y * y.y) + (y.z * y.z + y.w * y.w); } }
                ss += __shfl_xor(ss, 16); ss += __shfl_xor(ss, 32);
                if (fq == 0) RSS[(size_t)row * 64 + u.pn * 4 + wc] = ss; }
    }
};


template <class Epi>
__device__ __forceinline__ void wave_gemm_tiles(Frame& F, const bf16* A, int lda, const bf16* Bt, int ldb, int m0, int mtiles, int ntiles, int K, const Epi& E) {
    const int lane = F.lane, c = lane & 31, h = lane >> 5, grp = F.wave >> 2, ks = F.wave & 3, kq = K >> 2;
    LAS float* red = (LAS float*)(F.lds) + (grp * 3) * 1024;
    const int T = mtiles * ntiles;
    for (int t2 = blockIdx.x; 2 * t2 < T; t2 += F.G) {
        const int t = 2 * t2 + grp;
        const int tm = t / ntiles, tn = t % ntiles;
        const bf16* ap = A + (size_t)(m0 + 32 * tm + c) * lda + ks * kq + 8 * h;
        const bf16* bp = Bt + (size_t)(32 * tn + c) * ldb + ks * kq + 8 * h;
        f32x16 acc;
#pragma unroll
        for (int r = 0; r < 16; ++r) acc[r] = 0.f;
#pragma unroll 8
        for (int k = 0; k < kq; k += 16) { const bf16x8 a = *(const bf16x8*)(ap + k), b = *(const bf16x8*)(bp + k); acc = __builtin_amdgcn_mfma_f32_32x32x16_bf16(a, b, acc, 0, 0, 0); }
        __syncthreads();
        if (ks != 0) {
#pragma unroll
            for (int r = 0; r < 16; ++r) red[((ks - 1) * 16 + r) * 64 + lane] = acc[r];
        }
        __syncthreads();
        if (ks == 0) {
#pragma unroll
            for (int r = 0; r < 16; ++r) acc[r] += (red[(0 * 16 + r) * 64 + lane] + red[(1 * 16 + r) * 64 + lane]) + red[(2 * 16 + r) * 64 + lane];
            E(acc, m0 + 32 * tm, 32 * tn, tn, lane);
        }
    }
    __syncthreads();
}
struct SEpiPlain { bf16* O; int ldc;
    __device__ __forceinline__ void operator()(const f32x16& acc, int m0, int n0, int tn, int lane) const { const int c = lane & 31, h = lane >> 5;
#pragma unroll
        for (int r = 0; r < 16; ++r) O[(size_t)(m0 + (r & 3) + 8 * (r >> 2) + 4 * h) * ldc + n0 + c] = (bf16)f2bf(acc[r]); } };
template <bool SECOND> struct SEpiMerge { const bf16* G; bf16* O;
    __device__ __forceinline__ void operator()(const f32x16& acc, int m0, int n0, int tn, int lane) const { const int c = lane & 31, h = lane >> 5;
#pragma unroll
        for (int r = 0; r < 16; ++r) { const size_t idx = (size_t)(m0 + (r & 3) + 8 * (r >> 2) + 4 * h) * 2048 + n0 + c;
            float v = acc[r] * bf2f(G[idx]); if (SECOND) v += bf2f(O[idx]); O[idx] = (bf16)f2bf(v); } } };
struct SEpiOut { const float* x_s; const long long* MOD; float* out; float* RSS;
    __device__ __forceinline__ void operator()(const f32x16& acc, int m0, int n0, int tn, int lane) const { const int c = lane & 31, h = lane >> 5;
#pragma unroll
        for (int r = 0; r < 16; ++r) { const int row = m0 + (r & 3) + 8 * (r >> 2) + 4 * h, sr = row - TP;
            const float y = x_s[(size_t)sr * DM + n0 + c] + ((float)MOD[(size_t)(1 + (sr >> 3)) * NMOD + 4096 + n0 + c] * MOD_INV) * acc[r];
            out[O_YS + (size_t)sr * DM + n0 + c] = y;
            float ss = y * y; ss += __shfl_xor(ss, 1); ss += __shfl_xor(ss, 2); ss += __shfl_xor(ss, 4); ss += __shfl_xor(ss, 8); ss += __shfl_xor(ss, 16);
            if (c == 0) RSS[(size_t)row * 64 + tn] = ss; } } };

__device__ __forceinline__ void compress_l2(Frame& F) {
    const int lane = F.lane, c32 = lane & 31, h = lane >> 5;
    const float* POSB = WSP(float, WS_POSB);
    for (int x = 0; x < 2; ++x) {
        const bf16* W2T = WSP(bf16, WS_POSB + 4096) + (size_t)x * 64 * 128;
        const bf16* PART = WSP(bf16, WS_PART) + (size_t)x * CROWS * 256;
        bf16* KC = WSP(bf16, WS_KC) + (size_t)x * CROWS * 64;
        bf16x8 bfr[2][8];
#pragma unroll
        for (int dt = 0; dt < 2; ++dt)
#pragma unroll
            for (int ks = 0; ks < 8; ++ks) bfr[dt][ks] = *(const bf16x8*)(W2T + (size_t)(32 * dt + c32) * 128 + 16 * ks + 8 * h);
        const float b2a = F.cmp_b2[x * 64 + c32], b2b = F.cmp_b2[x * 64 + 32 + c32];
        for (int it = F.gw; it < CROWS / 32; it += F.NGW) {
            const size_t row = (size_t)it * 32 + c32;
            f32x16 o0, o1;
#pragma unroll
            for (int r = 0; r < 16; ++r) { o0[r] = 0.f; o1[r] = 0.f; }
#pragma unroll
            for (int ks = 0; ks < 8; ++ks) {
                const int e0 = 16 * ks + 8 * h;
                const u32x4 p0 = *(const u32x4*)(PART + row * 256 + e0), p1 = *(const u32x4*)(PART + (row + 1) * 256 + 128 + e0);
                const f32x4 ba = *(const f32x4*)(POSB + x * 128 + e0), bb = *(const f32x4*)(POSB + x * 128 + e0 + 4);
                f32x4 a = (f32x4){bflo(p0.x) + bflo(p1.x), bfhi(p0.x) + bfhi(p1.x), bflo(p0.y) + bflo(p1.y), bfhi(p0.y) + bfhi(p1.y)} + ba;
                f32x4 b = (f32x4){bflo(p0.z) + bflo(p1.z), bfhi(p0.z) + bfhi(p1.z), bflo(p0.w) + bflo(p1.w), bfhi(p0.w) + bfhi(p1.w)} + bb;
                a = (f32x4){silu(a.x), silu(a.y), silu(a.z), silu(a.w)}; b = (f32x4){silu(b.x), silu(b.y), silu(b.z), silu(b.w)};
                const u32x4 hp = pack8(a, b); const bf16x8 hf = __builtin_bit_cast(bf16x8, hp);
                o0 = __builtin_amdgcn_mfma_f32_32x32x16_bf16(hf, bfr[0][ks], o0, 0, 0, 0);
                o1 = __builtin_amdgcn_mfma_f32_32x32x16_bf16(hf, bfr[1][ks], o1, 0, 0, 0);
            }
#pragma unroll
            for (int r = 0; r < 16; ++r) {
                const size_t orow = (size_t)it * 32 + (r & 3) + 8 * (r >> 2) + 4 * h;
                const bool dead = (orow & 511) == 511;
                KC[orow * 64 + c32] = dead ? (bf16)0 : (bf16)f2bf(o0[r] + b2a);
                KC[orow * 64 + 32 + c32] = dead ? (bf16)0 : (bf16)f2bf(o1[r] + b2b);
            }
        }
    }
}

__device__ __forceinline__ void final_norm(Frame& F) {
    const float* RSS = WSP(float, WS_RSS);
    for (int r = F.gw; r < MROWS; r += F.NGW) {
        float* yr = F.out + ((r < TP) ? O_YP + (size_t)r * DM : O_YS + (size_t)(r - TP) * DM);
        float ss = (F.lane < 32 || r >= TP) ? RSS[(size_t)r * 64 + F.lane] : 0.f;
        const float rstd = 1.f / sqrtf(wave_sum(ss) * (1.f / DM) + 1e-6f);
#pragma unroll
        for (int j = 0; j < 8; ++j) { const int c = (j * 64 + F.lane) * 4;
            const f32x4 v = *(const f32x4*)(yr + c) * rstd * *(const f32x4*)(F.fnw + c); *(f32x4*)(yr + c) = v; }
    }
}

constexpr int KTLD = 72;
typedef short v4i16_t __attribute__((ext_vector_type(4)));
__device__ __forceinline__ s16x4 tr_read(const LAS bf16* p) { return __builtin_bit_cast(s16x4, __builtin_amdgcn_ds_read_tr16_b64_v4i16((LAS v4i16_t*)p)); }
__device__ __forceinline__ unsigned cvtpk(float lo, float hi) { unsigned r; asm("v_cvt_pk_bf16_f32 %0, %1, %2" : "=v"(r) : "v"(lo), "v"(hi)); return r; }

template <int NKT>
__device__ __forceinline__ void qk_scores(f32x16 (&s)[NKT], const LAS bf16* Kt, const bf16x8 (&qf)[4], int lane) {
    const int c = lane & 31, h = lane >> 5;
#pragma unroll
    for (int kt = 0; kt < NKT; ++kt) {
#pragma unroll
        for (int r = 0; r < 16; ++r) s[kt][r] = 0.f;
#pragma unroll
        for (int ks = 0; ks < 4; ++ks) {
            const bf16x8 a = *(const LAS bf16x8*)(Kt + (32 * kt + c) * KTLD + 16 * ks + 8 * h);
            s[kt] = __builtin_amdgcn_mfma_f32_32x32x16_bf16(a, qf[ks], s[kt], 0, 0, 0);
        }
    }
}
template <int NKT>
__device__ __forceinline__ void pv_accum(f32x16 (&o)[2], const f32x16 (&p)[NKT], const LAS bf16* Vt, int lane) {
    const int i16 = lane & 15, g16 = lane >> 4, h = lane >> 5;
    const LAS bf16* vb = Vt + (4 * h + (i16 >> 2)) * KTLD + 16 * (g16 & 1) + 4 * (i16 & 3);
#pragma unroll
    for (int kt = 0; kt < NKT; ++kt)
#pragma unroll
        for (int s2 = 0; s2 < 2; ++s2) {
            u32x4 pw; pw.x = cvtpk(p[kt][8 * s2 + 0], p[kt][8 * s2 + 1]); pw.y = cvtpk(p[kt][8 * s2 + 2], p[kt][8 * s2 + 3]);
            pw.z = cvtpk(p[kt][8 * s2 + 4], p[kt][8 * s2 + 5]); pw.w = cvtpk(p[kt][8 * s2 + 6], p[kt][8 * s2 + 7]);
            const bf16x8 pf = __builtin_bit_cast(bf16x8, pw);
#pragma unroll
            for (int dt = 0; dt < 2; ++dt) {
                const s16x4 lo = tr_read(vb + (32 * kt + 16 * s2) * KTLD + 32 * dt), hi = tr_read(vb + (32 * kt + 16 * s2 + 8) * KTLD + 32 * dt);
                const bf16x8 vf = (bf16x8){lo[0], lo[1], lo[2], lo[3], hi[0], hi[1], hi[2], hi[3]};
                o[dt] = __builtin_amdgcn_mfma_f32_32x32x16_bf16(vf, pf, o[dt], 0, 0, 0);
            }
            __builtin_amdgcn_sched_barrier(0);
        }
}
template <int NKT>
__device__ __forceinline__ float mask_max(f32x16 (&s)[NKT], int lo, int hi, int h) {
    const int lo2 = lo - 4 * h, hi2 = hi - 4 * h; float mx = -1e30f;
#pragma unroll
    for (int kt = 0; kt < NKT; ++kt)
#pragma unroll
        for (int r = 0; r < 16; ++r) { const int ko = 32 * kt + (r & 3) + 8 * (r >> 2); const bool v = (ko >= lo2) && (ko <= hi2);
            const float x = v ? s[kt][r] : -1e30f; s[kt][r] = x; mx = fmaxf(mx, x); }
    return fmaxf(mx, __shfl_xor(mx, 32));
}
struct FlashSt { float m, l; f32x16 o[2]; };
__device__ __forceinline__ void flash_init(FlashSt& st) { st.m = -1e30f; st.l = 0.f;
#pragma unroll
    for (int r = 0; r < 16; ++r) { st.o[0][r] = 0.f; st.o[1][r] = 0.f; } }
template <int NKT>
__device__ __forceinline__ void flash_tile(FlashSt& st, const LAS bf16* Kt, const LAS bf16* Vt, const bf16x8 (&qf)[4], int lo, int hi, int lane) {
    f32x16 s[NKT];
    qk_scores<NKT>(s, Kt, qf, lane);
    const float mx = mask_max<NKT>(s, lo, hi, lane >> 5);
    const float mn = fmaxf(st.m, mx), alpha = ex2(st.m - mn); st.m = mn;
    float ps = 0.f;
#pragma unroll
    for (int kt = 0; kt < NKT; ++kt)
#pragma unroll
        for (int r = 0; r < 16; ++r) { const float x = s[kt][r]; const float p = (x > -1e29f) ? ex2(x - mn) : 0.f; s[kt][r] = p; ps += p; }
    st.l = st.l * alpha + ps;
#pragma unroll
    for (int r = 0; r < 16; ++r) { st.o[0][r] *= alpha; st.o[1][r] *= alpha; }
    pv_accum<NKT>(st.o, s, Vt, lane);
}
template <int NKT>
__device__ __forceinline__ void stats_tile(float& m, float& l, const LAS bf16* Kt, const bf16x8 (&qf)[4], int lo, int hi, int lane) {
    f32x16 s[NKT];
    qk_scores<NKT>(s, Kt, qf, lane);
    const float mx = mask_max<NKT>(s, lo, hi, lane >> 5);
    const float mn = fmaxf(m, mx), alpha = ex2(m - mn); m = mn;
    float ps = 0.f;
#pragma unroll
    for (int kt = 0; kt < NKT; ++kt)
#pragma unroll
        for (int r = 0; r < 16; ++r) { const float x = s[kt][r]; ps += (x > -1e29f) ? ex2(x - mn) : 0.f; }
    l = l * alpha + ps;
}
template <int NKT>
__device__ __forceinline__ void cmp2_tile(f32x16 (&o)[2], const LAS bf16* Kt, const LAS bf16* Vt, const bf16x8 (&qf)[4], int lo, int hi, float M, float invL,
                                          LAS float* impA, LAS float* impB, int q, int impld, int n_base, int lane) {
    f32x16 s[NKT];
    qk_scores<NKT>(s, Kt, qf, lane);
    (void)mask_max<NKT>(s, lo, hi, lane >> 5);
#pragma unroll
    for (int kt = 0; kt < NKT; ++kt)
#pragma unroll
        for (int r = 0; r < 16; ++r) { const float x = s[kt][r]; s[kt][r] = (x > -1e29f) ? ex2(x - M) * invL : 0.f; }
    const int h = lane >> 5;
#pragma unroll
    for (int kt = 0; kt < NKT; ++kt)
#pragma unroll
        for (int k4 = 0; k4 < 4; ++k4) {
            float s4 = (s[kt][4 * k4] + s[kt][4 * k4 + 1]) + (s[kt][4 * k4 + 2] + s[kt][4 * k4 + 3]), p3 = s[kt][4 * k4 + 3];
            s4 += __shfl_xor(s4, 8); s4 += __shfl_xor(s4, 16); p3 += __shfl_xor(p3, 8); p3 += __shfl_xor(p3, 16);
            if ((lane & 24) == 0) { const int n0 = n_base + 8 * kt + 2 * k4 + h; impA[q * impld + n0] = s4; impB[q * impld + n0 + 1] = p3; }
        }
    pv_accum<NKT>(o, s, Vt, lane);
}

constexpr int IMPLD = 130;
__device__ __forceinline__ void nsa_prompt_unit(Frame& F, int qt, int kvh) {
    const int tid = F.tid, lane = F.lane, w = F.wave, c = lane & 31, h = lane >> 5, qi = c & 7, g = c >> 3;
    LAS bf16* Kt0 = (LAS bf16*)(F.lds);
    LAS bf16* Vt0 = (LAS bf16*)(F.lds + 18432);
    LAS float* impA = (LAS float*)(F.lds + 36864);
    LAS float* impB = (LAS float*)(F.lds + 36864 + 33280);
    LAS unsigned* selb = (LAS unsigned*)(F.lds + 36864 + 66560);
    const int q_off = 8 * w + qi, token = 64 * qt + q_off, head = kvh * 4 + g;
    const bf16* QB = WSP(bf16, WS_QB);
    bf16x8 qf[4];
#pragma unroll
    for (int ks = 0; ks < 4; ++ks) qf[ks] = *(const bf16x8*)(QB + (size_t)token * 1024 + head * 64 + 16 * ks + 8 * h);
    const float* gbp = WSP(float, WS_GB) + (size_t)token * 48 + head * 3;
    const float gb_c = gbp[0], gb_s = gbp[1], gb_w = gbp[2];
    f32x16 oacc[2];
#pragma unroll
    for (int r = 0; r < 16; ++r) { oacc[0][r] = 0.f; oacc[1][r] = 0.f; }
    const int srow = tid >> 3, sch = tid & 7;
    const int lds_st = srow * KTLD + sch * 8;

    {
        const bf16* KCk = WSP(bf16, WS_KC) + ((size_t)(32 * 4 + kvh) * 512) * 64;
        const bf16* KCv = WSP(bf16, WS_KC) + (size_t)CROWS * 64 + ((size_t)(32 * 4 + kvh) * 512) * 64;
        int cmax = (token - 31) >> 4; if (cmax > 510) cmax = 510;
        const int nT = ((4 * qt + 2) >> 6) + 1;
        float m = -1e30f, l = 0.f;
        u32x4 kreg = *(const u32x4*)(KCk + (size_t)srow * 64 + sch * 8), vreg;
        for (int t = 0; t < nT; ++t) {
            LAS bf16* Kt = Kt0 + (t & 1) * 64 * KTLD;
            *(LAS u32x4*)(Kt + lds_st) = kreg;
            __syncthreads();
            if (t + 1 < nT) kreg = *(const u32x4*)(KCk + (size_t)((t + 1) * 64 + srow) * 64 + sch * 8);
            int hi = cmax - 64 * t; if (hi > 63) hi = 63;
            stats_tile<2>(m, l, Kt, qf, 0, hi, lane);
        }
        l += __shfl_xor(l, 32);
        const float invL = (l > 0.f) ? 1.f / l : 0.f;
        __syncthreads();
        kreg = *(const u32x4*)(KCk + (size_t)srow * 64 + sch * 8); vreg = *(const u32x4*)(KCv + (size_t)srow * 64 + sch * 8);
        f32x16 o[2];
#pragma unroll
        for (int r = 0; r < 16; ++r) { o[0][r] = 0.f; o[1][r] = 0.f; }
        for (int t = 0; t < nT; ++t) {
            LAS bf16* Kt = Kt0 + (t & 1) * 64 * KTLD; LAS bf16* Vt = Vt0 + (t & 1) * 64 * KTLD;
            *(LAS u32x4*)(Kt + lds_st) = kreg; *(LAS u32x4*)(Vt + lds_st) = vreg;
            __syncthreads();
            if (t + 1 < nT) { kreg = *(const u32x4*)(KCk + (size_t)((t + 1) * 64 + srow) * 64 + sch * 8); vreg = *(const u32x4*)(KCv + (size_t)((t + 1) * 64 + srow) * 64 + sch * 8); }
            int hi = cmax - 64 * t; if (hi > 63) hi = 63;
            cmp2_tile<2>(o, Kt, Vt, qf, 0, hi, m, invL, impA, impB, q_off, IMPLD, 16 * t, lane);
        }
#pragma unroll
        for (int r = 0; r < 16; ++r) { oacc[0][r] += gb_c * o[0][r]; oacc[1][r] += gb_c * o[1][r]; }
    }
    __syncthreads();
    if (tid < 256) selb[tid] = 0u;
    __syncthreads();
    if (qt <= 15) {
        if (tid < 64) selb[tid * 4] = (1u << (qt + 1)) - 1u;
    } else {
        const int q = tid >> 3, sub = tid & 7, nhi = qt - 2;
#pragma unroll 1
        for (int i = 0; i < 16; ++i) { const int n = sub + 8 * i; if (n >= 1 && n <= nhi) impA[q * IMPLD + n] += impB[q * IMPLD + n]; }
        __syncthreads();
#pragma unroll 1
        for (int i = 0; i < 16; ++i) {
            const int n = sub + 8 * i; bool sel;
            if (n >= 1 && n <= nhi) {
                const float v = impA[q * IMPLD + n]; int rank = 0;
#pragma unroll 4
                for (int mm = 1; mm <= nhi; ++mm) { const float vm = impA[q * IMPLD + mm]; rank += (vm > v || (vm == v && mm < n)) ? 1 : 0; }
                sel = rank < 13;
            } else sel = (n == 0 || n == qt || n == qt - 1);
            if (sel) atomicOr((unsigned*)&selb[q * 4 + (n >> 5)], 1u << (n & 31));
        }
    }
    __syncthreads();
    {
        const bf16* Kg = WSP(bf16, WS_KVB) + ((size_t)((0 * 2 + 0) * 4 + kvh) * 8192) * 64;
        const bf16* Vg = WSP(bf16, WS_KVB) + ((size_t)((0 * 2 + 1) * 4 + kvh) * 8192) * 64;
        const unsigned sw0 = selb[q_off * 4 + 0], sw1 = selb[q_off * 4 + 1], sw2 = selb[q_off * 4 + 2], sw3 = selb[q_off * 4 + 3];
        FlashSt st; flash_init(st);
#define LDT(kr, vr, blkn) { kr = *(const u32x4*)(Kg + (size_t)((blkn) * 64 + srow) * 64 + sch * 8); vr = *(const u32x4*)(Vg + (size_t)((blkn) * 64 + srow) * 64 + sch * 8); }
#define SEL_STEP(kr, vr, slot, blk) { LAS bf16* Kt = Kt0 + (slot) * 64 * KTLD; LAS bf16* Vt = Vt0 + (slot) * 64 * KTLD; \
            *(LAS u32x4*)(Kt + lds_st) = kr; *(LAS u32x4*)(Vt + lds_st) = vr; __syncthreads(); \
            if ((blk) + 2 <= qt) LDT(kr, vr, (blk) + 2) \
            const unsigned swd = ((blk) < 32) ? sw0 : ((blk) < 64) ? sw1 : ((blk) < 96) ? sw2 : sw3; const bool sq = (swd >> ((blk) & 31)) & 1u; \
            const int lo = sq ? 0 : 1, hi = sq ? (((blk) == qt) ? q_off : 63) : 0; flash_tile<2>(st, Kt, Vt, qf, lo, hi, lane); }
        u32x4 kA, vA, kB = (u32x4){0u, 0u, 0u, 0u}, vB = kB;
        LDT(kA, vA, 0) if (qt >= 1) LDT(kB, vB, 1)
        for (int blk = 0; blk <= qt; blk += 2) {
            SEL_STEP(kA, vA, 0, blk)
            if (blk + 1 > qt) break;
            SEL_STEP(kB, vB, 1, blk + 1)
        }
#undef SEL_STEP
        const float lt = st.l + __shfl_xor(st.l, 32); const float sc = (lt > 0.f) ? gb_s / lt : 0.f;
#pragma unroll
        for (int r = 0; r < 16; ++r) { oacc[0][r] += sc * st.o[0][r]; oacc[1][r] += sc * st.o[1][r]; }
    }
    __syncthreads();
    {
        const bf16* Kg = WSP(bf16, WS_KVB) + ((size_t)((1 * 2 + 0) * 4 + kvh) * 8192) * 64;
        const bf16* Vg = WSP(bf16, WS_KVB) + ((size_t)((1 * 2 + 1) * 4 + kvh) * 8192) * 64;
        const int b0 = (qt >= 8) ? qt - 8 : 0;
        FlashSt st; flash_init(st);
#define WIN_STEP(kr, vr, slot, blk) { LAS bf16* Kt = Kt0 + (slot) * 64 * KTLD; LAS bf16* Vt = Vt0 + (slot) * 64 * KTLD; \
            *(LAS u32x4*)(Kt + lds_st) = kr; *(LAS u32x4*)(Vt + lds_st) = vr; __syncthreads(); \
            if ((blk) + 2 <= qt) LDT(kr, vr, (blk) + 2) \
            const int lo = ((blk) == qt - 8) ? q_off + 1 : 0, hi = ((blk) == qt) ? q_off : 63; flash_tile<2>(st, Kt, Vt, qf, lo, hi, lane); }
        u32x4 kA, vA, kB = (u32x4){0u, 0u, 0u, 0u}, vB = kB;
        LDT(kA, vA, b0) if (b0 + 1 <= qt) LDT(kB, vB, b0 + 1)
        for (int blk = b0; blk <= qt; blk += 2) {
            WIN_STEP(kA, vA, 0, blk)
            if (blk + 1 > qt) break;
            WIN_STEP(kB, vB, 1, blk + 1)
        }
#undef WIN_STEP
#undef LDT
        const float lt = st.l + __shfl_xor(st.l, 32); const float sc = (lt > 0.f) ? gb_w / lt : 0.f;
#pragma unroll
        for (int r = 0; r < 16; ++r) { oacc[0][r] += sc * st.o[0][r]; oacc[1][r] += sc * st.o[1][r]; }
    }
    __syncthreads();
    {
        const bf16* zn = WSP(bf16, WS_ZN) + (size_t)token * 1024 + head * 64;
        bf16* on = WSP(bf16, WS_ONSA) + (size_t)token * 1024 + head * 64;
#pragma unroll
        for (int dt = 0; dt < 2; ++dt)
#pragma unroll
            for (int k4 = 0; k4 < 4; ++k4) { const int d = 32 * dt + 8 * k4 + 4 * h;
                const u32x2 z = *(const u32x2*)(zn + d);
                const f32x4 v = (f32x4){oacc[dt][4 * k4] * bflo(z.x), oacc[dt][4 * k4 + 1] * bfhi(z.x), oacc[dt][4 * k4 + 2] * bflo(z.y), oacc[dt][4 * k4 + 3] * bfhi(z.y)};
                *(u32x2*)(on + d) = pack4(v); }
    }
}

__device__ __forceinline__ void stage_half_f32(LAS bf16* dst, const float* base, int nvalid, int lane) {
    const int row = lane >> 1, hf = lane & 1;
    const float* s = base + (size_t)row * 512 + hf * 32;
#pragma unroll
    for (int i = 0; i < 4; ++i) {
        u32x4 o = (u32x4){0u, 0u, 0u, 0u};
        if (row < nvalid) { const f32x4 a = *(const f32x4*)(s + 8 * i), b2 = *(const f32x4*)(s + 8 * i + 4); o = pack8(a, b2); }
        *(LAS u32x4*)(dst + row * KTLD + hf * 32 + 8 * i) = o;
    }
}
__device__ __forceinline__ void stage_half_bf16(LAS bf16* dst, const bf16* base, int lane) {
    const int row = lane >> 1, hf = lane & 1;
#pragma unroll
    for (int i = 0; i < 4; ++i) *(LAS u32x4*)(dst + row * KTLD + hf * 32 + 8 * i) = *(const u32x4*)(base + (size_t)row * 64 + hf * 32 + 8 * i);
}
__device__ __forceinline__ void merge_partials(const LAS float* mlb, const LAS float* comb, int lane, f32x16 (&o)[2], float& L) {
    const int c = lane & 31;
    float M = -1e30f;
#pragma unroll
    for (int ww = 0; ww < 8; ++ww) M = fmaxf(M, mlb[(ww * 64 + lane) * 2]);
    L = 0.f;
#pragma unroll
    for (int r = 0; r < 16; ++r) { o[0][r] = 0.f; o[1][r] = 0.f; }
#pragma unroll 1
    for (int ww = 0; ww < 8; ++ww) {
        const float f = ex2(mlb[(ww * 64 + lane) * 2] - M);
        L += (mlb[(ww * 64 + c) * 2 + 1] + mlb[(ww * 64 + c + 32) * 2 + 1]) * f;
#pragma unroll
        for (int r = 0; r < 16; ++r) { o[0][r] += comb[(ww * 32 + r) * 64 + lane] * f; o[1][r] += comb[(ww * 32 + 16 + r) * 64 + lane] * f; }
    }
}
__device__ __forceinline__ void nsa_sample_unit(Frame& F, int b, int kvh) {
    const int tid = F.tid, lane = F.lane, w = F.wave, c = lane & 31, h = lane >> 5, qi = c & 7, g = c >> 3;
    LAS bf16* Kw = (LAS bf16*)(F.lds + w * 9216); LAS bf16* Vw = Kw + 32 * KTLD;
    LAS float* comb = (LAS float*)F.lds;
    LAS float* mlb = (LAS float*)(F.lds + 65536);
    LAS float* impA = (LAS float*)(F.lds + 73728);
    LAS float* impB = impA + 8 * IMPLD;
    LAS unsigned* selb = (LAS unsigned*)(impB + 8 * IMPLD);
    const int token = TP + 8 * b + qi, head = kvh * 4 + g;
    const bf16* QB = WSP(bf16, WS_QB);
    bf16x8 qf[4];
#pragma unroll
    for (int ks = 0; ks < 4; ++ks) qf[ks] = *(const bf16x8*)(QB + (size_t)token * 1024 + head * 64 + 16 * ks + 8 * h);
    const float* gbp = WSP(float, WS_GB) + (size_t)token * 48 + head * 3;
    const float gb_c = gbp[0], gb_s = gbp[1], gb_w = gbp[2];
    f32x16 oacc[2];
#pragma unroll
    for (int r = 0; r < 16; ++r) { oacc[0][r] = 0.f; oacc[1][r] = 0.f; }
    __syncthreads();
    {
        const bf16* KCk = WSP(bf16, WS_KC) + ((size_t)(b * 4 + kvh) * 512) * 64;
        const bf16* KCv = KCk + (size_t)CROWS * 64;
        float m = -1e30f, l = 0.f;
        for (int ti = w; ti < 16; ti += 8) {
            stage_half_bf16(Kw, KCk + (size_t)ti * 32 * 64, lane);
            int hi = 510 - 32 * ti; if (hi > 31) hi = 31;
            stats_tile<1>(m, l, Kw, qf, 0, hi, lane);
        }
        __syncthreads();
        mlb[(w * 64 + lane) * 2] = m; mlb[(w * 64 + lane) * 2 + 1] = l;
        __syncthreads();
        float M = -1e30f;
#pragma unroll
        for (int ww = 0; ww < 8; ++ww) M = fmaxf(M, mlb[(ww * 64 + lane) * 2]);
        float L = 0.f;
#pragma unroll
        for (int ww = 0; ww < 8; ++ww) L += (mlb[(ww * 64 + c) * 2 + 1] + mlb[(ww * 64 + c + 32) * 2 + 1]) * ex2(mlb[(ww * 64 + lane) * 2] - M);
        const float invL = (L > 0.f) ? 1.f / L : 0.f;
        __syncthreads();
        f32x16 o[2];
#pragma unroll
        for (int r = 0; r < 16; ++r) { o[0][r] = 0.f; o[1][r] = 0.f; }
        for (int ti = w; ti < 16; ti += 8) {
            stage_half_bf16(Kw, KCk + (size_t)ti * 32 * 64, lane); stage_half_bf16(Vw, KCv + (size_t)ti * 32 * 64, lane);
            int hi = 510 - 32 * ti; if (hi > 31) hi = 31;
            cmp2_tile<1>(o, Kw, Vw, qf, 0, hi, M, invL, impA, impB, qi, IMPLD, 8 * ti, lane);
        }
        __syncthreads();
#pragma unroll
        for (int r = 0; r < 16; ++r) { comb[(w * 32 + r) * 64 + lane] = o[0][r]; comb[(w * 32 + 16 + r) * 64 + lane] = o[1][r]; }
        __syncthreads();
        if (w == 0) {
#pragma unroll 1
            for (int ww = 0; ww < 8; ++ww)
#pragma unroll
                for (int r = 0; r < 16; ++r) { oacc[0][r] += gb_c * comb[(ww * 32 + r) * 64 + lane]; oacc[1][r] += gb_c * comb[(ww * 32 + 16 + r) * 64 + lane]; }
        }
    }
    __syncthreads();
    if (tid < 64) selb[tid] = 0u;
    {
        const int q = w;
#pragma unroll 1
        for (int i = 0; i < 2; ++i) { const int n = lane + 64 * i; if (n >= 1 && n <= 126) impA[q * IMPLD + n] += impB[q * IMPLD + n]; }
        __syncthreads();
#pragma unroll 1
        for (int i = 0; i < 2; ++i) {
            const int n = lane + 64 * i; bool sel = true;
            if (n >= 1 && n <= 126) {
                const float v = impA[q * IMPLD + n]; int rank = 0;
#pragma unroll 4
                for (int mm = 1; mm <= 126; ++mm) { const float vm = impA[q * IMPLD + mm]; rank += (vm > v || (vm == v && mm < n)) ? 1 : 0; }
                sel = rank < 13;
            }
            if (sel) atomicOr((unsigned*)&selb[q * 8 + (n >> 5)], 1u << (n & 31));
        }
        if (lane == 0) atomicOr((unsigned*)&selb[q * 8 + 4], 1u);
    }
    __syncthreads();
    {
        FlashSt st; flash_init(st);
        int cnt = 0;
        for (int blk = 0; blk <= 128; ++blk) {
            unsigned uw = 0u;
#pragma unroll
            for (int q = 0; q < 8; ++q) uw |= selb[q * 8 + (blk >> 5)];
            uw = __builtin_amdgcn_readfirstlane(uw);
            if (!((uw >> (blk & 31)) & 1u)) continue;
            const int nh = (blk == 128) ? 1 : 2;
            for (int hf = 0; hf < nh; ++hf) {
                if (((cnt++) & 7) != w) continue;
                const float* base; int nvalid;
                if (blk < 128) { const int page = F.ptab[b * NPAGE + (blk >> 1)]; base = F.c_sel + ((size_t)page * 128 + (blk & 1) * 64 + hf * 32) * 512 + kvh * 64; nvalid = 32; }
                else { base = F.out + O_SELS + (size_t)(b * 8) * 512 + kvh * 64; nvalid = 8; }
                stage_half_f32(Kw, base, nvalid, lane); stage_half_f32(Vw, base + 256, nvalid, lane);
                const bool sq = (selb[qi * 8 + (blk >> 5)] >> (blk & 31)) & 1u;
                const int lo = sq ? 0 : 1, hi = sq ? ((blk == 128) ? qi : 31) : 0;
                flash_tile<1>(st, Kw, Vw, qf, lo, hi, lane);
            }
        }
        __syncthreads();
        mlb[(w * 64 + lane) * 2] = st.m; mlb[(w * 64 + lane) * 2 + 1] = st.l;
#pragma unroll
        for (int r = 0; r < 16; ++r) { comb[(w * 32 + r) * 64 + lane] = st.o[0][r]; comb[(w * 32 + 16 + r) * 64 + lane] = st.o[1][r]; }
        __syncthreads();
        if (w == 0) { f32x16 o[2]; float L; merge_partials(mlb, comb, lane, o, L); const float sc = (L > 0.f) ? gb_s / L : 0.f;
#pragma unroll
            for (int r = 0; r < 16; ++r) { oacc[0][r] += sc * o[0][r]; oacc[1][r] += sc * o[1][r]; } }
    }
    __syncthreads();
    {
        FlashSt st; flash_init(st);
        for (int ti = w; ti < 17; ti += 8) {
            const float* base; int nvalid;
            if (ti < 16) { base = F.c_win + ((size_t)b * 512 + 32 * ti) * 512 + kvh * 64; nvalid = 32; }
            else { base = F.out + O_WINS + ((size_t)b * 512 + 504) * 512 + kvh * 64; nvalid = 8; }
            stage_half_f32(Kw, base, nvalid, lane); stage_half_f32(Vw, base + 256, nvalid, lane);
            const int lo = (ti == 0) ? 1 + qi : 0, hi = (ti == 16) ? qi : 31;
            flash_tile<1>(st, Kw, Vw, qf, lo, hi, lane);
        }
        __syncthreads();
        mlb[(w * 64 + lane) * 2] = st.m; mlb[(w * 64 + lane) * 2 + 1] = st.l;
#pragma unroll
        for (int r = 0; r < 16; ++r) { comb[(w * 32 + r) * 64 + lane] = st.o[0][r]; comb[(w * 32 + 16 + r) * 64 + lane] = st.o[1][r]; }
        __syncthreads();
        if (w == 0) { f32x16 o[2]; float L; merge_partials(mlb, comb, lane, o, L); const float sc = (L > 0.f) ? gb_w / L : 0.f;
#pragma unroll
            for (int r = 0; r < 16; ++r) { oacc[0][r] += sc * o[0][r]; oacc[1][r] += sc * o[1][r]; } }
    }
    if (w == 0) {
        const bf16* zn = WSP(bf16, WS_ZN) + (size_t)token * 1024 + head * 64;
        bf16* on = WSP(bf16, WS_ONSA) + (size_t)token * 1024 + head * 64;
#pragma unroll
        for (int dt = 0; dt < 2; ++dt)
#pragma unroll
            for (int k4 = 0; k4 < 4; ++k4) { const int d = 32 * dt + 8 * k4 + 4 * h;
                const u32x2 z = *(const u32x2*)(zn + d);
                const f32x4 v = (f32x4){oacc[dt][4 * k4] * bflo(z.x), oacc[dt][4 * k4 + 1] * bfhi(z.x), oacc[dt][4 * k4 + 2] * bflo(z.y), oacc[dt][4 * k4 + 3] * bfhi(z.y)};
                *(u32x2*)(on + d) = pack4(v); }
    }
    __syncthreads();
}


__device__ __forceinline__ float log_sigmoid(float z) { return (z < 0.f) ? z - log1pf(__expf(z)) : -log1pf(__expf(-z)); }
__device__ __forceinline__ void gla_cum(Frame& F, int ch, int hd, LAS float* cum, LAS float* qs, LAS float* agt) {
    const int tid = F.tid, k = tid & 127, tq = tid >> 7;
    const float* AG = WSP(float, WS_AG) + (size_t)(64 * ch) * 16;
    for (int i = tid; i < 64 * 16; i += 512) agt[i] = AG[i];
    float wv[16];
#pragma unroll
    for (int r = 0; r < 16; ++r) wv[r] = F.w_a2[r * 512 + hd * 128 + k];
    const float bias = F.b_a[hd * 128 + k];
    __syncthreads();
    float run = 0.f;
    for (int tt = 0; tt < 16; ++tt) {
        const int t = 16 * tq + tt; float z = bias;
#pragma unroll
        for (int r = 0; r < 16; ++r) z += agt[t * 16 + r] * wv[r];
        run += log_sigmoid(z) * (1.f / 16.f); cum[t * 128 + k] = run;
    }
    qs[tq * 128 + k] = run;
    __syncthreads();
    float off = 0.f;
    for (int j = 0; j < tq; ++j) off += qs[j * 128 + k];
    if (tq > 0) for (int tt = 0; tt < 16; ++tt) cum[(16 * tq + tt) * 128 + k] += off;
    __syncthreads();
}
__device__ __forceinline__ void gla_pass1_unit(Frame& F, int ch, int hd) {
    LAS float* cum = (LAS float*)F.lds; LAS float* qs = cum + 64 * 128; LAS float* agt = qs + 512;
    LAS bf16* KhT = (LAS bf16*)(F.lds + 40960);
    gla_cum(F, ch, hd, cum, qs, agt);
    const int tid = F.tid, k = tid & 127, tq = tid >> 7, lane = F.lane, c = lane & 31, h = lane >> 5, w = F.wave;
    const float cl = cum[63 * 128 + k];
    const bf16* KG = WSP(bf16, WS_KG) + (size_t)(64 * ch) * 512 + hd * 128 + k;
    unsigned pk[8];
#pragma unroll
    for (int j = 0; j < 8; ++j) { const int s = 16 * tq + 2 * j;
        const float v0 = bf2f(KG[(size_t)s * 512]) * __expf(cl - cum[s * 128 + k]), v1 = bf2f(KG[(size_t)(s + 1) * 512]) * __expf(cl - cum[(s + 1) * 128 + k]);
        pk[j] = pk2(v0, v1); }
    *(LAS u32x4*)(KhT + k * 72 + 16 * tq) = (u32x4){pk[0], pk[1], pk[2], pk[3]};
    *(LAS u32x4*)(KhT + k * 72 + 16 * tq + 8) = (u32x4){pk[4], pk[5], pk[6], pk[7]};
    if (tq == 0) WSP(float, WS_DC)[(ch * 4 + hd) * 128 + k] = __expf(cl);
    __syncthreads();
    const bf16* VGT = WSP(bf16, WS_VGT) + ((size_t)ch * 1024 + hd * 256 + 32 * w + c) * 64;
    bf16x8 af[4];
#pragma unroll
    for (int ss = 0; ss < 4; ++ss) af[ss] = *(const bf16x8*)(VGT + 16 * ss + 8 * h);
    float* LT = WSP(float, WS_LT) + ((size_t)(ch * 4 + hd) * 256 + 32 * w) * 128;
#pragma unroll
    for (int kt = 0; kt < 4; ++kt) {
        f32x16 acc;
#pragma unroll
        for (int r = 0; r < 16; ++r) acc[r] = 0.f;
#pragma unroll
        for (int ss = 0; ss < 4; ++ss) { const bf16x8 bv = *(const LAS bf16x8*)(KhT + (32 * kt + c) * 72 + 16 * ss + 8 * h); acc = __builtin_amdgcn_mfma_f32_32x32x16_bf16(af[ss], bv, acc, 0, 0, 0); }
#pragma unroll
        for (int r = 0; r < 16; ++r) LT[(size_t)((r & 3) + 8 * (r >> 2) + 4 * h) * 128 + 32 * kt + c] = acc[r];
    }
    __syncthreads();
}
__device__ __forceinline__ void gla_pass2(Frame& F) {
    const float* __restrict__ LT = WSP(float, WS_LT); const float* __restrict__ DC = WSP(float, WS_DC); bf16* __restrict__ ST = WSP(bf16, WS_ST);
    for (int e = blockIdx.x * 512 + F.tid; e < 4 * 256 * 128; e += F.G * 512) {
        const int k = e & 127, v = (e >> 7) & 255, hd = e >> 15;
        float S = 0.f;
#pragma unroll 8
        for (int cc = 0; cc < 128; ++cc) { const size_t idx = ((size_t)(cc * 4 + hd) * 256 + v) * 128 + k; ST[idx] = (bf16)f2bf(S); S = DC[(cc * 4 + hd) * 128 + k] * S + LT[idx]; }
        F.out[O_STP + ((size_t)hd * 128 + k) * 256 + v] = S;
    }
}
__device__ __forceinline__ void gla_pass3_unit(Frame& F, int ch, int hd) {
    LAS float* cum = (LAS float*)F.lds; LAS float* qs = cum + 64 * 128; LAS float* agt = qs + 512;
    LAS bf16* Qt = (LAS bf16*)(F.lds + 40960);
    LAS bf16* Kt2 = Qt + 64 * 136;
    LAS bf16* Att = Kt2 + 64 * 136;
    LAS float* red = (LAS float*)(F.lds + 84992);
    LAS float* rstdv = red + 512;
    gla_cum(F, ch, hd, cum, qs, agt);
    const int tid = F.tid, k = tid & 127, tq = tid >> 7, lane = F.lane, c = lane & 31, h = lane >> 5, w = F.wave;
    {
        const bf16* QG = WSP(bf16, WS_QG) + (size_t)(64 * ch) * 512 + hd * 128 + k;
        const bf16* KG = WSP(bf16, WS_KG) + (size_t)(64 * ch) * 512 + hd * 128 + k;
        for (int tt = 0; tt < 16; ++tt) { const int t = 16 * tq + tt; const float cu = cum[t * 128 + k];
            Qt[t * 136 + k] = (bf16)f2bf(bf2f(QG[(size_t)t * 512]) * __expf(cu)); Kt2[t * 136 + k] = (bf16)f2bf(bf2f(KG[(size_t)t * 512]) * __expf(-cu)); }
    }
    __syncthreads();
    if (w < 3) {
        const int tt = (w + 1) >> 1, st = w >> 1;
        f32x16 acc;
#pragma unroll
        for (int r = 0; r < 16; ++r) acc[r] = 0.f;
#pragma unroll
        for (int ks = 0; ks < 8; ++ks) { const bf16x8 a = *(const LAS bf16x8*)(Qt + (32 * tt + c) * 136 + 16 * ks + 8 * h), bv = *(const LAS bf16x8*)(Kt2 + (32 * st + c) * 136 + 16 * ks + 8 * h);
            acc = __builtin_amdgcn_mfma_f32_32x32x16_bf16(a, bv, acc, 0, 0, 0); }
#pragma unroll
        for (int r = 0; r < 16; ++r) { const int t = 32 * tt + (r & 3) + 8 * (r >> 2) + 4 * h, s = 32 * st + c; Att[t * 72 + s] = (s <= t) ? (bf16)f2bf(acc[r]) : (bf16)0; }
    } else if (w == 3) {
#pragma unroll
        for (int r = 0; r < 16; ++r) { const int t = (r & 3) + 8 * (r >> 2) + 4 * h; Att[t * 72 + 32 + c] = (bf16)0; }
    }
    __syncthreads();
    f32x16 acc[2];
    {
        const bf16* VGT = WSP(bf16, WS_VGT) + ((size_t)ch * 1024 + hd * 256 + 32 * w + c) * 64;
        const bf16* STp = WSP(bf16, WS_ST) + ((size_t)(ch * 4 + hd) * 256 + 32 * w + c) * 128;
        bf16x8 bv[4], bs[8];
#pragma unroll
        for (int ss = 0; ss < 4; ++ss) bv[ss] = *(const bf16x8*)(VGT + 16 * ss + 8 * h);
#pragma unroll
        for (int ks = 0; ks < 8; ++ks) bs[ks] = *(const bf16x8*)(STp + 16 * ks + 8 * h);
#pragma unroll
        for (int tt = 0; tt < 2; ++tt) {
#pragma unroll
            for (int r = 0; r < 16; ++r) acc[tt][r] = 0.f;
#pragma unroll
            for (int ss = 0; ss < 4; ++ss) { if (tt == 0 && ss >= 2) continue;
                const bf16x8 a = *(const LAS bf16x8*)(Att + (32 * tt + c) * 72 + 16 * ss + 8 * h); acc[tt] = __builtin_amdgcn_mfma_f32_32x32x16_bf16(a, bv[ss], acc[tt], 0, 0, 0); }
#pragma unroll
            for (int ks = 0; ks < 8; ++ks) { const bf16x8 a = *(const LAS bf16x8*)(Qt + (32 * tt + c) * 136 + 16 * ks + 8 * h); acc[tt] = __builtin_amdgcn_mfma_f32_32x32x16_bf16(a, bs[ks], acc[tt], 0, 0, 0); }
        }
    }
#pragma unroll
    for (int tt = 0; tt < 2; ++tt)
#pragma unroll
        for (int r = 0; r < 16; ++r) { float sq = acc[tt][r] * acc[tt][r];
            sq += __shfl_xor(sq, 1); sq += __shfl_xor(sq, 2); sq += __shfl_xor(sq, 4); sq += __shfl_xor(sq, 8); sq += __shfl_xor(sq, 16);
            if (c == 0) red[w * 64 + 32 * tt + (r & 3) + 8 * (r >> 2) + 4 * h] = sq; }
    __syncthreads();
    if (tid < 64) { float s = 0.f;
#pragma unroll
        for (int ww = 0; ww < 8; ++ww) s += red[ww * 64 + tid];
        rstdv[tid] = 1.f / sqrtf(s * (1.f / 256.f) + 1e-6f); }
    __syncthreads();
    {
        const int col = hd * 256 + 32 * w + c; const float gw = F.gnw[32 * w + c];
        const bf16* ZG = WSP(bf16, WS_ZG); bf16* OG = WSP(bf16, WS_OGLA);
#pragma unroll
        for (int tt = 0; tt < 2; ++tt)
#pragma unroll
            for (int r = 0; r < 16; ++r) { const int t = 32 * tt + (r & 3) + 8 * (r >> 2) + 4 * h; const size_t row = (size_t)(64 * ch + t);
                OG[row * 1024 + col] = (bf16)f2bf(acc[tt][r] * rstdv[t] * gw * bf2f(ZG[row * 1024 + col])); }
    }
    __syncthreads();
}
__device__ __forceinline__ void gla_sample_unit(Frame& F, int b, int hd) {
    LAS float* cumS = (LAS float*)F.lds; LAS float* qtl = cumS + 1024; LAS float* khl = qtl + 1024; LAS float* ktl = khl + 1024;
    LAS float* att = ktl + 1024; LAS float* oih = att + 64; LAS float* red = oih + 2048;
    const int tid = F.tid, lane = F.lane, w = F.wave, row0 = TP + 8 * b;
    if (tid < 128) {
        const int k = tid; float wv[16];
#pragma unroll
        for (int r = 0; r < 16; ++r) wv[r] = F.w_a2[r * 512 + hd * 128 + k];
        const float bias = F.b_a[hd * 128 + k]; float run = 0.f;
        const float* AG = WSP(float, WS_AG) + (size_t)row0 * 16;
        for (int t = 0; t < 8; ++t) { float z = bias;
#pragma unroll
            for (int r = 0; r < 16; ++r) z += AG[t * 16 + r] * wv[r];
            run += log_sigmoid(z) * (1.f / 16.f); cumS[t * 128 + k] = run; }
    }
    __syncthreads();
    for (int i = tid; i < 1024; i += 512) { const int t = i >> 7, k = i & 127; const float cu = cumS[i], cl = cumS[7 * 128 + k];
        const float q = bf2f(WSP(bf16, WS_QG)[(size_t)(row0 + t) * 512 + hd * 128 + k]), kk = bf2f(WSP(bf16, WS_KG)[(size_t)(row0 + t) * 512 + hd * 128 + k]);
        qtl[i] = q * __expf(cu); khl[i] = kk * __expf(cl - cu); ktl[i] = kk * __expf(-cu); }
    __syncthreads();
    if (tid < 64) { const int t = tid >> 3, s = tid & 7; float a = 0.f;
        if (s <= t) for (int k = 0; k < 128; ++k) a += qtl[t * 128 + k] * ktl[s * 128 + k];
        att[tid] = a; }
    __syncthreads();
    const int v = tid & 255, kh = tid >> 8;
    float vv[8], oi[8];
#pragma unroll
    for (int s = 0; s < 8; ++s) { vv[s] = WSP(float, WS_VGS)[(size_t)(8 * b + s) * 1024 + hd * 256 + v]; oi[s] = 0.f; }
    const float* S0 = F.state + ((size_t)(b * 4 + hd) * 128) * 256; float* SN = F.out + O_STS + ((size_t)(b * 4 + hd) * 128) * 256;
#pragma unroll 4
    for (int kk = 0; kk < 64; ++kk) { const int k = kh * 64 + kk; const float s0 = S0[(size_t)k * 256 + v]; float sn = __expf(cumS[7 * 128 + k]) * s0;
#pragma unroll
        for (int s = 0; s < 8; ++s) { sn += khl[s * 128 + k] * vv[s]; oi[s] += qtl[s * 128 + k] * s0; }
        SN[(size_t)k * 256 + v] = sn; }
    if (kh == 1) {
#pragma unroll
        for (int t = 0; t < 8; ++t) oih[t * 256 + v] = oi[t]; }
    __syncthreads();
    if (kh == 0) {
#pragma unroll
        for (int t = 0; t < 8; ++t) { float o = oi[t] + oih[t * 256 + v];
#pragma unroll
            for (int s = 0; s < 8; ++s) if (s <= t) o += att[t * 8 + s] * vv[s];
            oi[t] = o; } }
#pragma unroll
    for (int t = 0; t < 8; ++t) { float sq = (kh == 0) ? oi[t] * oi[t] : 0.f; sq = wave_sum(sq); if (lane == 0) red[w * 8 + t] = sq; }
    __syncthreads();
    if (kh == 0) { const float gw = F.gnw[v];
#pragma unroll
        for (int t = 0; t < 8; ++t) { const float ssum = (red[t] + red[8 + t]) + (red[16 + t] + red[24 + t]); const float rstd = 1.f / sqrtf(ssum * (1.f / 256.f) + 1e-6f);
            const size_t row = (size_t)(row0 + t);
            WSP(bf16, WS_OGLA)[row * 1024 + hd * 256 + v] = (bf16)f2bf(oi[t] * rstd * gw * bf2f(WSP(bf16, WS_ZG)[row * 1024 + hd * 256 + v])); } }
    __syncthreads();
}

#ifndef MK_N_LAUNCHES
#define MK_N_LAUNCHES 1
#endif
constexpr int NPH = 10;
constexpr int N_LAUNCHES = MK_N_LAUNCHES;
struct Args { const void* in[25]; float* out; unsigned char* ws; int ph_lo, ph_hi, rpt, pad; };

__global__ void __launch_bounds__(NWAVES * 64, 2) nsa_gla_fwd(Args args) {
    extern __shared__ __attribute__((aligned(16))) unsigned char lds[];
    Frame F;
    F.lds = (LAS unsigned char*)lds;
    F.MISC = (volatile LAS unsigned*)(F.lds + LDSCTL_OFF);
    F.tid = threadIdx.x; F.lane = F.tid & 63; F.wave = __builtin_amdgcn_readfirstlane(F.tid >> 6);
    F.G = gridDim.x; F.gw = blockIdx.x * NWAVES + F.wave; F.NGW = F.G * NWAVES;
    F.ws = args.ws; F.out = args.out; F.ctl = (gu32*)(args.ws + WS_CTL);
    F.x_p = (const float*)args.in[0]; F.x_s = (const float*)args.in[1]; F.c_cmp = (const float*)args.in[2]; F.c_sel = (const float*)args.in[3];
    F.c_win = (const float*)args.in[4]; F.state = (const float*)args.in[5]; F.ptab = (const int*)args.in[6]; F.c_p = (const float*)args.in[7];
    F.c_s = (const float*)args.in[8]; F.norm_w = (const float*)args.in[9]; F.w_ada = (const float*)args.in[10]; F.b_ada = (const float*)args.in[11];
    F.w_in = (const float*)args.in[12]; F.cmp_pos = (const float*)args.in[13]; F.cmp_w1 = (const float*)args.in[14]; F.cmp_b1 = (const float*)args.in[15];
    F.cmp_w2 = (const float*)args.in[16]; F.cmp_b2 = (const float*)args.in[17]; F.w_a2 = (const float*)args.in[18]; F.b_a = (const float*)args.in[19];
    F.gnw = (const float*)args.in[20]; F.w_on = (const float*)args.in[21]; F.w_og = (const float*)args.in[22]; F.w_out = (const float*)args.in[23];
    F.fnw = (const float*)args.in[24];
    for (int u = F.tid; u < (LDS_BYTES - LDSCTL_OFF) / 4; u += NWAVES * 64) ((LAS unsigned*)(F.lds + LDSCTL_OFF))[u] = 0u;
    __syncthreads();
    const int lo = args.ph_lo, hi = args.ph_hi;
    const bool use_bar = (hi - lo) > 1;
    XcdBarrier bar; bar.bar = (unsigned*)(F.ctl + CW_BAR); bar.x = 0; bar.st = nullptr;
    if (use_bar) bar = xcd_barrier_post((unsigned*)(F.ctl + CW_BAR), F.MISC + 8);
#ifndef PH_MASK
#define PH_MASK 0x3ff
#endif
#define IN(k) (((PH_MASK >> (k)) & 1) && lo <= (k) && (k) < hi)
#define SEAM(k) do { if (IN(k) && IN((k) + 1)) xcd_barrier(bar); } while (0)
    LAS unsigned char* ring = F.lds;

#ifndef DBL_MASK
#define DBL_MASK 0
#endif
#ifndef P5_MASK
#define P5_MASK 7
#endif
#ifndef P5_DBL
#define P5_DBL 0
#endif
#define QUEUE_LOOP(word, N, BODY) for (;;) { if (F.tid == 0) F.MISC[0] = __hip_atomic_fetch_add((unsigned*)(F.ctl + (word)), 1u, RLX_AGENT); __syncthreads(); \
            const int idx = (int)F.MISC[0]; __syncthreads(); if (idx >= (N)) break; BODY; }
#define PHASE0(rep) { p0_prologue(F, (rep) | args.rpt); }
#define PHASE1(rep) { p1_modnorm(F); }
#define PHASE2(rep) { pg8::Gemm g{WSP(const bf16, WS_H), WSP(const bf16, WS_WIN), MROWS, NINP, DM}; pg8::StaticOrder S; S.init(MROWS, NINP, F.G, (int)blockIdx.x); \
        EpiIn E{F.out, F.ws}; pg8::gemm_phase<EpiIn, pg8::StaticOrder, true, true>(ring, g, S, E); }
#define PHASE3X(XX) { { SEpiPlain SE{WSP(bf16, WS_PART) + (size_t)(XX) * CROWS * 256, 256}; \
          wave_gemm_tiles<SEpiPlain>(F, WSP(const bf16, WS_CB) + (size_t)(XX) * CB_X, 1024, WSP(const bf16, WS_W1T) + (size_t)(XX) * 256 * 1024, 1024, 65536, 64, 8, 1024, SE); } \
        pg8::Gemm g{WSP(const bf16, WS_CB) + (size_t)(XX) * CB_X, WSP(const bf16, WS_W1T) + (size_t)(XX) * 256 * 1024, 65536, 256, 1024}; pg8::StaticOrder S; S.init(65536, 256, F.G, (int)blockIdx.x); \
        EpiPlainBf16 E{WSP(bf16, WS_PART) + (size_t)(XX) * CROWS * 256, 256}; pg8::gemm_phase<EpiPlainBf16, pg8::StaticOrder, true, true>(ring, g, S, E); __syncthreads(); }
#define PHASE3(rep) { PHASE3X(0) PHASE3X(1) \
        QUEUE_LOOP(CW_Q5 + 2048 + 512 * (rep), 128, gla_sample_unit(F, idx >> 2, idx & 3)) \
        QUEUE_LOOP(CW_Q5 + 2048 + 64 + 512 * (rep), 512, gla_pass1_unit(F, idx >> 2, idx & 3)) }
#define PHASE4(rep) { compress_l2(F); gla_pass2(F); }
#define PHASE5(rep) { \
        if (P5_MASK & 1) { QUEUE_LOOP(CW_Q5 + 512 * (rep), 128, nsa_sample_unit(F, idx >> 2, idx & 3)) if (P5_DBL & 1) { QUEUE_LOOP(CW_Q5 + 1024, 128, nsa_sample_unit(F, idx >> 2, idx & 3)) } } \
        if (P5_MASK & 2) { QUEUE_LOOP(CW_Q5 + 64 + 512 * (rep), 512, nsa_prompt_unit(F, 127 - (idx >> 2), idx & 3)) if (P5_DBL & 2) { QUEUE_LOOP(CW_Q5 + 1024 + 64, 512, nsa_prompt_unit(F, 127 - (idx >> 2), idx & 3)) } } \
        if (P5_MASK & 4) { QUEUE_LOOP(CW_Q5 + 128 + 512 * (rep), 512, gla_pass3_unit(F, idx >> 2, idx & 3)) if (P5_DBL & 4) { QUEUE_LOOP(CW_Q5 + 1024 + 128, 512, gla_pass3_unit(F, idx >> 2, idx & 3)) } } }
#define PHASE6(rep) { { SEpiMerge<false> SE{WSP(const bf16, WS_MN), WSP(bf16, WS_MERGED)}; wave_gemm_tiles<SEpiMerge<false>>(F, WSP(const bf16, WS_ONSA), 1024, WSP(const bf16, WS_WON), 1024, TP, 8, 64, 1024, SE); } \
        pg8::Gemm g{WSP(const bf16, WS_ONSA), WSP(const bf16, WS_WON), TP, DM, 1024}; pg8::StaticOrder S; S.init(TP, DM, F.G, (int)blockIdx.x); \
        EpiMerge<false> E{WSP(const bf16, WS_MN), WSP(bf16, WS_MERGED)}; pg8::gemm_phase<EpiMerge<false>, pg8::StaticOrder, true, true>(ring, g, S, E); }
#define PHASE7(rep) { { SEpiMerge<true> SE{WSP(const bf16, WS_MG), WSP(bf16, WS_MERGED)}; wave_gemm_tiles<SEpiMerge<true>>(F, WSP(const bf16, WS_OGLA), 1024, WSP(const bf16, WS_WOG), 1024, TP, 8, 64, 1024, SE); } \
        pg8::Gemm g{WSP(const bf16, WS_OGLA), WSP(const bf16, WS_WOG), TP, DM, 1024}; pg8::StaticOrder S; S.init(TP, DM, F.G, (int)blockIdx.x); \
        EpiMerge<true> E{WSP(const bf16, WS_MG), WSP(bf16, WS_MERGED)}; pg8::gemm_phase<EpiMerge<true>, pg8::StaticOrder, true, true>(ring, g, S, E); }
#define PHASE8(rep) { { SEpiOut SE{F.x_s, WSP(const long long, WS_MOD), F.out, WSP(float, WS_RSS)}; wave_gemm_tiles<SEpiOut>(F, WSP(const bf16, WS_MERGED), 2048, WSP(const bf16, WS_WOUT), 2048, TP, 8, 64, 2048, SE); } \
        pg8::Gemm g{WSP(const bf16, WS_MERGED), WSP(const bf16, WS_WOUT), TP, DM, DM}; pg8::StaticOrder S; S.init(TP, DM, F.G, (int)blockIdx.x); \
        EpiOut E{F.x_p, F.x_s, WSP(const long long, WS_MOD), F.out, WSP(float, WS_RSS)}; pg8::gemm_phase<EpiOut, pg8::StaticOrder, true, true>(ring, g, S, E); }
#define PHASE9(rep) { final_norm(F); }
#define RUN(k) do { if (IN(k)) { PHASE##k(0) if ((DBL_MASK >> (k)) & 1) { if (use_bar) xcd_barrier(bar); PHASE##k(1) } } SEAM(k); } while (0)
    RUN(0); RUN(1); RUN(2); RUN(3); RUN(4); RUN(5); RUN(6); RUN(7); RUN(8);
    if (IN(9)) { PHASE9(0) }
#undef IN
#undef SEAM
}

extern "C" void kernel_launch(void* const* d_in, const int* in_sizes, int n_in, void* d_out, int out_size, void* d_ws, size_t ws_size, hipStream_t stream) {
    static int grid = 0;
    if (grid == 0) {
        if (n_in != 25 || (size_t)out_size != O_TOTAL || ws_size < WS_END) {
            fprintf(stderr, "kernel_launch: built for 25 inputs, %zu outputs, >= %zu bytes of workspace; got n_in %d, out %d, ws %zu; nothing launched\n", (size_t)O_TOTAL, (size_t)WS_END, n_in, out_size, ws_size); grid = -1; return; }
        int dev = 0, cus = 0, per_cu = 0;
        if (hipGetDevice(&dev) != hipSuccess || hipDeviceGetAttribute(&cus, hipDeviceAttributeMultiprocessorCount, dev) != hipSuccess) { fprintf(stderr, "kernel_launch: device query failed\n"); grid = -1; return; }
        if (hipFuncSetAttribute((const void*)nsa_gla_fwd, hipFuncAttributeMaxDynamicSharedMemorySize, LDS_BYTES) != hipSuccess) { fprintf(stderr, "kernel_launch: hipFuncSetAttribute failed\n"); grid = -1; return; }
        if (hipOccupancyMaxActiveBlocksPerMultiprocessor(&per_cu, (const void*)nsa_gla_fwd, NWAVES * 64, LDS_BYTES) != hipSuccess || per_cu < 1)
            fprintf(stderr, "kernel_launch: note: occupancy query reports %d workgroups per CU\n", per_cu);
        (void)hipGetLastError();
        grid = cus;
    }
    if (grid < 0) return;
    if (hipMemsetAsync((char*)d_ws + WS_CTL, 0, CTL_ZERO_BYTES, stream) != hipSuccess || hipMemsetAsync((char*)d_ws + WS_MOD, 0, MOD_BYTES, stream) != hipSuccess) { fprintf(stderr, "kernel_launch: memset failed\n"); return; }
    Args a{};
    for (int i = 0; i < 25; ++i) a.in[i] = d_in[i];
    a.out = (float*)d_out; a.ws = (unsigned char*)d_ws;
#ifndef DBL_LAUNCH
#define DBL_LAUNCH 0
#endif
    int seq[2 * NPH + 4], rp[2 * NPH + 4], ns = 0;
    if (N_LAUNCHES == 1) { seq[ns] = -1; rp[ns++] = 0; }
    else for (int k = 0; k < NPH; ++k) {
        seq[ns] = k; rp[ns++] = 0;
        if ((DBL_LAUNCH >> k) & 1) { if (k == 7 || k == 9) { seq[ns] = k - 1; rp[ns++] = 1; } seq[ns] = k; rp[ns++] = 1; }
    }
    for (int li = 0; li < ns; ++li) {
        if (seq[li] < 0) { a.ph_lo = 0; a.ph_hi = NPH; } else { a.ph_lo = seq[li]; a.ph_hi = seq[li] + 1; }
        a.rpt = rp[li]; a.pad = 0;
        hipLaunchKernelGGL(nsa_gla_fwd, dim3(grid), dim3(NWAVES * 64), LDS_BYTES, stream, a);
        const hipError_t le = hipPeekAtLastError();
        if (le != hipSuccess) { fprintf(stderr, "kernel_launch: launch %d failed: %s\n", li, hipGetErrorName(le)); break; }
    }
}
```

```cpp
#include <hip/hip_runtime.h>
#include <cstdio>
#include <cstdint>
#define MK_N_LAUNCHES 1
namespace pg8 {
#define PG8_LAS __attribute__((address_space(3)))
typedef unsigned short bf16_t;
typedef short bf16x8 __attribute__((ext_vector_type(8)));
typedef float f32x4 __attribute__((ext_vector_type(4)));
typedef unsigned u32x4 __attribute__((ext_vector_type(4)));
constexpr int BM = 256, BK = 64, HALF = 128, HTB = HALF * BK * 2  , STAGE_BYTES = 8 * HTB, NXCD = 8, WGM = 8;

__host__ __device__ __forceinline__ int lds_byte(int r, int c) { const int st = (r >> 4) * 2 + (c >> 5), rr = r & 15, cc = c & 31, ob = rr * 64 + cc * 2; return st * 1024 + (ob ^ (((ob >> 9) & 1) << 5)); }
__host__ __device__ __forceinline__ void stage_rc(int b, int& R, int& C) { const int st = b / 1024, sb = b % 1024, swz = sb ^ (((sb >> 9) & 1) << 5); R = (st >> 1) * 16 + swz / 64; C = (st & 1) * 32 + (swz % 64) / 2; }
__host__ __device__ __forceinline__ int perm32(int rho) { const int n = rho >> 4, i = rho & 15; return 8 * (i >> 2) + 4 * n + (i & 3); }

struct Unit { int pm, pn, z; };
struct Gemm { const bf16_t* A; const bf16_t* Bt; int M, N, K, ld, zoff; };

struct StaticOrder {
    int nM, nN, nwg, G, c;
    __host__ __device__ void init(int M, int N, int G_, int c_) { nM = M / BM; nN = N / BM; nwg = nM * nN; G = G_; c = c_; }
    __host__ __device__ bool next(int i, Unit& u) const {
        const long L = (long)i * G + c; if (L >= nwg) return false;
        int wgid = (int)L; { const int q = nwg / NXCD, r = nwg % NXCD, xcd = wgid % NXCD, off = wgid / NXCD; wgid = (xcd < r ? xcd * (q + 1) : r * (q + 1) + (xcd - r) * q) + off; }
        const int nig = WGM * nN, gid = wgid / nig, fm = gid * WGM, gsz = (nM - fm) < WGM ? (nM - fm) : WGM;
        u.pm = fm + ((wgid % nig) % gsz); u.pn = (wgid % nig) / gsz; u.z = 0; return true;
    }
    __device__ __forceinline__ void a_ready(const Unit&) const {}
    __device__ __forceinline__ void done(const Unit&) const {}
};

struct StaticOrderZ2 {
    StaticOrder so;
    __host__ __device__ void init(int M, int N, int G_, int c_) { so.init(M, N, G_, c_); }
    __host__ __device__ bool next(int i, Unit& u) const { if (!so.next(i >> 1, u)) return false; u.z = i & 1; return true; }
    __device__ __forceinline__ void a_ready(const Unit&) const {}
    __device__ __forceinline__ void done(const Unit&) const {}
};

__device__ __forceinline__ unsigned cvt_pk_bf16(float lo, float hi) { unsigned r; asm volatile("v_cvt_pk_bf16_f32 %0, %1, %2" : "=v"(r) : "v"(lo), "v"(hi)); return r; }
typedef float f32x2 __attribute__((ext_vector_type(2)));

template <class Epi, class Sched, bool ALIGN_EPI = false, bool SP2 = false>
__device__ __forceinline__ void gemm_phase(PG8_LAS unsigned char* lds, const Gemm g, const Sched& S, const Epi& E) {
    const int tid = threadIdx.x, wid = __builtin_amdgcn_readfirstlane(tid >> 6), lane = tid & 63, wr = wid >> 2, wc = wid & 3, fr = lane & 15, fq = lane >> 4;
    const int K = g.K, nt = K / BK, LD = g.ld ? g.ld : K;
    unsigned voffA[2], voffB[2];
#pragma unroll
    for (int i = 0; i < 2; ++i) { int R, C; stage_rc(tid * 16 + i * 8192, R, C); const int Rb = Epi::PERM ? ((R & ~31) + perm32(R & 31)) : R;
        voffA[i] = (unsigned)(R * LD + C) * 2u; voffB[i] = (unsigned)(Rb * LD + C) * 2u; }
    const size_t kstep = (size_t)(BK * 2);
    const size_t hstep = (size_t)HALF * LD * 2;
    const size_t tstep = 2 * hstep;
    const unsigned ldsw = (unsigned)wid * 1024u;
    const int aoff = lds_byte(wr * 64 + fr, fq * 8), boff = lds_byte(wc * 32 + fr, fq * 8);
#define PG8_SA(b, h) (((b) * 2 + (h)) * HTB)
#define PG8_SB(b, h) ((4 + (b) * 2 + (h)) * HTB)
#define PG8_STAGE(bufoff, gbase, voff) do { _Pragma("unroll") for (int _i = 0; _i < 2; ++_i) \
        __builtin_amdgcn_global_load_lds((const unsigned*)((const char*)(gbase) + (voff)[_i]), (PG8_LAS unsigned*)(lds + (bufoff) + ldsw + _i * 8192), 16, 0, 0); } while (0)
#define PG8_LDA(dst, b, h) do { _Pragma("unroll") for (int m = 0; m < 4; ++m) _Pragma("unroll") for (int k = 0; k < 2; ++k) dst[m][k] = *(const PG8_LAS bf16x8*)(lds + PG8_SA(b, h) + aoff + m * 2048 + k * 1024); } while (0)
#define PG8_LDB(dst, b, h) do { _Pragma("unroll") for (int n = 0; n < 2; ++n) _Pragma("unroll") for (int k = 0; k < 2; ++k) dst[n][k] = *(const PG8_LAS bf16x8*)(lds + PG8_SB(b, h) + boff + n * 2048 + k * 1024); } while (0)
#define PG8_MMA(ai, bj, At, Bt) do { __builtin_amdgcn_s_setprio(1); _Pragma("unroll") for (int m = 0; m < 4; ++m) _Pragma("unroll") for (int n = 0; n < 2; ++n) _Pragma("unroll") for (int k = 0; k < 2; ++k) \
        acc[ai][bj][m][n] = __builtin_amdgcn_mfma_f32_16x16x32_bf16(Bt[n][k], At[m][k], acc[ai][bj][m][n], 0, 0, 0); __builtin_amdgcn_s_setprio(0); } while (0)
#define PG8_WAIT_V(n) asm volatile("s_waitcnt vmcnt(" #n ")" ::: "memory")
#define PG8_WAIT_L(n) asm volatile("s_waitcnt lgkmcnt(" #n ")" ::: "memory")
#define PG8_BAR __builtin_amdgcn_s_barrier()
#define PG8_SCHED __builtin_amdgcn_sched_barrier(0)
    Unit cur, nxt; int ui = 0;
    if (!S.next(0, cur)) return;
    f32x4 acc[2][2][4][2];
#pragma unroll
    for (int a = 0; a < 2; ++a)
#pragma unroll
        for (int b = 0; b < 2; ++b)
#pragma unroll
            for (int m = 0; m < 4; ++m)
#pragma unroll
                for (int n = 0; n < 2; ++n) acc[a][b][m][n] = (f32x4){0.f, 0.f, 0.f, 0.f};
    bf16x8 At[4][2], B0[2][2], B1[2][2];
    const char* cA = (const char*)g.A + (size_t)cur.pm * tstep + (size_t)cur.z * g.zoff * 2; const char* cB = (const char*)g.Bt + (size_t)cur.pn * tstep + (size_t)cur.z * g.zoff * 2;
    S.a_ready(cur);
    if constexpr (SP2) {
        PG8_STAGE(PG8_SB(0, 0), cB, voffB); PG8_STAGE(PG8_SB(0, 1), cB + hstep, voffB); PG8_STAGE(PG8_SA(0, 0), cA, voffA); PG8_STAGE(PG8_SA(0, 1), cA + hstep, voffA);
        if (wr == 1) PG8_BAR;
        PG8_WAIT_V(2); PG8_BAR;
        PG8_STAGE(PG8_SB(1, 0), cB + kstep, voffB); PG8_STAGE(PG8_SA(1, 0), cA + kstep, voffA); PG8_STAGE(PG8_SB(1, 1), cB + hstep + kstep, voffB);
        PG8_WAIT_V(6); PG8_BAR;
    } else {
        PG8_STAGE(PG8_SB(0, 0), cB, voffB); PG8_STAGE(PG8_SA(0, 0), cA, voffA); PG8_STAGE(PG8_SB(0, 1), cB + hstep, voffB); PG8_STAGE(PG8_SA(0, 1), cA + hstep, voffA);
        if (wr == 1) PG8_BAR;
        PG8_WAIT_V(4); PG8_BAR;
        PG8_STAGE(PG8_SB(1, 0), cB + kstep, voffB); PG8_STAGE(PG8_SA(1, 0), cA + kstep, voffA); PG8_STAGE(PG8_SB(1, 1), cB + hstep + kstep, voffB);
        PG8_WAIT_V(6); PG8_BAR;
    }
    for (;;) {
        const bool has_next = S.next(ui + 1, nxt);
        const char* nA = has_next ? (const char*)g.A + (size_t)nxt.pm * tstep + (size_t)nxt.z * g.zoff * 2 : cA; const char* nB = has_next ? (const char*)g.Bt + (size_t)nxt.pn * tstep + (size_t)nxt.z * g.zoff * 2 : cB;
        for (int t = 0; t < nt; t += 2) {
            const bool last = (t == nt - 2);
            const char* a1 = cA + (size_t)(t + 1) * kstep;
            const char* a2 = last ? nA : cA + (size_t)(t + 2) * kstep; const char* b2 = last ? nB : cB + (size_t)(t + 2) * kstep;
            const char* a3 = a2 + kstep; const char* b3 = b2 + kstep;
            if (last && has_next) S.a_ready(nxt);
            if constexpr (SP2) {
            PG8_LDB(B0, 0, 0); PG8_LDB(B1, 0, 1); PG8_SCHED; PG8_LDA(At, 0, 0); PG8_STAGE(PG8_SA(1, 1), a1 + hstep, voffA);
            PG8_WAIT_V(8); PG8_WAIT_L(0); PG8_BAR; PG8_MMA(0, 0, At, B0); PG8_MMA(0, 1, At, B1); PG8_BAR; PG8_SCHED;
            PG8_LDA(At, 0, 1); PG8_STAGE(PG8_SB(0, 0), b2, voffB); PG8_STAGE(PG8_SB(0, 1), b2 + hstep, voffB); PG8_STAGE(PG8_SA(0, 0), a2, voffA);
            PG8_WAIT_V(8); PG8_WAIT_L(0); PG8_BAR; PG8_MMA(1, 0, At, B0); PG8_MMA(1, 1, At, B1); PG8_BAR; PG8_SCHED;
            PG8_LDB(B0, 1, 0); PG8_LDB(B1, 1, 1); PG8_SCHED; PG8_LDA(At, 1, 0); PG8_STAGE(PG8_SA(0, 1), a2 + hstep, voffA);
            PG8_WAIT_V(8); PG8_WAIT_L(0); PG8_BAR; PG8_MMA(0, 0, At, B0); PG8_MMA(0, 1, At, B1); PG8_BAR; PG8_SCHED;
            PG8_LDA(At, 1, 1); PG8_STAGE(PG8_SB(1, 0), b3, voffB); PG8_STAGE(PG8_SB(1, 1), b3 + hstep, voffB); PG8_STAGE(PG8_SA(1, 0), a3, voffA);
            PG8_WAIT_V(8); PG8_WAIT_L(0); PG8_BAR; PG8_MMA(1, 0, At, B0); PG8_MMA(1, 1, At, B1); PG8_BAR; PG8_SCHED;
            } else {
            PG8_LDB(B0, 0, 0); PG8_SCHED; PG8_LDA(At, 0, 0); PG8_STAGE(PG8_SA(1, 1), a1 + hstep, voffA);
            PG8_WAIT_L(8); PG8_BAR; PG8_WAIT_L(0); PG8_MMA(0, 0, At, B0); PG8_BAR; PG8_SCHED;
            PG8_LDB(B1, 0, 1); PG8_STAGE(PG8_SB(0, 0), b2, voffB);
            PG8_BAR; PG8_WAIT_L(0); PG8_MMA(0, 1, At, B1); PG8_BAR;
            PG8_LDA(At, 0, 1); PG8_STAGE(PG8_SA(0, 0), a2, voffA);
            PG8_BAR; PG8_WAIT_L(0); PG8_MMA(1, 0, At, B0); PG8_BAR; PG8_SCHED;
            PG8_STAGE(PG8_SB(0, 1), b2 + hstep, voffB);
            PG8_WAIT_V(6); PG8_BAR; PG8_MMA(1, 1, At, B1); PG8_BAR;
            PG8_LDB(B0, 1, 0); PG8_SCHED; PG8_LDA(At, 1, 0); PG8_STAGE(PG8_SA(0, 1), a2 + hstep, voffA);
            PG8_WAIT_L(8); PG8_BAR; PG8_WAIT_L(0); PG8_MMA(0, 0, At, B0); PG8_BAR; PG8_SCHED;
            PG8_LDB(B1, 1, 1); PG8_STAGE(PG8_SB(1, 0), b3, voffB);
            PG8_BAR; PG8_WAIT_L(0); PG8_MMA(0, 1, At, B1); PG8_BAR;
            PG8_LDA(At, 1, 1); PG8_STAGE(PG8_SA(1, 0), a3, voffA);
            PG8_BAR; PG8_WAIT_L(0); PG8_MMA(1, 0, At, B0); PG8_BAR; PG8_SCHED;
            PG8_STAGE(PG8_SB(1, 1), b3 + hstep, voffB);
            PG8_WAIT_V(6); PG8_BAR; PG8_MMA(1, 1, At, B1); PG8_BAR;
            }
        }
        if constexpr (ALIGN_EPI) { if (wr == 0) PG8_BAR; }
        if constexpr (!Epi::AFTER_DRAIN) { E(acc, cur, wr, wc, fr, fq); S.done(cur); }
        if (!has_next) break;
#pragma unroll
        for (int a = 0; a < 2; ++a)
#pragma unroll
            for (int b = 0; b < 2; ++b)
#pragma unroll
                for (int m = 0; m < 4; ++m)
#pragma unroll
                    for (int n = 0; n < 2; ++n) acc[a][b][m][n] = (f32x4){0.f, 0.f, 0.f, 0.f};
        cur = nxt; cA = nA; cB = nB; ++ui;
        if constexpr (ALIGN_EPI) { if (wr == 1) PG8_BAR; }
    }
    PG8_WAIT_V(0);
    if constexpr (!ALIGN_EPI) { if (wr == 0) PG8_BAR; }
    PG8_BAR;
    if constexpr (Epi::AFTER_DRAIN) { E.fused(acc, cur, wr, wc, fr, fq, lds, wid, lane); S.done(cur); }
#undef PG8_SA
#undef PG8_SB
#undef PG8_STAGE
#undef PG8_LDA
#undef PG8_LDB
#undef PG8_MMA
#undef PG8_WAIT_V
#undef PG8_WAIT_L
#undef PG8_BAR
#undef PG8_SCHED
}
}

constexpr int NWAVES = 8;
constexpr int DM = 2048, TP = 8192, TS = 256, MROWS = TP + TS, NINP = 11008, NMOD = 6144;
constexpr int NBATCH_S = 32, TSEQ_S = 8, NPAGE = 64;
constexpr float QSCALE = 0.125f * 1.4426950408889634f;
constexpr float GQSCALE = 0.08838834764831845f;
constexpr size_t O_YP = 0, O_YS = 16777216, O_CMPP = 17301504, O_CMPS = 21495808, O_SELP = 21626880, O_SELS = 25821184,
                 O_WINP = 25952256, O_WINS = 26214400, O_STP = 34603008, O_STS = 34734080, O_TOTAL = 38928384;
constexpr size_t MiB = 1u << 20;
constexpr size_t WS_CTL = 0, CTL_ZERO_BYTES = 1 * MiB;
constexpr size_t WS_MOD = 786 * MiB;
constexpr size_t MOD_BYTES = (size_t)33 * 6144 * 8;
constexpr float MOD_SCALE = 4294967296.f, MOD_INV = 1.f / 4294967296.f;
constexpr size_t WS_ROPE = 2 * MiB;
constexpr size_t WS_POSB = 5 * MiB;
constexpr size_t WS_W1T = 6 * MiB;
constexpr size_t WS_WIN = 7 * MiB;
constexpr size_t WS_WCAT = 50 * MiB, WS_WOUT = 58 * MiB;
constexpr size_t WS_H = 66 * MiB;
constexpr size_t WS_QB = 99 * MiB;
constexpr size_t WS_KVB = 116 * MiB;
constexpr size_t WS_CB = 132 * MiB;
constexpr size_t CB_X = (size_t)33 * 4 * 8192 * 64;
constexpr size_t WS_PART = 397 * MiB;
constexpr int CROWS = 33 * 4 * 512;
constexpr size_t WS_KC = 464 * MiB;
constexpr size_t WS_ZN = 481 * MiB, WS_ZG = 498 * MiB;
constexpr size_t WS_MN = 515 * MiB, WS_MG = 548 * MiB;
constexpr size_t WS_QG = 581 * MiB, WS_KG = 590 * MiB;
constexpr size_t WS_VGT = 599 * MiB;
constexpr size_t WS_VGS = 615 * MiB;
constexpr size_t WS_AG = 616 * MiB;
constexpr size_t WS_GB = 617 * MiB;
constexpr size_t WS_LT = 619 * MiB;
constexpr size_t WS_DC = 683 * MiB;
constexpr size_t WS_ST = 684 * MiB;
constexpr size_t WS_OCAT = 716 * MiB;
constexpr size_t WS_MERGED = 750 * MiB;
constexpr size_t WS_RSS = 783 * MiB;
constexpr size_t WS_END = 788 * MiB;
constexpr int CW_BAR = 4096;
constexpr int CW_Q5 = 8192;
constexpr int RING_BYTES = 131072;
constexpr int LDSCTL_OFF = RING_BYTES;
constexpr int LDS_BYTES = 147456;

constexpr int KTLD = 72;
#define GAS __attribute__((address_space(1)))
#define LAS __attribute__((address_space(3)))
typedef unsigned short bf16;
typedef short bf16x8 __attribute__((ext_vector_type(8)));
typedef short s16x4 __attribute__((ext_vector_type(4)));
typedef float f32x4 __attribute__((ext_vector_type(4)));
typedef float f32x2 __attribute__((ext_vector_type(2)));
typedef float f32x16 __attribute__((ext_vector_type(16)));
typedef unsigned u32x4 __attribute__((ext_vector_type(4)));
typedef unsigned u32x2 __attribute__((ext_vector_type(2)));
typedef GAS unsigned gu32;
#define RLX_AGENT __ATOMIC_RELAXED, __HIP_MEMORY_SCOPE_AGENT
#define LDS_WAIT() asm volatile("s_waitcnt lgkmcnt(0)" ::: "memory")

__device__ __forceinline__ unsigned f2bf(float f) { unsigned u = __builtin_bit_cast(unsigned, f); return (u + 0x7fffu + ((u >> 16) & 1u)) >> 16; }
__device__ __forceinline__ unsigned pk2(float lo, float hi) { return f2bf(lo) | (f2bf(hi) << 16); }
__device__ __forceinline__ u32x4 pack8(const f32x4 a, const f32x4 b) { u32x4 o; o.x = pk2(a.x, a.y); o.y = pk2(a.z, a.w); o.z = pk2(b.x, b.y); o.w = pk2(b.z, b.w); return o; }
__device__ __forceinline__ u32x2 pack4(const f32x4 a) { u32x2 o; o.x = pk2(a.x, a.y); o.y = pk2(a.z, a.w); return o; }
__device__ __forceinline__ float bf2f(unsigned b) { return __builtin_bit_cast(float, b << 16); }
__device__ __forceinline__ float bflo(unsigned w) { return __builtin_bit_cast(float, w << 16); }
__device__ __forceinline__ float bfhi(unsigned w) { return __builtin_bit_cast(float, w & 0xffff0000u); }
__device__ __forceinline__ float sigm(float x) { return 1.f / (1.f + __expf(-x)); }
__device__ __forceinline__ float silu(float x) { return x / (1.f + __expf(-x)); }
__device__ __forceinline__ float ex2(float x) { return __builtin_amdgcn_exp2f(x); }
__device__ __forceinline__ float wave_sum(float v) {
#pragma unroll
    for (int o = 1; o < 64; o <<= 1) v += __shfl_xor(v, o);
    return v;
}
#define XB_TMO      128
#define XB_XCNT(j)  (256  + 64 * (j))
#define XB_XSUB(j)  (1280 + 64 * (j))
#define XB_XGEN(j)  (2304 + 64 * (j))
#define XB_TOP      3328
#define XB_TOPGEN   3392
#define XCD_BAR_WORDS 3456
#define XB_SPIN_CAP (1u << 18)

__device__ __forceinline__ unsigned xb_ld(unsigned* p)              { return __hip_atomic_load(p, __ATOMIC_RELAXED, __HIP_MEMORY_SCOPE_AGENT); }
__device__ __forceinline__ unsigned xb_add(unsigned* p, unsigned v) { return __hip_atomic_fetch_add(p, v, __ATOMIC_RELAXED, __HIP_MEMORY_SCOPE_AGENT); }
__device__ __forceinline__ unsigned xb_xcc_id() { return (unsigned)__builtin_amdgcn_s_getreg((3 << 11) | 20) & 0xFu; }
#define XB_SPIN(cond, bar) do { unsigned _sp = 0; while (cond) { __builtin_amdgcn_s_sleep(1); \
    if ((++_sp & 255u) == 0u) { if (xb_ld(&(bar)[XB_TMO])) break; if (_sp > XB_SPIN_CAP) { atomicAdd(&(bar)[XB_TMO], 1u); break; } } } } while (0)

struct XcdBarrier {
    unsigned* bar; unsigned x;
    volatile LAS unsigned* st;
};

__device__ __forceinline__ XcdBarrier xcd_barrier_post(unsigned* bar, volatile LAS unsigned* st) {
    XcdBarrier b; b.bar = bar; b.x = xb_xcc_id(); b.st = st;
    if (threadIdx.x == 0) (void)xb_add(&bar[XB_XCNT(b.x)], 1u);
    return b;
}
__device__ __forceinline__ void xcd_barrier_complete(unsigned* bar, unsigned x, unsigned& nloc, unsigned& nx) {
    const unsigned G = gridDim.x * gridDim.y * gridDim.z;
    unsigned sum, cnt, mine, sp = 0u;
    for (;;) {
        sum = 0u; cnt = 0u; mine = 0u;
#pragma unroll
        for (unsigned j = 0; j < 16; ++j) { const unsigned c = xb_ld(&bar[XB_XCNT(j)]); sum += c; cnt += (c > 0u) ? 1u : 0u; mine = (j == x) ? c : mine; }
        if (sum == G) break;
        __builtin_amdgcn_s_sleep(1);
        if ((++sp & 255u) == 0u) { if (xb_ld(&bar[XB_TMO])) break; if (sp > XB_SPIN_CAP) { atomicAdd(&bar[XB_TMO], 1u); break; } }
    }
    nloc = mine > 0u ? mine : 1u; nx = cnt > 0u ? cnt : 1u;
}

__device__ __forceinline__ void xcd_barrier(const XcdBarrier& b) {
    asm volatile("s_waitcnt vmcnt(0)" ::: "memory");
    __syncthreads();
    if (threadIdx.x == 0) {
        unsigned* bar = b.bar;
        __builtin_amdgcn_s_waitcnt(0);
        unsigned nloc = b.st[0], nx = b.st[1];
        if (nloc == 0u) { xcd_barrier_complete(bar, b.x, nloc, nx); b.st[0] = nloc; b.st[1] = nx; }
        const unsigned old = xb_add(&bar[XB_XSUB(b.x)], 1u);
        const unsigned gen = old / nloc;
        if (old + 1u == (gen + 1u) * nloc) {
            __builtin_amdgcn_fence(__ATOMIC_RELEASE, "agent");
            asm volatile("s_waitcnt vmcnt(0)" ::: "memory");
            const unsigned og = xb_add(&bar[XB_TOP], 1u);
            const unsigned tg = og / nx;
            if (og + 1u == (tg + 1u) * nx) xb_add(&bar[XB_TOPGEN], 1u);
            else XB_SPIN(xb_ld(&bar[XB_TOPGEN]) == tg, bar);
            __builtin_amdgcn_fence(__ATOMIC_ACQUIRE, "agent");
            xb_add(&bar[XB_XGEN(b.x)], 1u);
            asm volatile("s_waitcnt vmcnt(0)" ::: "memory");
        } else {
            XB_SPIN(xb_ld(&bar[XB_XGEN(b.x)]) == gen, bar);
            __builtin_amdgcn_fence(__ATOMIC_ACQUIRE, "agent");
            asm volatile("s_waitcnt vmcnt(0)" ::: "memory");
        }
    }
    __syncthreads();
}

struct Frame {
    LAS unsigned char* lds;
    volatile LAS unsigned* MISC;
    gu32* ctl;
    int tid, lane, wave, G, gw, NGW;
    const float *x_p, *x_s, *c_cmp, *c_sel, *c_win, *state, *c_p, *c_s, *norm_w, *w_ada, *b_ada, *w_in, *cmp_pos, *cmp_w1, *cmp_b1, *cmp_w2, *cmp_b2,
                *w_a2, *b_a, *gnw, *w_on, *w_og, *w_out, *fnw;
    const int* ptab;
    float* out;
    unsigned char* ws;
};
#define WSP(T, off) ((T*)(F.ws + (off)))

__device__ __forceinline__ int ropeperm(int pp) { const int j8 = pp >> 3, e = pp & 7; return e < 4 ? 4 * j8 + e : 32 + 4 * j8 + (e - 4); }
__device__ __forceinline__ int in_col(int n) {
    const int tile = n >> 8, pc = n & 255;
    if (tile < 4) return (tile * 4 + (pc >> 6)) * 64 + ropeperm(pc & 63);
    if (tile < 10) { const int t = tile - 4, br = t >> 1, x = t & 1, pp = pc & 63; return 1024 + br * 512 + x * 256 + (pc >> 6) * 64 + (x == 0 ? ropeperm(pp) : pp); }
    if (tile < 14) return 2608 + (n - 10 * 256);
    if (tile < 16) return 3632 + (n - 14 * 256);
    if (tile < 18) return 4144 + (n - 16 * 256);
    if (tile < 22) return 4656 + (n - 18 * 256);
    if (tile < 26) return 5696 + (n - 22 * 256);
    if (tile < 34) return 6720 + (n - 26 * 256);
    if (tile < 42) return 8768 + (n - 34 * 256);
    if (pc < 48) return 2560 + pc;
    if (pc < 64) return 5680 + (pc - 48);
    return -1;
}
template <bool MAPPED>
__device__ __forceinline__ void transpose_item(const float* __restrict__ W, int ldw, int K, bf16* WT, int row_off, LAS float* scr, int k0, int n0, int lane) {
    int col = n0 + (lane & 31);
    if (MAPPED) col = in_col(col);
#pragma unroll 8
    for (int i = 0; i < 32; ++i) { const int kk = 2 * i + (lane >> 5); scr[kk * 33 + (lane & 31)] = (col >= 0) ? W[(size_t)(k0 + kk) * ldw + col] : 0.f; }
    LDS_WAIT(); asm volatile("" ::: "memory");
    const int c = lane & 7;
#pragma unroll
    for (int j = 0; j < 4; ++j) { const int n = (lane >> 3) + 8 * j; const LAS float* s = scr + (8 * c) * 33 + n;
        u32x4 o; o.x = pk2(s[0 * 33], s[1 * 33]); o.y = pk2(s[2 * 33], s[3 * 33]); o.z = pk2(s[4 * 33], s[5 * 33]); o.w = pk2(s[6 * 33], s[7 * 33]);
        *(u32x4*)(WT + (size_t)(row_off + n0 + n) * K + k0 + 8 * c) = o; }
    LDS_WAIT(); asm volatile("" ::: "memory");
}
__device__ const float INVF[32] = {1.000000000e+00f, 7.498942018e-01f, 5.623413324e-01f, 4.216965139e-01f, 3.162277639e-01f, 2.371373773e-01f, 1.778279394e-01f, 1.333521456e-01f,
    1.000000015e-01f, 7.498942316e-02f, 5.623413250e-02f, 4.216964915e-02f, 3.162277490e-02f, 2.371373773e-02f, 1.778279431e-02f, 1.333521400e-02f,
    9.999999776e-03f, 7.498942316e-03f, 5.623413250e-03f, 4.216964822e-03f, 3.162277630e-03f, 2.371373819e-03f, 1.778279431e-03f, 1.333521446e-03f,
    1.000000047e-03f, 7.498941850e-04f, 5.623413017e-04f, 4.216965172e-04f, 3.162277571e-04f, 2.371373703e-04f, 1.778279402e-04f, 1.333521504e-04f};
__device__ __forceinline__ void sincos_acc(float a, float& s, float& c) {
    const double x = (double)a;
    const double kq = __builtin_rint(x * 0.63661977236758134308);
    double r = __builtin_fma(-kq, 1.5707963267948966192, x); r = __builtin_fma(-kq, 6.123233995736766e-17, r);
    const int q = ((int)kq) & 3;
    const double z = r * r;
    double sp = 1.0 / 6227020800.0; sp = sp * z - 1.0 / 39916800.0; sp = sp * z + 1.0 / 362880.0; sp = sp * z - 1.0 / 5040.0; sp = sp * z + 1.0 / 120.0; sp = sp * z - 1.0 / 6.0; sp = sp * z + 1.0; sp *= r;
    double cp = 1.0 / 479001600.0; cp = cp * z - 1.0 / 3628800.0; cp = cp * z + 1.0 / 40320.0; cp = cp * z - 1.0 / 720.0; cp = cp * z + 1.0 / 24.0; cp = cp * z - 0.5; cp = cp * z + 1.0;
    const double ss = (q == 0) ? sp : (q == 1) ? cp : (q == 2) ? -sp : -cp;
    const double cc = (q == 0) ? cp : (q == 1) ? -sp : (q == 2) ? -cp : sp;
    s = (float)ss; c = (float)cc;
}

__device__ __forceinline__ void p0_prologue(Frame& F, const int rep) {
    LAS float* scr = (LAS float*)(F.lds + F.wave * 16384);
    const int lane = F.lane;
    constexpr int I_IN = 32 * 344;
    for (int it = F.gw; it < I_IN; it += F.NGW) transpose_item<true>(F.w_in, 10816, 2048, WSP(bf16, WS_WIN), 0, scr, 64 * (it / 344), 32 * (it % 344), lane);
    for (int r = F.gw; r < 4 * 16 * 4 + 2 * 2 * 2; r += F.NGW) {
        if (r < 256) { const int xj = r / 64, rr = r % 64;
            transpose_item<false>(F.cmp_w1 + (size_t)xj * 1024 * 128, 128, 1024, WSP(bf16, WS_W1T) + (size_t)(xj >> 1) * 256 * 1024, (xj & 1) * 128, scr, 64 * (rr / 4), 32 * (rr % 4), lane); }
        else { const int x = (r - 256) / 4, rr = (r - 256) % 4;
            transpose_item<false>(F.cmp_w2 + (size_t)x * 128 * 64, 64, 128, WSP(bf16, WS_POSB + 4096) + (size_t)x * 64 * 128, 0, scr, 64 * (rr / 2), 32 * (rr % 2), lane); }
    }
    for (int it = F.gw; it < 256; it += F.NGW) {
        const int x = it >> 7, e = it & 127; float s = 0.f;
        for (int i = 0; i < 32; ++i) { const int ld = i * 64 + lane; s += F.cmp_pos[x * 2048 + ld] * F.cmp_w1[((size_t)x * 2048 + ld) * 128 + e]; }
        s = wave_sum(s);
        if (lane == 0) WSP(float, WS_POSB)[it] = s + F.cmp_b1[it];
    }
    for (int i = F.gw * 64 + lane; i < 8200 * 32; i += F.NGW * 64) {
        const int pos = i >> 5, j = i & 31; const float ang = (float)pos * INVF[j]; float s, c; sincos_acc(ang, s, c);
        WSP(float, WS_ROPE)[pos * 64 + j] = c; WSP(float, WS_ROPE)[pos * 64 + 32 + j] = s;
    }
    for (int item = blockIdx.x; item < (rep ? 0 : 256); item += F.G) {
        const int cg = item & 31, ks = item >> 5;
        LAS float* cl = (LAS float*)(F.lds);
        LAS float* accl = (LAS float*)(F.lds + 33 * 256 * 4);
        __syncthreads();
        for (int i = F.tid; i < 33 * 256; i += 512) { const int r = i >> 8, kk = i & 255; cl[i] = (r == 0) ? F.c_p[ks * 256 + kk] : F.c_s[(r - 1) * 2048 + ks * 256 + kk]; }
        for (int i = F.tid; i < 33 * 192; i += 512) accl[i] = 0.f;
        __syncthreads();
#pragma unroll 1
        for (int g3 = 0; g3 < 3; ++g3) {
            f32x4 acc[11];
#pragma unroll
            for (int r = 0; r < 11; ++r) acc[r] = (f32x4){0.f, 0.f, 0.f, 0.f};
            if (lane < 48) {
                const float* wp = F.w_ada + (size_t)(ks * 256 + F.wave * 32) * NMOD + cg * 192 + lane * 4;
                const LAS float* clg = cl + g3 * 11 * 256 + F.wave * 32;
#pragma unroll 1
                for (int kk0 = 0; kk0 < 32; kk0 += 8) {
                    f32x4 w[8];
#pragma unroll
                    for (int j = 0; j < 8; ++j) w[j] = *(const f32x4*)(wp + (size_t)(kk0 + j) * NMOD);
#pragma unroll
                    for (int j = 0; j < 8; ++j)
#pragma unroll
                        for (int r = 0; r < 11; ++r) acc[r] += w[j] * clg[r * 256 + kk0 + j];
                }
            }
#pragma unroll 1
            for (int ww = 0; ww < 8; ++ww) {
                if (F.wave == ww && lane < 48) {
#pragma unroll
                    for (int r = 0; r < 11; ++r) { LAS f32x4* a = (LAS f32x4*)(accl + (g3 * 11 + r) * 192 + lane * 4); *a = *a + acc[r]; }
                }
                __syncthreads();
            }
        }
        for (int i = F.tid; i < 33 * 192; i += 512) { const int r = i / 192, cc = i % 192;
            const float v = accl[i] + ((ks == 0) ? F.b_ada[cg * 192 + cc] : 0.f);
            atomicAdd(WSP(unsigned long long, WS_MOD) + (size_t)r * NMOD + cg * 192 + cc, (unsigned long long)(long long)__builtin_rintf(v * MOD_SCALE)); }
        __syncthreads();
    }
}

constexpr int D_CMP = NBATCH_S * 2 * 8;
constexpr int D_TR_W = 2 * 16 * 64 + 32 * 64;
constexpr int D_TR = D_TR_W / 8;
constexpr int D_WIN = (NBATCH_S * 504 * 128) / 4096;
constexpr int D_TOTAL = D_CMP + D_TR + D_WIN;
static_assert((NBATCH_S * 504 * 128) % 4096 == 0 && D_TR_W % 8 == 0, "deferred items");
__device__ __forceinline__ void compress_sample_unit(Frame& F, int idx) {
    const int tid = F.tid, lane = F.lane, w = F.wave, c = lane & 31, h = lane >> 5;
    const int b = idx >> 4, x = (idx >> 3) & 1, pj = (idx & 7) * 8 + w;
    const int page = F.ptab[b * NPAGE + pj];
    LAS bf16* Bs = (LAS bf16*)F.lds;
    const bf16* W = WSP(bf16, WS_W1T) + (size_t)x * 256 * 1024 + (size_t)(tid >> 1) * 1024 + (tid & 1) * 32;
    const float* ap = F.c_cmp + ((size_t)page * 128 + 16 * (c >> 2)) * 512 + x * 256 + (c & 3) * 64 + 8 * h;
    const int bst = (tid >> 1) * KTLD + (tid & 1) * 32;
    f32x16 acc[8];
#pragma unroll
    for (int nt = 0; nt < 8; ++nt)
#pragma unroll
        for (int r = 0; r < 16; ++r) acc[nt][r] = 0.f;
    u32x4 breg[4]; f32x4 areg[8];
#pragma unroll
    for (int i = 0; i < 4; ++i) breg[i] = *(const u32x4*)(W + 8 * i);
#pragma unroll
    for (int ks = 0; ks < 4; ++ks) { areg[2 * ks] = *(const f32x4*)(ap + 16 * ks); areg[2 * ks + 1] = *(const f32x4*)(ap + 16 * ks + 4); }
#pragma unroll 1
    for (int s = 0; s < 16; ++s) {
        LAS bf16* Bb = Bs + (s & 1) * 256 * KTLD;
#pragma unroll
        for (int i = 0; i < 4; ++i) *(LAS u32x4*)(Bb + bst + 8 * i) = breg[i];
        bf16x8 af[4];
#pragma unroll
        for (int ks = 0; ks < 4; ++ks) af[ks] = __builtin_bit_cast(bf16x8, pack8(areg[2 * ks], areg[2 * ks + 1]));
        __syncthreads();
        if (s + 1 < 16) {
#pragma unroll
            for (int i = 0; i < 4; ++i) breg[i] = *(const u32x4*)(W + 64 * (s + 1) + 8 * i);
#pragma unroll
            for (int ks = 0; ks < 4; ++ks) { areg[2 * ks] = *(const f32x4*)(ap + (size_t)(s + 1) * 512 + 16 * ks); areg[2 * ks + 1] = *(const f32x4*)(ap + (size_t)(s + 1) * 512 + 16 * ks + 4); }
        }
#pragma unroll
        for (int ks = 0; ks < 4; ++ks)
#pragma unroll
            for (int nt = 0; nt < 8; ++nt) { const bf16x8 bv = *(const LAS bf16x8*)(Bb + (32 * nt + c) * KTLD + 16 * ks + 8 * h); acc[nt] = __builtin_amdgcn_mfma_f32_32x32x16_bf16(af[ks], bv, acc[nt], 0, 0, 0); }
    }
    bf16* PART = WSP(bf16, WS_PART) + (size_t)x * CROWS * 256;
#pragma unroll
    for (int nt = 0; nt < 8; ++nt)
#pragma unroll
        for (int r = 0; r < 16; ++r) { const int m = (r & 3) + 8 * (r >> 2) + 4 * h; const size_t row = (size_t)(b * 4 + (m & 3)) * 512 + pj * 8 + (m >> 2);
            PART[row * 256 + 32 * nt + c] = (bf16)f2bf(acc[nt][r]); }
    __syncthreads();
}
__device__ __forceinline__ void p2_deferred_item(Frame& F, int item) {
    const int lane = F.lane;
    if (item < D_CMP) { compress_sample_unit(F, item); return; }
    item -= D_CMP;
    if (item < D_TR) {
        LAS float* scr = (LAS float*)(F.lds + F.wave * 16384);
        constexpr int I_ON = 16 * 64;
        int r = item * 8 + F.wave;
        if (r < I_ON) { transpose_item<false>(F.w_on, 2048, 2048, WSP(bf16, WS_WCAT), 0, scr, 64 * (r / 64), 32 * (r % 64), lane); return; } r -= I_ON;
        if (r < I_ON) { transpose_item<false>(F.w_og, 2048, 2048, WSP(bf16, WS_WCAT) + 1024, 0, scr, 64 * (r / 64), 32 * (r % 64), lane); return; } r -= I_ON;
        transpose_item<false>(F.w_out, 2048, 2048, WSP(bf16, WS_WOUT), 0, scr, 64 * (r / 64), 32 * (r % 64), lane);
        return;
    }
    item -= D_TR;
    {
        const f32x4* src = (const f32x4*)F.c_win; f32x4* dst = (f32x4*)(F.out + O_WINS);
        f32x4 v[8]; size_t di[8];
#pragma unroll
        for (int j = 0; j < 8; ++j) { const int i = item * 4096 + j * 512 + F.tid; const int b = i / (504 * 128), o = i % (504 * 128);
            di[j] = (size_t)b * 512 * 128 + o; v[j] = src[di[j] + 8 * 128]; }
#pragma unroll
        for (int j = 0; j < 8; ++j) dst[di[j]] = v[j];
    }
}

__device__ __forceinline__ void p1_modnorm(Frame& F) {
    const long long* MOD = WSP(long long, WS_MOD);
    bf16* H = WSP(bf16, WS_H);
    for (int r = F.gw; r < MROWS; r += F.NGW) {
        const float* xr = (r < TP) ? F.x_p + (size_t)r * DM : F.x_s + (size_t)(r - TP) * DM;
        const long long* mr = MOD + (size_t)((r < TP) ? 0 : 1 + ((r - TP) >> 3)) * NMOD;
        f32x4 v[8]; float ss = 0.f;
#pragma unroll
        for (int j = 0; j < 8; ++j) { v[j] = *(const f32x4*)(xr + (j * 64 + F.lane) * 4); ss += (v[j].x * v[j].x + v[j].y * v[j].y) + (v[j].z * v[j].z + v[j].w * v[j].w); }
        const float rstd = 1.f / sqrtf(wave_sum(ss) * (1.f / DM) + 1e-6f);
#pragma unroll
        for (int j = 0; j < 8; ++j) {
            const int c = (j * 64 + F.lane) * 4;
            const f32x4 nw = *(const f32x4*)(F.norm_w + c);
            const f32x4 sh = (f32x4){(float)mr[c], (float)mr[c + 1], (float)mr[c + 2], (float)mr[c + 3]} * MOD_INV;
            const f32x4 sc = (f32x4){(float)mr[2048 + c], (float)mr[2048 + c + 1], (float)mr[2048 + c + 2], (float)mr[2048 + c + 3]} * MOD_INV;
            const f32x4 hv = (v[j] * rstd) * nw * (sc + 1.0f) + sh;
            u32x2 o; o.x = pk2(hv.x, hv.y); o.y = pk2(hv.z, hv.w);
            *(u32x2*)(H + (size_t)r * DM + c) = o;
        }
    }
}


struct EpiPlainBf16 {
    static constexpr bool PERM = true, AFTER_DRAIN = false;
    bf16* O; int ldc;
    __device__ __forceinline__ void operator()(const f32x4 (&acc)[2][2][4][2], const pg8::Unit& u, int wr, int wc, int fr, int fq) const {
#pragma unroll
        for (int ai = 0; ai < 2; ++ai)
#pragma unroll
            for (int m = 0; m < 4; ++m) { const size_t row = (size_t)u.pm * 256 + ai * 128 + wr * 64 + m * 16 + fr;
#pragma unroll
                for (int bj = 0; bj < 2; ++bj) { const int col = u.pn * 256 + bj * 128 + wc * 32 + fq * 8;
                    *(u32x4*)(O + row * ldc + col) = pack8(acc[ai][bj][m][0], acc[ai][bj][m][1]); } }
    }
};

struct EpiIn {
    static constexpr bool PERM = true, AFTER_DRAIN = false;
    float* out; unsigned char* ws;
    __device__ __forceinline__ void operator()(const f32x4 (&acc)[2][2][4][2], const pg8::Unit& u, int wr, int wc, int fr, int fq) const {
        const int tile = u.pn;
        const float* ROPE = (const float*)(ws + WS_ROPE);
#pragma unroll
        for (int ai = 0; ai < 2; ++ai)
#pragma unroll
            for (int m = 0; m < 4; ++m) {
                const int row = u.pm * 256 + ai * 128 + wr * 64 + m * 16 + fr;
                const int pos = (row < TP) ? row : TP + ((row - TP) & 7);
#pragma unroll
                for (int bj = 0; bj < 2; ++bj) {
                    const int pc = bj * 128 + wc * 32 + fq * 8;
                    f32x4 v0 = acc[ai][bj][m][0], v1 = acc[ai][bj][m][1];
                    if (tile < 10) {
                        const int hh = pc >> 6, pp = pc & 63, j8 = pp >> 3;
                        const bool is_q = tile < 4; const int t = tile - 4, br = t >> 1, x = t & 1;
                        int d0, d1;
                        if (is_q || x == 0) {
                            const f32x4 cs = *(const f32x4*)(ROPE + (size_t)pos * 64 + 4 * j8), sn = *(const f32x4*)(ROPE + (size_t)pos * 64 + 32 + 4 * j8);
                            const f32x4 lo = v0 * cs - v1 * sn, hi = v1 * cs + v0 * sn; v0 = lo; v1 = hi; d0 = 4 * j8; d1 = 32 + 4 * j8;
                        } else { d0 = pp; d1 = pp + 4; }
                        if (is_q) {
                            bf16* q = (bf16*)(ws + WS_QB) + (size_t)row * 1024 + (tile * 4 + hh) * 64;
                            *(u32x2*)(q + d0) = pack4(v0 * QSCALE); *(u32x2*)(q + d1) = pack4(v1 * QSCALE);
                        } else {
                            const int co = x * 256 + hh * 64;
                            float* o = nullptr;
                            if (row < TP) {
                                if (br == 0) o = out + O_CMPP + (size_t)row * 512 + co;
                                else if (br == 1) o = out + O_SELP + (size_t)row * 512 + co;
                                else if (row >= TP - 512) o = out + O_WINP + (size_t)(row - (TP - 512)) * 512 + co;
                                bf16* kb = (br == 0) ? (bf16*)(ws + WS_CB) + (size_t)x * CB_X + ((size_t)(32 * 4 + hh) * 8192 + row) * 64
                                                     : (bf16*)(ws + WS_KVB) + ((size_t)(((br - 1) * 2 + x) * 4 + hh) * 8192 + row) * 64;
                                *(u32x2*)(kb + d0) = pack4(v0); *(u32x2*)(kb + d1) = pack4(v1);
                            } else {
                                const int sr = row - TP;
                                if (br == 0) o = out + O_CMPS + (size_t)sr * 512 + co;
                                else if (br == 1) o = out + O_SELS + (size_t)sr * 512 + co;
                                else o = out + O_WINS + ((size_t)(sr >> 3) * 512 + 504 + (sr & 7)) * 512 + co;
                            }
                            if (o) { *(f32x4*)(o + d0) = v0; *(f32x4*)(o + d1) = v1; }
                        }
                    } else if (tile < 14) {
                        const int col = (tile - 10) * 256 + pc;
                        v0 = (f32x4){silu(v0.x), silu(v0.y), silu(v0.z), silu(v0.w)}; v1 = (f32x4){silu(v1.x), silu(v1.y), silu(v1.z), silu(v1.w)};
                        *(u32x4*)((bf16*)(ws + WS_ZN) + (size_t)row * 1024 + col) = pack8(v0, v1);
                    } else if (tile < 16) {
                        *(u32x4*)((bf16*)(ws + WS_QG) + (size_t)row * 512 + (tile - 14) * 256 + pc) = pack8(v0 * GQSCALE, v1 * GQSCALE);
                    } else if (tile < 18) {
                        *(u32x4*)((bf16*)(ws + WS_KG) + (size_t)row * 512 + (tile - 16) * 256 + pc) = pack8(v0, v1);
                    } else if (tile < 22) {
                        const int col = (tile - 18) * 256 + pc;
                        if (row < TP) {
                            bf16* vt = (bf16*)(ws + WS_VGT) + ((size_t)(row >> 6) * 1024 + col) * 64 + (row & 63);
                            vt[0 * 64] = (bf16)f2bf(v0.x); vt[1 * 64] = (bf16)f2bf(v0.y); vt[2 * 64] = (bf16)f2bf(v0.z); vt[3 * 64] = (bf16)f2bf(v0.w);
                            vt[4 * 64] = (bf16)f2bf(v1.x); vt[5 * 64] = (bf16)f2bf(v1.y); vt[6 * 64] = (bf16)f2bf(v1.z); vt[7 * 64] = (bf16)f2bf(v1.w);
                        } else {
                            float* vs = (float*)(ws + WS_VGS) + (size_t)(row - TP) * 1024 + col;
                            *(f32x4*)vs = v0; *(f32x4*)(vs + 4) = v1;
                        }
                    } else if (tile < 26) {
                        const int col = (tile - 22) * 256 + pc;
                        v0 = (f32x4){silu(v0.x), silu(v0.y), silu(v0.z), silu(v0.w)}; v1 = (f32x4){silu(v1.x), silu(v1.y), silu(v1.z), silu(v1.w)};
                        *(u32x4*)((bf16*)(ws + WS_ZG) + (size_t)row * 1024 + col) = pack8(v0, v1);
                    } else if (tile < 42) {
                        const bool mn = tile < 34; const int col = (tile - (mn ? 26 : 34)) * 256 + pc;
                        v0 = (f32x4){sigm(v0.x), sigm(v0.y), sigm(v0.z), sigm(v0.w)}; v1 = (f32x4){sigm(v1.x), sigm(v1.y), sigm(v1.z), sigm(v1.w)};
                        *(u32x4*)((bf16*)(ws + (mn ? WS_MN : WS_MG)) + (size_t)row * 2048 + col) = pack8(v0, v1);
                    } else {
                        if (pc < 48) {
                            v0 = (f32x4){sigm(v0.x), sigm(v0.y), sigm(v0.z), sigm(v0.w)}; v1 = (f32x4){sigm(v1.x), sigm(v1.y), sigm(v1.z), sigm(v1.w)};
                            float* g = (float*)(ws + WS_GB) + (size_t)row * 48 + pc; *(f32x4*)g = v0; *(f32x4*)(g + 4) = v1;
                        } else if (pc < 64) {
                            float* a = (float*)(ws + WS_AG) + (size_t)row * 16 + (pc - 48); *(f32x4*)a = v0; *(f32x4*)(a + 4) = v1;
                        }
                    }
                }
            }
    }
};

struct EpiMergeZ {
    static constexpr bool PERM = true, AFTER_DRAIN = false;
    const bf16* GN; const bf16* GG; bf16* O;
    __device__ __forceinline__ void operator()(const f32x4 (&acc)[2][2][4][2], const pg8::Unit& u, int wr, int wc, int fr, int fq) const {
        const bf16* G = u.z ? GG : GN;
#pragma unroll
        for (int ai = 0; ai < 2; ++ai)
#pragma unroll
            for (int m = 0; m < 4; ++m) { const size_t row = (size_t)u.pm * 256 + ai * 128 + wr * 64 + m * 16 + fr;
#pragma unroll
                for (int bj = 0; bj < 2; ++bj) { const int col = u.pn * 256 + bj * 128 + wc * 32 + fq * 8;
                    const u32x4 g = *(const u32x4*)(G + row * 2048 + col);
                    f32x4 v0 = acc[ai][bj][m][0] * (f32x4){bflo(g.x), bfhi(g.x), bflo(g.y), bfhi(g.y)};
                    f32x4 v1 = acc[ai][bj][m][1] * (f32x4){bflo(g.z), bfhi(g.z), bflo(g.w), bfhi(g.w)};
                    if (u.z) { const u32x4 p = *(const u32x4*)(O + row * 2048 + col);
                        v0 += (f32x4){bflo(p.x), bfhi(p.x), bflo(p.y), bfhi(p.y)}; v1 += (f32x4){bflo(p.z), bfhi(p.z), bflo(p.w), bfhi(p.w)}; }
                    *(u32x4*)(O + row * 2048 + col) = pack8(v0, v1); } }
    }
};
struct EpiOut {
    static constexpr bool PERM = true, AFTER_DRAIN = false;
    const float* x_p; const float* x_s; const long long* MOD; float* out; float* RSS;
    __device__ __forceinline__ void operator()(const f32x4 (&acc)[2][2][4][2], const pg8::Unit& u, int wr, int wc, int fr, int fq) const {
#pragma unroll
        for (int ai = 0; ai < 2; ++ai)
#pragma unroll
            for (int m = 0; m < 4; ++m) { const int row = u.pm * 256 + ai * 128 + wr * 64 + m * 16 + fr;
                const float* xr = (row < TP) ? x_p + (size_t)row * DM : x_s + (size_t)(row - TP) * DM;
                const long long* gr = MOD + (size_t)((row < TP) ? 0 : 1 + ((row - TP) >> 3)) * NMOD + 4096;
                float* yr = out + ((row < TP) ? O_YP + (size_t)row * DM : O_YS + (size_t)(row - TP) * DM);
                float ss = 0.f;
#pragma unroll
                for (int bj = 0; bj < 2; ++bj) { const int col = u.pn * 256 + bj * 128 + wc * 32 + fq * 8;
#pragma unroll
                    for (int n = 0; n < 2; ++n) { const long long* gp = gr + col + 4 * n; const f32x4 gt = (f32x4){(float)gp[0], (float)gp[1], (float)gp[2], (float)gp[3]} * MOD_INV;
                        const f32x4 y = *(const f32x4*)(xr + col + 4 * n) + gt * acc[ai][bj][m][n];
                        *(f32x4*)(yr + col + 4 * n) = y; ss += (y.x * y.x + y.y * y.y) + (y.z * y.z + y.w * y.w); } }
                ss += __shfl_xor(ss, 16); ss += __shfl_xor(ss, 32);
                if (fq == 0) RSS[(size_t)row * 64 + u.pn * 4 + wc] = ss; }
    }
};


template <class Epi>
__device__ __forceinline__ void wave_gemm_tiles(Frame& F, const bf16* A, int lda, const bf16* Bt, int ldb, int m0, int mtiles, int ntiles, int K, const Epi& E) {
    const int lane = F.lane, c = lane & 31, h = lane >> 5, grp = F.wave >> 2, ks = F.wave & 3, kq = K >> 2;
    LAS float* red = (LAS float*)(F.lds) + (grp * 3) * 1024;
    const int T = mtiles * ntiles;
    for (int t2 = blockIdx.x; 2 * t2 < T; t2 += F.G) {
        const int t = 2 * t2 + grp;
        const int tm = t / ntiles, tn = t % ntiles;
        const bf16* ap = A + (size_t)(m0 + 32 * tm + c) * lda + ks * kq + 8 * h;
        const bf16* bp = Bt + (size_t)(32 * tn + c) * ldb + ks * kq + 8 * h;
        f32x16 acc;
#pragma unroll
        for (int r = 0; r < 16; ++r) acc[r] = 0.f;
#pragma unroll 4
        for (int k = 0; k < kq; k += 16) { const bf16x8 a = *(const bf16x8*)(ap + k), b = *(const bf16x8*)(bp + k); acc = __builtin_amdgcn_mfma_f32_32x32x16_bf16(a, b, acc, 0, 0, 0); }
        if constexpr (Epi::PRE) E.pre(acc, m0 + 32 * tm, 32 * tn, ks, lane);
        __syncthreads();
        if (ks != 0) {
#pragma unroll
            for (int r = 0; r < 16; ++r) red[((ks - 1) * 16 + r) * 64 + lane] = acc[r];
        }
        __syncthreads();
        if (ks == 0) {
#pragma unroll
            for (int r = 0; r < 16; ++r) acc[r] += (red[(0 * 16 + r) * 64 + lane] + red[(1 * 16 + r) * 64 + lane]) + red[(2 * 16 + r) * 64 + lane];
            E(acc, m0 + 32 * tm, 32 * tn, tn, lane);
        }
    }
    __syncthreads();
}
struct SEpiPlain { static constexpr bool PRE = false; bf16* O; int ldc;
    __device__ __forceinline__ void operator()(const f32x16& acc, int m0, int n0, int tn, int lane) const { const int c = lane & 31, h = lane >> 5;
#pragma unroll
        for (int r = 0; r < 16; ++r) O[(size_t)(m0 + (r & 3) + 8 * (r >> 2) + 4 * h) * ldc + n0 + c] = (bf16)f2bf(acc[r]); } };
struct SEpiMergeCat { static constexpr bool PRE = true; const bf16* GN; const bf16* GG; bf16* O;
    __device__ __forceinline__ void pre(f32x16& acc, int m0, int n0, int ks, int lane) const { const int c = lane & 31, h = lane >> 5; const bf16* G = (ks < 2) ? GN : GG;
#pragma unroll
        for (int r = 0; r < 16; ++r) acc[r] *= bf2f(G[(size_t)(m0 + (r & 3) + 8 * (r >> 2) + 4 * h) * 2048 + n0 + c]); }
    __device__ __forceinline__ void operator()(const f32x16& acc, int m0, int n0, int tn, int lane) const { const int c = lane & 31, h = lane >> 5;
#pragma unroll
        for (int r = 0; r < 16; ++r) O[(size_t)(m0 + (r & 3) + 8 * (r >> 2) + 4 * h) * 2048 + n0 + c] = (bf16)f2bf(acc[r]); } };
struct SEpiOut { static constexpr bool PRE = false; const float* x_s; const long long* MOD; float* out; float* RSS;
    __device__ __forceinline__ void operator()(const f32x16& acc, int m0, int n0, int tn, int lane) const { const int c = lane & 31, h = lane >> 5;
#pragma unroll
        for (int r = 0; r < 16; ++r) { const int row = m0 + (r & 3) + 8 * (r >> 2) + 4 * h, sr = row - TP;
            const float y = x_s[(size_t)sr * DM + n0 + c] + ((float)MOD[(size_t)(1 + (sr >> 3)) * NMOD + 4096 + n0 + c] * MOD_INV) * acc[r];
            out[O_YS + (size_t)sr * DM + n0 + c] = y;
            float ss = y * y; ss += __shfl_xor(ss, 1); ss += __shfl_xor(ss, 2); ss += __shfl_xor(ss, 4); ss += __shfl_xor(ss, 8); ss += __shfl_xor(ss, 16);
            if (c == 0) RSS[(size_t)row * 64 + tn] = ss; } } };

__device__ __forceinline__ void compress_l2(Frame& F) {
    const int lane = F.lane, c32 = lane & 31, h = lane >> 5;
    const float* POSB = WSP(float, WS_POSB);
    for (int x = 0; x < 2; ++x) {
        const bf16* W2T = WSP(bf16, WS_POSB + 4096) + (size_t)x * 64 * 128;
        const bf16* PART = WSP(bf16, WS_PART) + (size_t)x * CROWS * 256;
        bf16* KC = WSP(bf16, WS_KC) + (size_t)x * CROWS * 64;
        bf16x8 bfr[2][8];
#pragma unroll
        for (int dt = 0; dt < 2; ++dt)
#pragma unroll
            for (int ks = 0; ks < 8; ++ks) bfr[dt][ks] = *(const bf16x8*)(W2T + (size_t)(32 * dt + c32) * 128 + 16 * ks + 8 * h);
        const float b2a = F.cmp_b2[x * 64 + c32], b2b = F.cmp_b2[x * 64 + 32 + c32];
        for (int it = F.gw; it < CROWS / 32; it += F.NGW) {
            const size_t row = (size_t)it * 32 + c32;
            f32x16 o0, o1;
#pragma unroll
            for (int r = 0; r < 16; ++r) { o0[r] = 0.f; o1[r] = 0.f; }
#pragma unroll
            for (int ks = 0; ks < 8; ++ks) {
                const int e0 = 16 * ks + 8 * h;
                const u32x4 p0 = *(const u32x4*)(PART + row * 256 + e0), p1 = *(const u32x4*)(PART + (row + 1) * 256 + 128 + e0);
                const f32x4 ba = *(const f32x4*)(POSB + x * 128 + e0), bb = *(const f32x4*)(POSB + x * 128 + e0 + 4);
                f32x4 a = (f32x4){bflo(p0.x) + bflo(p1.x), bfhi(p0.x) + bfhi(p1.x), bflo(p0.y) + bflo(p1.y), bfhi(p0.y) + bfhi(p1.y)} + ba;
                f32x4 b = (f32x4){bflo(p0.z) + bflo(p1.z), bfhi(p0.z) + bfhi(p1.z), bflo(p0.w) + bflo(p1.w), bfhi(p0.w) + bfhi(p1.w)} + bb;
                a = (f32x4){silu(a.x), silu(a.y), silu(a.z), silu(a.w)}; b = (f32x4){silu(b.x), silu(b.y), silu(b.z), silu(b.w)};
                const u32x4 hp = pack8(a, b); const bf16x8 hf = __builtin_bit_cast(bf16x8, hp);
                o0 = __builtin_amdgcn_mfma_f32_32x32x16_bf16(hf, bfr[0][ks], o0, 0, 0, 0);
                o1 = __builtin_amdgcn_mfma_f32_32x32x16_bf16(hf, bfr[1][ks], o1, 0, 0, 0);
            }
#pragma unroll
            for (int r = 0; r < 16; ++r) {
                const size_t orow = (size_t)it * 32 + (r & 3) + 8 * (r >> 2) + 4 * h;
                const bool dead = (orow & 511) == 511;
                KC[orow * 64 + c32] = dead ? (bf16)0 : (bf16)f2bf(o0[r] + b2a);
                KC[orow * 64 + 32 + c32] = dead ? (bf16)0 : (bf16)f2bf(o1[r] + b2b);
            }
        }
    }
}

__device__ __forceinline__ void final_norm(Frame& F) {
    const float* RSS = WSP(float, WS_RSS);
    for (int r = F.gw; r < MROWS; r += F.NGW) {
        float* yr = F.out + ((r < TP) ? O_YP + (size_t)r * DM : O_YS + (size_t)(r - TP) * DM);
        float ss = (F.lane < 32 || r >= TP) ? RSS[(size_t)r * 64 + F.lane] : 0.f;
        const float rstd = 1.f / sqrtf(wave_sum(ss) * (1.f / DM) + 1e-6f);
#pragma unroll
        for (int j = 0; j < 8; ++j) { const int c = (j * 64 + F.lane) * 4;
            const f32x4 v = *(const f32x4*)(yr + c) * rstd * *(const f32x4*)(F.fnw + c); *(f32x4*)(yr + c) = v; }
    }
}

typedef short v4i16_t __attribute__((ext_vector_type(4)));
__device__ __forceinline__ s16x4 tr_read(const LAS bf16* p) { return __builtin_bit_cast(s16x4, __builtin_amdgcn_ds_read_tr16_b64_v4i16((LAS v4i16_t*)p)); }
typedef __bf16 bf16x2_t __attribute__((ext_vector_type(2)));
__device__ __forceinline__ unsigned cvtpk(float lo, float hi) { const f32x2 v = {lo, hi}; const bf16x2_t b = __builtin_convertvector(v, bf16x2_t); return __builtin_bit_cast(unsigned, b); }

template <int NKT>
__device__ __forceinline__ void qk_scores(f32x16 (&s)[NKT], const LAS bf16* Kt, const bf16x8 (&qf)[4], int lane) {
    const int c = lane & 31, h = lane >> 5;
#pragma unroll
    for (int kt = 0; kt < NKT; ++kt) {
#pragma unroll
        for (int r = 0; r < 16; ++r) s[kt][r] = 0.f;
#pragma unroll
        for (int ks = 0; ks < 4; ++ks) {
            const bf16x8 a = *(const LAS bf16x8*)(Kt + (32 * kt + c) * KTLD + 16 * ks + 8 * h);
            s[kt] = __builtin_amdgcn_mfma_f32_32x32x16_bf16(a, qf[ks], s[kt], 0, 0, 0);
        }
    }
}
template <int NKT>
__device__ __forceinline__ void pv_accum(f32x16 (&o)[2], const f32x16 (&p)[NKT], const LAS bf16* Vt, int lane) {
    const int i16 = lane & 15, g16 = lane >> 4, h = lane >> 5;
    const LAS bf16* vb = Vt + (4 * h + (i16 >> 2)) * KTLD + 16 * (g16 & 1) + 4 * (i16 & 3);
#pragma unroll
    for (int kt = 0; kt < NKT; ++kt)
#pragma unroll
        for (int s2 = 0; s2 < 2; ++s2) {
            u32x4 pw; pw.x = cvtpk(p[kt][8 * s2 + 0], p[kt][8 * s2 + 1]); pw.y = cvtpk(p[kt][8 * s2 + 2], p[kt][8 * s2 + 3]);
            pw.z = cvtpk(p[kt][8 * s2 + 4], p[kt][8 * s2 + 5]); pw.w = cvtpk(p[kt][8 * s2 + 6], p[kt][8 * s2 + 7]);
            const bf16x8 pf = __builtin_bit_cast(bf16x8, pw);
#pragma unroll
            for (int dt = 0; dt < 2; ++dt) {
                const s16x4 lo = tr_read(vb + (32 * kt + 16 * s2) * KTLD + 32 * dt), hi = tr_read(vb + (32 * kt + 16 * s2 + 8) * KTLD + 32 * dt);
                const bf16x8 vf = (bf16x8){lo[0], lo[1], lo[2], lo[3], hi[0], hi[1], hi[2], hi[3]};
                o[dt] = __builtin_amdgcn_mfma_f32_32x32x16_bf16(vf, pf, o[dt], 0, 0, 0);
            }
            __builtin_amdgcn_sched_barrier(0);
        }
}
template <int NKT>
__device__ __forceinline__ float mask_max(f32x16 (&s)[NKT], int lo, int hi, int h) {
    const int lo2 = lo - 4 * h, hi2 = hi - 4 * h; float mx = -1e30f;
#pragma unroll
    for (int kt = 0; kt < NKT; ++kt)
#pragma unroll
        for (int r = 0; r < 16; ++r) { const int ko = 32 * kt + (r & 3) + 8 * (r >> 2); const bool v = (ko >= lo2) && (ko <= hi2);
            const float x = v ? s[kt][r] : -1e30f; s[kt][r] = x; mx = fmaxf(mx, x); }
    return fmaxf(mx, __shfl_xor(mx, 32));
}
struct FlashSt { float m, l; f32x16 o[2]; };
__device__ __forceinline__ void flash_init(FlashSt& st) { st.m = -1e30f; st.l = 0.f;
#pragma unroll
    for (int r = 0; r < 16; ++r) { st.o[0][r] = 0.f; st.o[1][r] = 0.f; } }
template <int NKT>
__device__ __forceinline__ void flash_tile(FlashSt& st, const LAS bf16* Kt, const LAS bf16* Vt, const bf16x8 (&qf)[4], int lo, int hi, int lane) {
    f32x16 s[NKT];
    qk_scores<NKT>(s, Kt, qf, lane);
    const float mx = mask_max<NKT>(s, lo, hi, lane >> 5);
    const float mn = fmaxf(st.m, mx), alpha = ex2(st.m - mn); st.m = mn;
    float ps = 0.f;
#pragma unroll
    for (int kt = 0; kt < NKT; ++kt)
#pragma unroll
        for (int r = 0; r < 16; ++r) { const float x = s[kt][r]; const float p = (x > -1e29f) ? ex2(x - mn) : 0.f; s[kt][r] = p; ps += p; }
    st.l = st.l * alpha + ps;
#pragma unroll
    for (int r = 0; r < 16; ++r) { st.o[0][r] *= alpha; st.o[1][r] *= alpha; }
    pv_accum<NKT>(st.o, s, Vt, lane);
}
template <int NKT>
__device__ __forceinline__ void stats_tile(float& m, float& l, const LAS bf16* Kt, const bf16x8 (&qf)[4], int lo, int hi, int lane) {
    f32x16 s[NKT];
    qk_scores<NKT>(s, Kt, qf, lane);
    const float mx = mask_max<NKT>(s, lo, hi, lane >> 5);
    const float mn = fmaxf(m, mx), alpha = ex2(m - mn); m = mn;
    float ps = 0.f;
#pragma unroll
    for (int kt = 0; kt < NKT; ++kt)
#pragma unroll
        for (int r = 0; r < 16; ++r) { const float x = s[kt][r]; ps += (x > -1e29f) ? ex2(x - mn) : 0.f; }
    l = l * alpha + ps;
}
template <int NKT>
__device__ __forceinline__ void cmp2_tile(f32x16 (&o)[2], const LAS bf16* Kt, const LAS bf16* Vt, const bf16x8 (&qf)[4], int lo, int hi, float M, float invL,
                                          LAS float* impA, LAS float* impB, int q, int impld, int n_base, int lane) {
    f32x16 s[NKT];
    qk_scores<NKT>(s, Kt, qf, lane);
    (void)mask_max<NKT>(s, lo, hi, lane >> 5);
#pragma unroll
    for (int kt = 0; kt < NKT; ++kt)
#pragma unroll
        for (int r = 0; r < 16; ++r) { const float x = s[kt][r]; s[kt][r] = (x > -1e29f) ? ex2(x - M) * invL : 0.f; }
    const int h = lane >> 5;
#pragma unroll
    for (int kt = 0; kt < NKT; ++kt)
#pragma unroll
        for (int k4 = 0; k4 < 4; ++k4) {
            float s4 = (s[kt][4 * k4] + s[kt][4 * k4 + 1]) + (s[kt][4 * k4 + 2] + s[kt][4 * k4 + 3]), p3 = s[kt][4 * k4 + 3];
            s4 += __shfl_xor(s4, 8); s4 += __shfl_xor(s4, 16); p3 += __shfl_xor(p3, 8); p3 += __shfl_xor(p3, 16);
            if ((lane & 24) == 0) { const int n0 = n_base + 8 * kt + 2 * k4 + h; impA[q * impld + n0] = s4; impB[q * impld + n0 + 1] = p3; }
        }
    pv_accum<NKT>(o, s, Vt, lane);
}

constexpr int IMPLD = 130;
__device__ __forceinline__ void nsa_prompt_unit(Frame& F, int qt, int kvh) {
    const int tid = F.tid, lane = F.lane, w = F.wave, c = lane & 31, h = lane >> 5, qi = c & 7, g = c >> 3;
    LAS bf16* Kt0 = (LAS bf16*)(F.lds);
    LAS bf16* Vt0 = (LAS bf16*)(F.lds + 18432);
    LAS float* impA = (LAS float*)(F.lds + 36864);
    LAS float* impB = (LAS float*)(F.lds + 36864 + 33280);
    LAS unsigned* selb = (LAS unsigned*)(F.lds + 36864 + 66560);
    const int q_off = 8 * w + qi, token = 64 * qt + q_off, head = kvh * 4 + g;
    const bf16* QB = WSP(bf16, WS_QB);
    bf16x8 qf[4];
#pragma unroll
    for (int ks = 0; ks < 4; ++ks) qf[ks] = *(const bf16x8*)(QB + (size_t)token * 1024 + head * 64 + 16 * ks + 8 * h);
    const float* gbp = WSP(float, WS_GB) + (size_t)token * 48 + head * 3;
    const float gb_c = gbp[0], gb_s = gbp[1], gb_w = gbp[2];
    f32x16 oacc[2];
#pragma unroll
    for (int r = 0; r < 16; ++r) { oacc[0][r] = 0.f; oacc[1][r] = 0.f; }
    const int srow = tid >> 3, sch = tid & 7;
    const int lds_st = srow * KTLD + sch * 8;

    {
        const bf16* KCk = WSP(bf16, WS_KC) + ((size_t)(32 * 4 + kvh) * 512) * 64;
        const bf16* KCv = WSP(bf16, WS_KC) + (size_t)CROWS * 64 + ((size_t)(32 * 4 + kvh) * 512) * 64;
        int cmax = (token - 31) >> 4; if (cmax > 510) cmax = 510;
        const int nT = ((4 * qt + 2) >> 6) + 1;
        float m = -1e30f, l = 0.f;
        u32x4 kreg = *(const u32x4*)(KCk + (size_t)srow * 64 + sch * 8), vreg;
        for (int t = 0; t < nT; ++t) {
            LAS bf16* Kt = Kt0 + (t & 1) * 64 * KTLD;
            *(LAS u32x4*)(Kt + lds_st) = kreg;
            __syncthreads();
            if (t + 1 < nT) kreg = *(const u32x4*)(KCk + (size_t)((t + 1) * 64 + srow) * 64 + sch * 8);
            int hi = cmax - 64 * t; if (hi > 63) hi = 63;
            stats_tile<2>(m, l, Kt, qf, 0, hi, lane);
        }
        l += __shfl_xor(l, 32);
        const float invL = (l > 0.f) ? 1.f / l : 0.f;
        __syncthreads();
        kreg = *(const u32x4*)(KCk + (size_t)srow * 64 + sch * 8); vreg = *(const u32x4*)(KCv + (size_t)srow * 64 + sch * 8);
        f32x16 o[2];
#pragma unroll
        for (int r = 0; r < 16; ++r) { o[0][r] = 0.f; o[1][r] = 0.f; }
        for (int t = 0; t < nT; ++t) {
            LAS bf16* Kt = Kt0 + (t & 1) * 64 * KTLD; LAS bf16* Vt = Vt0 + (t & 1) * 64 * KTLD;
            *(LAS u32x4*)(Kt + lds_st) = kreg; *(LAS u32x4*)(Vt + lds_st) = vreg;
            __syncthreads();
            if (t + 1 < nT) { kreg = *(const u32x4*)(KCk + (size_t)((t + 1) * 64 + srow) * 64 + sch * 8); vreg = *(const u32x4*)(KCv + (size_t)((t + 1) * 64 + srow) * 64 + sch * 8); }
            int hi = cmax - 64 * t; if (hi > 63) hi = 63;
            cmp2_tile<2>(o, Kt, Vt, qf, 0, hi, m, invL, impA, impB, q_off, IMPLD, 16 * t, lane);
        }
#pragma unroll
        for (int r = 0; r < 16; ++r) { oacc[0][r] += gb_c * o[0][r]; oacc[1][r] += gb_c * o[1][r]; }
    }
    __syncthreads();
    if (tid < 256) selb[tid] = 0u;
    __syncthreads();
    if (qt <= 15) {
        if (tid < 64) selb[tid * 4] = (1u << (qt + 1)) - 1u;
    } else {
        const int q = tid >> 3, sub = tid & 7, nhi = qt - 2;
#pragma unroll 1
        for (int i = 0; i < 16; ++i) { const int n = sub + 8 * i; if (n >= 1 && n <= nhi) impA[q * IMPLD + n] += impB[q * IMPLD + n]; }
        __syncthreads();
#pragma unroll 1
        for (int i = 0; i < 16; ++i) {
            const int n = sub + 8 * i; bool sel;
            if (n >= 1 && n <= nhi) {
                const float v = impA[q * IMPLD + n]; int rank = 0;
#pragma unroll 4
                for (int mm = 1; mm <= nhi; ++mm) { const float vm = impA[q * IMPLD + mm]; rank += (vm > v || (vm == v && mm < n)) ? 1 : 0; }
                sel = rank < 13;
            } else sel = (n == 0 || n == qt || n == qt - 1);
            if (sel) atomicOr((unsigned*)&selb[q * 4 + (n >> 5)], 1u << (n & 31));
        }
    }
    __syncthreads();
    {
        const bf16* Kg = WSP(bf16, WS_KVB) + ((size_t)((0 * 2 + 0) * 4 + kvh) * 8192) * 64;
        const bf16* Vg = WSP(bf16, WS_KVB) + ((size_t)((0 * 2 + 1) * 4 + kvh) * 8192) * 64;
        const unsigned sw0 = selb[q_off * 4 + 0], sw1 = selb[q_off * 4 + 1], sw2 = selb[q_off * 4 + 2], sw3 = selb[q_off * 4 + 3];
        FlashSt st; flash_init(st);
        LAS bf16* KS = (LAS bf16*)(F.lds); LAS bf16* VS = (LAS bf16*)(F.lds + 36864);
#define LDT(kr, vr, blkn) { kr = *(const u32x4*)(Kg + (size_t)((blkn) * 64 + srow) * 64 + sch * 8); vr = *(const u32x4*)(Vg + (size_t)((blkn) * 64 + srow) * 64 + sch * 8); }
#define STT(kr, vr, slot) { *(LAS u32x4*)(KS + (slot) * 64 * KTLD + lds_st) = kr; *(LAS u32x4*)(VS + (slot) * 64 * KTLD + lds_st) = vr; }
#define SEL_TILE(slot, blk) { const unsigned swd = ((blk) < 32) ? sw0 : ((blk) < 64) ? sw1 : ((blk) < 96) ? sw2 : sw3; const bool sq = (swd >> ((blk) & 31)) & 1u; \
            const int lo = sq ? 0 : 1, hi = sq ? (((blk) == qt) ? q_off : 63) : 0; flash_tile<2>(st, KS + (slot) * 64 * KTLD, VS + (slot) * 64 * KTLD, qf, lo, hi, lane); }
        u32x4 k0, v0, k1 = (u32x4){0u, 0u, 0u, 0u}, v1 = k1;
        LDT(k0, v0, 0) if (qt >= 1) LDT(k1, v1, 1)
        for (int blk = 0; blk <= qt; blk += 2) {
            const int sb = blk & 2; const bool two = (blk + 1 <= qt);
            STT(k0, v0, sb) if (two) STT(k1, v1, sb + 1)
            __syncthreads();
            if (blk + 2 <= qt) LDT(k0, v0, blk + 2)
            if (blk + 3 <= qt) LDT(k1, v1, blk + 3)
            SEL_TILE(sb, blk)
            if (two) SEL_TILE(sb + 1, blk + 1)
        }
#undef SEL_TILE
        const float lt = st.l + __shfl_xor(st.l, 32); const float sc = (lt > 0.f) ? gb_s / lt : 0.f;
#pragma unroll
        for (int r = 0; r < 16; ++r) { oacc[0][r] += sc * st.o[0][r]; oacc[1][r] += sc * st.o[1][r]; }
    }
    __syncthreads();
    {
        const bf16* Kg = WSP(bf16, WS_KVB) + ((size_t)((1 * 2 + 0) * 4 + kvh) * 8192) * 64;
        const bf16* Vg = WSP(bf16, WS_KVB) + ((size_t)((1 * 2 + 1) * 4 + kvh) * 8192) * 64;
        const int b0 = (qt >= 8) ? qt - 8 : 0;
        FlashSt st; flash_init(st);
        LAS bf16* KS = (LAS bf16*)(F.lds); LAS bf16* VS = (LAS bf16*)(F.lds + 36864);
#define WIN_TILE(slot, blk) { const int lo = ((blk) == qt - 8) ? q_off + 1 : 0, hi = ((blk) == qt) ? q_off : 63; flash_tile<2>(st, KS + (slot) * 64 * KTLD, VS + (slot) * 64 * KTLD, qf, lo, hi, lane); }
        u32x4 k0, v0, k1 = (u32x4){0u, 0u, 0u, 0u}, v1 = k1;
        LDT(k0, v0, b0) if (b0 + 1 <= qt) LDT(k1, v1, b0 + 1)
        for (int blk = b0; blk <= qt; blk += 2) {
            const int sb = (blk - b0) & 2; const bool two = (blk + 1 <= qt);
            STT(k0, v0, sb) if (two) STT(k1, v1, sb + 1)
            __syncthreads();
            if (blk + 2 <= qt) LDT(k0, v0, blk + 2)
            if (blk + 3 <= qt) LDT(k1, v1, blk + 3)
            WIN_TILE(sb, blk)
            if (two) WIN_TILE(sb + 1, blk + 1)
        }
#undef WIN_TILE
#undef STT
#undef LDT
        const float lt = st.l + __shfl_xor(st.l, 32); const float sc = (lt > 0.f) ? gb_w / lt : 0.f;
#pragma unroll
        for (int r = 0; r < 16; ++r) { oacc[0][r] += sc * st.o[0][r]; oacc[1][r] += sc * st.o[1][r]; }
    }
    __syncthreads();
    {
        const bf16* zn = WSP(bf16, WS_ZN) + (size_t)token * 1024 + head * 64;
        bf16* on = WSP(bf16, WS_OCAT) + (size_t)token * 2048 + head * 64;
#pragma unroll
        for (int dt = 0; dt < 2; ++dt)
#pragma unroll
            for (int k4 = 0; k4 < 4; ++k4) { const int d = 32 * dt + 8 * k4 + 4 * h;
                const u32x2 z = *(const u32x2*)(zn + d);
                const f32x4 v = (f32x4){oacc[dt][4 * k4] * bflo(z.x), oacc[dt][4 * k4 + 1] * bfhi(z.x), oacc[dt][4 * k4 + 2] * bflo(z.y), oacc[dt][4 * k4 + 3] * bfhi(z.y)};
                *(u32x2*)(on + d) = pack4(v); }
    }
}

__device__ __forceinline__ void stage_half_f32(LAS bf16* dst, const float* base, int nvalid, int lane) {
    const int row = lane >> 1, hf = lane & 1;
    const float* s = base + (size_t)row * 512 + hf * 32;
#pragma unroll
    for (int i = 0; i < 4; ++i) {
        u32x4 o = (u32x4){0u, 0u, 0u, 0u};
        if (row < nvalid) { const f32x4 a = *(const f32x4*)(s + 8 * i), b2 = *(const f32x4*)(s + 8 * i + 4); o = pack8(a, b2); }
        *(LAS u32x4*)(dst + row * KTLD + hf * 32 + 8 * i) = o;
    }
}
__device__ __forceinline__ void stage_half_bf16(LAS bf16* dst, const bf16* base, int lane) {
    const int row = lane >> 1, hf = lane & 1;
#pragma unroll
    for (int i = 0; i < 4; ++i) *(LAS u32x4*)(dst + row * KTLD + hf * 32 + 8 * i) = *(const u32x4*)(base + (size_t)row * 64 + hf * 32 + 8 * i);
}
__device__ __forceinline__ void merge_partials(const LAS float* mlb, const LAS float* comb, int lane, f32x16 (&o)[2], float& L) {
    const int c = lane & 31;
    float M = -1e30f;
#pragma unroll
    for (int ww = 0; ww < 8; ++ww) M = fmaxf(M, mlb[(ww * 64 + lane) * 2]);
    L = 0.f;
#pragma unroll
    for (int r = 0; r < 16; ++r) { o[0][r] = 0.f; o[1][r] = 0.f; }
#pragma unroll 1
    for (int ww = 0; ww < 8; ++ww) {
        const float f = ex2(mlb[(ww * 64 + lane) * 2] - M);
        L += (mlb[(ww * 64 + c) * 2 + 1] + mlb[(ww * 64 + c + 32) * 2 + 1]) * f;
#pragma unroll
        for (int r = 0; r < 16; ++r) { o[0][r] += comb[(ww * 32 + r) * 64 + lane] * f; o[1][r] += comb[(ww * 32 + 16 + r) * 64 + lane] * f; }
    }
}
__device__ __forceinline__ void nsa_sample_unit(Frame& F, int b, int kvh) {
    const int tid = F.tid, lane = F.lane, w = F.wave, c = lane & 31, h = lane >> 5, qi = c & 7, g = c >> 3;
    LAS bf16* Kw = (LAS bf16*)(F.lds + w * 9216); LAS bf16* Vw = Kw + 32 * KTLD;
    LAS float* comb = (LAS float*)F.lds;
    LAS float* mlb = (LAS float*)(F.lds + 65536);
    LAS float* impA = (LAS float*)(F.lds + 73728);
    LAS float* impB = impA + 8 * IMPLD;
    LAS unsigned* selb = (LAS unsigned*)(impB + 8 * IMPLD);
    const int token = TP + 8 * b + qi, head = kvh * 4 + g;
    const bf16* QB = WSP(bf16, WS_QB);
    bf16x8 qf[4];
#pragma unroll
    for (int ks = 0; ks < 4; ++ks) qf[ks] = *(const bf16x8*)(QB + (size_t)token * 1024 + head * 64 + 16 * ks + 8 * h);
    const float* gbp = WSP(float, WS_GB) + (size_t)token * 48 + head * 3;
    const float gb_c = gbp[0], gb_s = gbp[1], gb_w = gbp[2];
    f32x16 oacc[2];
#pragma unroll
    for (int r = 0; r < 16; ++r) { oacc[0][r] = 0.f; oacc[1][r] = 0.f; }
    __syncthreads();
    {
        const bf16* KCk = WSP(bf16, WS_KC) + ((size_t)(b * 4 + kvh) * 512) * 64;
        const bf16* KCv = KCk + (size_t)CROWS * 64;
        float m = -1e30f, l = 0.f;
        for (int ti = w; ti < 16; ti += 8) {
            stage_half_bf16(Kw, KCk + (size_t)ti * 32 * 64, lane);
            int hi = 510 - 32 * ti; if (hi > 31) hi = 31;
            stats_tile<1>(m, l, Kw, qf, 0, hi, lane);
        }
        __syncthreads();
        mlb[(w * 64 + lane) * 2] = m; mlb[(w * 64 + lane) * 2 + 1] = l;
        __syncthreads();
        float M = -1e30f;
#pragma unroll
        for (int ww = 0; ww < 8; ++ww) M = fmaxf(M, mlb[(ww * 64 + lane) * 2]);
        float L = 0.f;
#pragma unroll
        for (int ww = 0; ww < 8; ++ww) L += (mlb[(ww * 64 + c) * 2 + 1] + mlb[(ww * 64 + c + 32) * 2 + 1]) * ex2(mlb[(ww * 64 + lane) * 2] - M);
        const float invL = (L > 0.f) ? 1.f / L : 0.f;
        __syncthreads();
        f32x16 o[2];
#pragma unroll
        for (int r = 0; r < 16; ++r) { o[0][r] = 0.f; o[1][r] = 0.f; }
        for (int ti = w; ti < 16; ti += 8) {
            stage_half_bf16(Kw, KCk + (size_t)ti * 32 * 64, lane); stage_half_bf16(Vw, KCv + (size_t)ti * 32 * 64, lane);
            int hi = 510 - 32 * ti; if (hi > 31) hi = 31;
            cmp2_tile<1>(o, Kw, Vw, qf, 0, hi, M, invL, impA, impB, qi, IMPLD, 8 * ti, lane);
        }
        __syncthreads();
#pragma unroll
        for (int r = 0; r < 16; ++r) { comb[(w * 32 + r) * 64 + lane] = o[0][r]; comb[(w * 32 + 16 + r) * 64 + lane] = o[1][r]; }
        __syncthreads();
        if (w == 0) {
#pragma unroll 1
            for (int ww = 0; ww < 8; ++ww)
#pragma unroll
                for (int r = 0; r < 16; ++r) { oacc[0][r] += gb_c * comb[(ww * 32 + r) * 64 + lane]; oacc[1][r] += gb_c * comb[(ww * 32 + 16 + r) * 64 + lane]; }
        }
    }
    __syncthreads();
    if (tid < 64) selb[tid] = 0u;
    {
        const int q = w;
#pragma unroll 1
        for (int i = 0; i < 2; ++i) { const int n = lane + 64 * i; if (n >= 1 && n <= 126) impA[q * IMPLD + n] += impB[q * IMPLD + n]; }
        __syncthreads();
#pragma unroll 1
        for (int i = 0; i < 2; ++i) {
            const int n = lane + 64 * i; bool sel = true;
            if (n >= 1 && n <= 126) {
                const float v = impA[q * IMPLD + n]; int rank = 0;
#pragma unroll 4
                for (int mm = 1; mm <= 126; ++mm) { const float vm = impA[q * IMPLD + mm]; rank += (vm > v || (vm == v && mm < n)) ? 1 : 0; }
                sel = rank < 13;
            }
            if (sel) atomicOr((unsigned*)&selb[q * 8 + (n >> 5)], 1u << (n & 31));
        }
        if (lane == 0) atomicOr((unsigned*)&selb[q * 8 + 4], 1u);
    }
    __syncthreads();
    {
        FlashSt st; flash_init(st);
        int cnt = 0;
        for (int blk = 0; blk <= 128; ++blk) {
            unsigned uw = 0u;
#pragma unroll
            for (int q = 0; q < 8; ++q) uw |= selb[q * 8 + (blk >> 5)];
            uw = __builtin_amdgcn_readfirstlane(uw);
            if (!((uw >> (blk & 31)) & 1u)) continue;
            const int nh = (blk == 128) ? 1 : 2;
            for (int hf = 0; hf < nh; ++hf) {
                if (((cnt++) & 7) != w) continue;
                const float* base; int nvalid;
                if (blk < 128) { const int page = F.ptab[b * NPAGE + (blk >> 1)]; base = F.c_sel + ((size_t)page * 128 + (blk & 1) * 64 + hf * 32) * 512 + kvh * 64; nvalid = 32; }
                else { base = F.out + O_SELS + (size_t)(b * 8) * 512 + kvh * 64; nvalid = 8; }
                stage_half_f32(Kw, base, nvalid, lane); stage_half_f32(Vw, base + 256, nvalid, lane);
                const bool sq = (selb[qi * 8 + (blk >> 5)] >> (blk & 31)) & 1u;
                const int lo = sq ? 0 : 1, hi = sq ? ((blk == 128) ? qi : 31) : 0;
                flash_tile<1>(st, Kw, Vw, qf, lo, hi, lane);
            }
        }
        __syncthreads();
        mlb[(w * 64 + lane) * 2] = st.m; mlb[(w * 64 + lane) * 2 + 1] = st.l;
#pragma unroll
        for (int r = 0; r < 16; ++r) { comb[(w * 32 + r) * 64 + lane] = st.o[0][r]; comb[(w * 32 + 16 + r) * 64 + lane] = st.o[1][r]; }
        __syncthreads();
        if (w == 0) { f32x16 o[2]; float L; merge_partials(mlb, comb, lane, o, L); const float sc = (L > 0.f) ? gb_s / L : 0.f;
#pragma unroll
            for (int r = 0; r < 16; ++r) { oacc[0][r] += sc * o[0][r]; oacc[1][r] += sc * o[1][r]; } }
    }
    __syncthreads();
    {
        FlashSt st; flash_init(st);
        for (int ti = w; ti < 17; ti += 8) {
            const float* base; int nvalid;
            if (ti < 16) { base = F.c_win + ((size_t)b * 512 + 32 * ti) * 512 + kvh * 64; nvalid = 32; }
            else { base = F.out + O_WINS + ((size_t)b * 512 + 504) * 512 + kvh * 64; nvalid = 8; }
            stage_half_f32(Kw, base, nvalid, lane); stage_half_f32(Vw, base + 256, nvalid, lane);
            const int lo = (ti == 0) ? 1 + qi : 0, hi = (ti == 16) ? qi : 31;
            flash_tile<1>(st, Kw, Vw, qf, lo, hi, lane);
        }
        __syncthreads();
        mlb[(w * 64 + lane) * 2] = st.m; mlb[(w * 64 + lane) * 2 + 1] = st.l;
#pragma unroll
        for (int r = 0; r < 16; ++r) { comb[(w * 32 + r) * 64 + lane] = st.o[0][r]; comb[(w * 32 + 16 + r) * 64 + lane] = st.o[1][r]; }
        __syncthreads();
        if (w == 0) { f32x16 o[2]; float L; merge_partials(mlb, comb, lane, o, L); const float sc = (L > 0.f) ? gb_w / L : 0.f;
#pragma unroll
            for (int r = 0; r < 16; ++r) { oacc[0][r] += sc * o[0][r]; oacc[1][r] += sc * o[1][r]; } }
    }
    if (w == 0) {
        const bf16* zn = WSP(bf16, WS_ZN) + (size_t)token * 1024 + head * 64;
        bf16* on = WSP(bf16, WS_OCAT) + (size_t)token * 2048 + head * 64;
#pragma unroll
        for (int dt = 0; dt < 2; ++dt)
#pragma unroll
            for (int k4 = 0; k4 < 4; ++k4) { const int d = 32 * dt + 8 * k4 + 4 * h;
                const u32x2 z = *(const u32x2*)(zn + d);
                const f32x4 v = (f32x4){oacc[dt][4 * k4] * bflo(z.x), oacc[dt][4 * k4 + 1] * bfhi(z.x), oacc[dt][4 * k4 + 2] * bflo(z.y), oacc[dt][4 * k4 + 3] * bfhi(z.y)};
                *(u32x2*)(on + d) = pack4(v); }
    }
    __syncthreads();
}


__device__ __forceinline__ float log_sigmoid(float z) { return (z < 0.f) ? z - log1pf(__expf(z)) : -log1pf(__expf(-z)); }
__device__ __forceinline__ void gla_cum(Frame& F, int ch, int hd, LAS float* cum, LAS float* qs, LAS float* agt) {
    const int tid = F.tid, k = tid & 127, tq = tid >> 7;
    const float* AG = WSP(float, WS_AG) + (size_t)(64 * ch) * 16;
    for (int i = tid; i < 64 * 16; i += 512) agt[i] = AG[i];
    float wv[16];
#pragma unroll
    for (int r = 0; r < 16; ++r) wv[r] = F.w_a2[r * 512 + hd * 128 + k];
    const float bias = F.b_a[hd * 128 + k];
    __syncthreads();
    float run = 0.f;
    for (int tt = 0; tt < 16; ++tt) {
        const int t = 16 * tq + tt; float z = bias;
#pragma unroll
        for (int r = 0; r < 16; ++r) z += agt[t * 16 + r] * wv[r];
        run += log_sigmoid(z) * (1.f / 16.f); cum[t * 128 + k] = run;
    }
    qs[tq * 128 + k] = run;
    __syncthreads();
    float off = 0.f;
    for (int j = 0; j < tq; ++j) off += qs[j * 128 + k];
    if (tq > 0) for (int tt = 0; tt < 16; ++tt) cum[(16 * tq + tt) * 128 + k] += off;
    __syncthreads();
}
__device__ __forceinline__ void gla_pass1_unit(Frame& F, int ch, int hd) {
    LAS float* cum = (LAS float*)F.lds; LAS float* qs = cum + 64 * 128; LAS float* agt = qs + 512;
    LAS bf16* KhT = (LAS bf16*)(F.lds + 40960);
    gla_cum(F, ch, hd, cum, qs, agt);
    const int tid = F.tid, k = tid & 127, tq = tid >> 7, lane = F.lane, c = lane & 31, h = lane >> 5, w = F.wave;
    const float cl = cum[63 * 128 + k];
    const bf16* KG = WSP(bf16, WS_KG) + (size_t)(64 * ch) * 512 + hd * 128 + k;
    unsigned pk[8];
#pragma unroll
    for (int j = 0; j < 8; ++j) { const int s = 16 * tq + 2 * j;
        const float v0 = bf2f(KG[(size_t)s * 512]) * __expf(cl - cum[s * 128 + k]), v1 = bf2f(KG[(size_t)(s + 1) * 512]) * __expf(cl - cum[(s + 1) * 128 + k]);
        pk[j] = pk2(v0, v1); }
    *(LAS u32x4*)(KhT + k * 72 + 16 * tq) = (u32x4){pk[0], pk[1], pk[2], pk[3]};
    *(LAS u32x4*)(KhT + k * 72 + 16 * tq + 8) = (u32x4){pk[4], pk[5], pk[6], pk[7]};
    if (tq == 0) WSP(float, WS_DC)[(ch * 4 + hd) * 128 + k] = __expf(cl);
    __syncthreads();
    const bf16* VGT = WSP(bf16, WS_VGT) + ((size_t)ch * 1024 + hd * 256 + 32 * w + c) * 64;
    bf16x8 af[4];
#pragma unroll
    for (int ss = 0; ss < 4; ++ss) af[ss] = *(const bf16x8*)(VGT + 16 * ss + 8 * h);
    float* LT = WSP(float, WS_LT) + ((size_t)(ch * 4 + hd) * 256 + 32 * w) * 128;
#pragma unroll
    for (int kt = 0; kt < 4; ++kt) {
        f32x16 acc;
#pragma unroll
        for (int r = 0; r < 16; ++r) acc[r] = 0.f;
#pragma unroll
        for (int ss = 0; ss < 4; ++ss) { const bf16x8 bv = *(const LAS bf16x8*)(KhT + (32 * kt + c) * 72 + 16 * ss + 8 * h); acc = __builtin_amdgcn_mfma_f32_32x32x16_bf16(af[ss], bv, acc, 0, 0, 0); }
#pragma unroll
        for (int r = 0; r < 16; ++r) LT[(size_t)((r & 3) + 8 * (r >> 2) + 4 * h) * 128 + 32 * kt + c] = acc[r];
    }
    __syncthreads();
}
__device__ __forceinline__ void gla_pass2(Frame& F) {
    const float* __restrict__ LT = WSP(float, WS_LT); const float* __restrict__ DC = WSP(float, WS_DC); bf16* __restrict__ ST = WSP(bf16, WS_ST);
    for (int e = blockIdx.x * 512 + F.tid; e < 4 * 256 * 128; e += F.G * 512) {
        const int k = e & 127, v = (e >> 7) & 255, hd = e >> 15;
        float S = 0.f;
#pragma unroll 8
        for (int cc = 0; cc < 128; ++cc) { const size_t idx = ((size_t)(cc * 4 + hd) * 256 + v) * 128 + k; ST[idx] = (bf16)f2bf(S); S = DC[(cc * 4 + hd) * 128 + k] * S + LT[idx]; }
        F.out[O_STP + ((size_t)hd * 128 + k) * 256 + v] = S;
    }
}
__device__ __forceinline__ void gla_pass3_unit(Frame& F, int ch, int hd) {
    LAS float* cum = (LAS float*)F.lds; LAS float* qs = cum + 64 * 128; LAS float* agt = qs + 512;
    LAS bf16* Qt = (LAS bf16*)(F.lds + 40960);
    LAS bf16* Kt2 = Qt + 64 * 136;
    LAS bf16* Att = Kt2 + 64 * 136;
    LAS float* red = (LAS float*)(F.lds + 84992);
    LAS float* rstdv = red + 512;
    gla_cum(F, ch, hd, cum, qs, agt);
    const int tid = F.tid, k = tid & 127, tq = tid >> 7, lane = F.lane, c = lane & 31, h = lane >> 5, w = F.wave;
    {
        const bf16* QG = WSP(bf16, WS_QG) + (size_t)(64 * ch) * 512 + hd * 128 + k;
        const bf16* KG = WSP(bf16, WS_KG) + (size_t)(64 * ch) * 512 + hd * 128 + k;
        for (int tt = 0; tt < 16; ++tt) { const int t = 16 * tq + tt; const float cu = cum[t * 128 + k];
            Qt[t * 136 + k] = (bf16)f2bf(bf2f(QG[(size_t)t * 512]) * __expf(cu)); Kt2[t * 136 + k] = (bf16)f2bf(bf2f(KG[(size_t)t * 512]) * __expf(-cu)); }
    }
    __syncthreads();
    if (w < 3) {
        const int tt = (w + 1) >> 1, st = w >> 1;
        f32x16 acc;
#pragma unroll
        for (int r = 0; r < 16; ++r) acc[r] = 0.f;
#pragma unroll
        for (int ks = 0; ks < 8; ++ks) { const bf16x8 a = *(const LAS bf16x8*)(Qt + (32 * tt + c) * 136 + 16 * ks + 8 * h), bv = *(const LAS bf16x8*)(Kt2 + (32 * st + c) * 136 + 16 * ks + 8 * h);
            acc = __builtin_amdgcn_mfma_f32_32x32x16_bf16(a, bv, acc, 0, 0, 0); }
#pragma unroll
        for (int r = 0; r < 16; ++r) { const int t = 32 * tt + (r & 3) + 8 * (r >> 2) + 4 * h, s = 32 * st + c; Att[t * 72 + s] = (s <= t) ? (bf16)f2bf(acc[r]) : (bf16)0; }
    } else if (w == 3) {
#pragma unroll
        for (int r = 0; r < 16; ++r) { const int t = (r & 3) + 8 * (r >> 2) + 4 * h; Att[t * 72 + 32 + c] = (bf16)0; }
    }
    __syncthreads();
    f32x16 acc[2];
    {
        const bf16* VGT = WSP(bf16, WS_VGT) + ((size_t)ch * 1024 + hd * 256 + 32 * w + c) * 64;
        const bf16* STp = WSP(bf16, WS_ST) + ((size_t)(ch * 4 + hd) * 256 + 32 * w + c) * 128;
        bf16x8 bv[4], bs[8];
#pragma unroll
        for (int ss = 0; ss < 4; ++ss) bv[ss] = *(const bf16x8*)(VGT + 16 * ss + 8 * h);
#pragma unroll
        for (int ks = 0; ks < 8; ++ks) bs[ks] = *(const bf16x8*)(STp + 16 * ks + 8 * h);
#pragma unroll
        for (int tt = 0; tt < 2; ++tt) {
#pragma unroll
            for (int r = 0; r < 16; ++r) acc[tt][r] = 0.f;
#pragma unroll
            for (int ss = 0; ss < 4; ++ss) { if (tt == 0 && ss >= 2) continue;
                const bf16x8 a = *(const LAS bf16x8*)(Att + (32 * tt + c) * 72 + 16 * ss + 8 * h); acc[tt] = __builtin_amdgcn_mfma_f32_32x32x16_bf16(a, bv[ss], acc[tt], 0, 0, 0); }
#pragma unroll
            for (int ks = 0; ks < 8; ++ks) { const bf16x8 a = *(const LAS bf16x8*)(Qt + (32 * tt + c) * 136 + 16 * ks + 8 * h); acc[tt] = __builtin_amdgcn_mfma_f32_32x32x16_bf16(a, bs[ks], acc[tt], 0, 0, 0); }
        }
    }
#pragma unroll
    for (int tt = 0; tt < 2; ++tt)
#pragma unroll
        for (int r = 0; r < 16; ++r) { float sq = acc[tt][r] * acc[tt][r];
            sq += __shfl_xor(sq, 1); sq += __shfl_xor(sq, 2); sq += __shfl_xor(sq, 4); sq += __shfl_xor(sq, 8); sq += __shfl_xor(sq, 16);
            if (c == 0) red[w * 64 + 32 * tt + (r & 3) + 8 * (r >> 2) + 4 * h] = sq; }
    __syncthreads();
    if (tid < 64) { float s = 0.f;
#pragma unroll
        for (int ww = 0; ww < 8; ++ww) s += red[ww * 64 + tid];
        rstdv[tid] = 1.f / sqrtf(s * (1.f / 256.f) + 1e-6f); }
    __syncthreads();
    {
        const int col = hd * 256 + 32 * w + c; const float gw = F.gnw[32 * w + c];
        const bf16* ZG = WSP(bf16, WS_ZG); bf16* OG = WSP(bf16, WS_OCAT) + 1024;
#pragma unroll
        for (int tt = 0; tt < 2; ++tt)
#pragma unroll
            for (int r = 0; r < 16; ++r) { const int t = 32 * tt + (r & 3) + 8 * (r >> 2) + 4 * h; const size_t row = (size_t)(64 * ch + t);
                OG[row * 2048 + col] = (bf16)f2bf(acc[tt][r] * rstdv[t] * gw * bf2f(ZG[row * 1024 + col])); }
    }
    __syncthreads();
}
__device__ __forceinline__ void gla_sample_unit(Frame& F, int b, int hd) {
    LAS float* cumS = (LAS float*)F.lds; LAS float* qtl = cumS + 1024; LAS float* khl = qtl + 1024; LAS float* ktl = khl + 1024;
    LAS float* att = ktl + 1024; LAS float* oih = att + 64; LAS float* red = oih + 2048;
    const int tid = F.tid, lane = F.lane, w = F.wave, row0 = TP + 8 * b;
    if (tid < 128) {
        const int k = tid; float wv[16];
#pragma unroll
        for (int r = 0; r < 16; ++r) wv[r] = F.w_a2[r * 512 + hd * 128 + k];
        const float bias = F.b_a[hd * 128 + k]; float run = 0.f;
        const float* AG = WSP(float, WS_AG) + (size_t)row0 * 16;
        for (int t = 0; t < 8; ++t) { float z = bias;
#pragma unroll
            for (int r = 0; r < 16; ++r) z += AG[t * 16 + r] * wv[r];
            run += log_sigmoid(z) * (1.f / 16.f); cumS[t * 128 + k] = run; }
    }
    __syncthreads();
    for (int i = tid; i < 1024; i += 512) { const int t = i >> 7, k = i & 127; const float cu = cumS[i], cl = cumS[7 * 128 + k];
        const float q = bf2f(WSP(bf16, WS_QG)[(size_t)(row0 + t) * 512 + hd * 128 + k]), kk = bf2f(WSP(bf16, WS_KG)[(size_t)(row0 + t) * 512 + hd * 128 + k]);
        qtl[i] = q * __expf(cu); khl[i] = kk * __expf(cl - cu); ktl[i] = kk * __expf(-cu); }
    __syncthreads();
    if (tid < 64) { const int t = tid >> 3, s = tid & 7; float a = 0.f;
        if (s <= t) for (int k = 0; k < 128; ++k) a += qtl[t * 128 + k] * ktl[s * 128 + k];
        att[tid] = a; }
    __syncthreads();
    const int v = tid & 255, kh = tid >> 8;
    float vv[8], oi[8];
#pragma unroll
    for (int s = 0; s < 8; ++s) { vv[s] = WSP(float, WS_VGS)[(size_t)(8 * b + s) * 1024 + hd * 256 + v]; oi[s] = 0.f; }
    const float* S0 = F.state + ((size_t)(b * 4 + hd) * 128) * 256; float* SN = F.out + O_STS + ((size_t)(b * 4 + hd) * 128) * 256;
#pragma unroll 4
    for (int kk = 0; kk < 64; ++kk) { const int k = kh * 64 + kk; const float s0 = S0[(size_t)k * 256 + v]; float sn = __expf(cumS[7 * 128 + k]) * s0;
#pragma unroll
        for (int s = 0; s < 8; ++s) { sn += khl[s * 128 + k] * vv[s]; oi[s] += qtl[s * 128 + k] * s0; }
        SN[(size_t)k * 256 + v] = sn; }
    if (kh == 1) {
#pragma unroll
        for (int t = 0; t < 8; ++t) oih[t * 256 + v] = oi[t]; }
    __syncthreads();
    if (kh == 0) {
#pragma unroll
        for (int t = 0; t < 8; ++t) { float o = oi[t] + oih[t * 256 + v];
#pragma unroll
            for (int s = 0; s < 8; ++s) if (s <= t) o += att[t * 8 + s] * vv[s];
            oi[t] = o; } }
#pragma unroll
    for (int t = 0; t < 8; ++t) { float sq = (kh == 0) ? oi[t] * oi[t] : 0.f; sq = wave_sum(sq); if (lane == 0) red[w * 8 + t] = sq; }
    __syncthreads();
    if (kh == 0) { const float gw = F.gnw[v];
#pragma unroll
        for (int t = 0; t < 8; ++t) { const float ssum = (red[t] + red[8 + t]) + (red[16 + t] + red[24 + t]); const float rstd = 1.f / sqrtf(ssum * (1.f / 256.f) + 1e-6f);
            const size_t row = (size_t)(row0 + t);
            WSP(bf16, WS_OCAT)[row * 2048 + 1024 + hd * 256 + v] = (bf16)f2bf(oi[t] * rstd * gw * bf2f(WSP(bf16, WS_ZG)[row * 1024 + hd * 256 + v])); } }
    __syncthreads();
}


#ifdef SELF_CHECK
__device__ __forceinline__ void self_check_kc(Frame& F) {
    const int lane = F.lane;
    unsigned* errw = (unsigned*)(F.ctl + CW_Q5 + 4096);
    for (int sidx = F.gw; sidx < 4096; sidx += F.NGW) {
        unsigned hsh = (unsigned)sidx * 2654435761u; hsh ^= hsh >> 15; hsh *= 2246822519u; hsh ^= hsh >> 13;
        const int x = hsh & 1, b = (hsh >> 1) % 33, hh = (hsh >> 8) & 3, cc = (hsh >> 10) % 511, d = (hsh >> 20) & 63;
        float part = 0.f;
        for (int ee = 0; ee < 2; ++ee) {
            const int e = lane + 64 * ee; float hid = F.cmp_b1[x * 128 + e];
            for (int l = 0; l < 32; ++l) {
                const int pos = 16 * cc + l;
                const float* row = (b < 32) ? F.c_cmp + ((size_t)F.ptab[b * NPAGE + (pos >> 7)] * 128 + (pos & 127)) * 512 + x * 256 + hh * 64
                                            : F.out + O_CMPP + (size_t)pos * 512 + x * 256 + hh * 64;
                for (int dd = 0; dd < 64; ++dd) hid += (row[dd] + F.cmp_pos[(x * 32 + l) * 64 + dd]) * F.cmp_w1[(((size_t)x * 32 + l) * 64 + dd) * 128 + e];
            }
            part += silu(hid) * F.cmp_w2[((size_t)x * 128 + e) * 64 + d];
        }
        part = wave_sum(part) + F.cmp_b2[x * 64 + d];
        const float got = bf2f(WSP(bf16, WS_KC)[(size_t)x * CROWS * 64 + ((size_t)(b * 4 + hh) * 512 + cc) * 64 + d]);
        if (lane == 0 && !(fabsf(got - part) <= 0.02f * fabsf(part) + 0.004f)) atomicAdd(errw, 1u);
    }
}
#endif
#ifndef MK_N_LAUNCHES
#define MK_N_LAUNCHES 1
#endif
constexpr int NPH = 9;
constexpr int N_LAUNCHES = MK_N_LAUNCHES;
struct Args { const void* in[25]; float* out; unsigned char* ws; int ph_lo, ph_hi, rpt, pad; };

__global__ void __launch_bounds__(NWAVES * 64, 2) nsa_gla_fwd(Args args) {
    extern __shared__ __attribute__((aligned(16))) unsigned char lds[];
    Frame F;
    F.lds = (LAS unsigned char*)lds;
    F.MISC = (volatile LAS unsigned*)(F.lds + LDSCTL_OFF);
    F.tid = threadIdx.x; F.lane = F.tid & 63; F.wave = __builtin_amdgcn_readfirstlane(F.tid >> 6);
    F.G = gridDim.x; F.gw = blockIdx.x * NWAVES + F.wave; F.NGW = F.G * NWAVES;
    F.ws = args.ws; F.out = args.out; F.ctl = (gu32*)(args.ws + WS_CTL);
#define LOAD_INPUTS() do { \
    F.x_p = (const float*)args.in[0]; F.x_s = (const float*)args.in[1]; F.c_cmp = (const float*)args.in[2]; F.c_sel = (const float*)args.in[3]; \
    F.c_win = (const float*)args.in[4]; F.state = (const float*)args.in[5]; F.ptab = (const int*)args.in[6]; F.c_p = (const float*)args.in[7]; \
    F.c_s = (const float*)args.in[8]; F.norm_w = (const float*)args.in[9]; F.w_ada = (const float*)args.in[10]; F.b_ada = (const float*)args.in[11]; \
    F.w_in = (const float*)args.in[12]; F.cmp_pos = (const float*)args.in[13]; F.cmp_w1 = (const float*)args.in[14]; F.cmp_b1 = (const float*)args.in[15]; \
    F.cmp_w2 = (const float*)args.in[16]; F.cmp_b2 = (const float*)args.in[17]; F.w_a2 = (const float*)args.in[18]; F.b_a = (const float*)args.in[19]; \
    F.gnw = (const float*)args.in[20]; F.w_on = (const float*)args.in[21]; F.w_og = (const float*)args.in[22]; F.w_out = (const float*)args.in[23]; \
    F.fnw = (const float*)args.in[24]; } while (0)
    LOAD_INPUTS();
    for (int u = F.tid; u < (LDS_BYTES - LDSCTL_OFF) / 4; u += NWAVES * 64) ((LAS unsigned*)(F.lds + LDSCTL_OFF))[u] = 0u;
    __syncthreads();
    const int lo = args.ph_lo, hi = args.ph_hi;
    const bool use_bar = (hi - lo) > 1;
    XcdBarrier bar; bar.bar = (unsigned*)(F.ctl + CW_BAR); bar.x = 0; bar.st = nullptr;
    if (use_bar) bar = xcd_barrier_post((unsigned*)(F.ctl + CW_BAR), F.MISC + 8);
#ifndef PH_MASK
#define PH_MASK 0x1ff
#endif
#define IN(k) (((PH_MASK >> (k)) & 1) && lo <= (k) && (k) < hi)
#define SEAM(k) do { if (IN(k) && IN((k) + 1)) xcd_barrier(bar); } while (0)
    LAS unsigned char* ring = F.lds;

#ifndef DBL_MASK
#define DBL_MASK 0
#endif
#ifndef P5_MASK
#define P5_MASK 7
#endif
#ifndef P5_DBL
#define P5_DBL 0
#endif
#define QUEUE_LOOP(word, N, BODY) for (;;) { if (F.tid == 0) F.MISC[0] = __hip_atomic_fetch_add((unsigned*)(F.ctl + (word)), 1u, RLX_AGENT); __syncthreads(); \
            const int idx = (int)F.MISC[0]; __syncthreads(); if (idx >= (N)) break; BODY; }
#define PHASE0(rep) { p0_prologue(F, (rep) | args.rpt); }
#define PHASE1(rep) { p1_modnorm(F); }
#define PHASE2(rep) { const int GG = (F.G == 256) ? 240 : F.G;     \
        if ((int)blockIdx.x < GG) { pg8::Gemm g{WSP(const bf16, WS_H), WSP(const bf16, WS_WIN), MROWS, NINP, DM}; pg8::StaticOrder S; S.init(MROWS, NINP, GG, (int)blockIdx.x); \
            EpiIn E{F.out, F.ws}; pg8::gemm_phase<EpiIn, pg8::StaticOrder, true, true>(ring, g, S, E); __syncthreads(); } \
        QUEUE_LOOP(CW_Q5 + 3072 + 64 * (rep), D_TOTAL, p2_deferred_item(F, idx)) }
#define PHASE3X(XX) { SEpiPlain SE{WSP(bf16, WS_PART) + (size_t)(XX) * CROWS * 256, 256}; \
          wave_gemm_tiles<SEpiPlain>(F, WSP(const bf16, WS_CB) + (size_t)(XX) * CB_X, 1024, WSP(const bf16, WS_W1T) + (size_t)(XX) * 256 * 1024, 1024, 65536, 64, 8, 1024, SE); }
#define PHASE3(rep) { PHASE3X(0) PHASE3X(1) \
        QUEUE_LOOP(CW_Q5 + 2048 + 512 * (rep), 128, gla_sample_unit(F, idx >> 2, idx & 3)) \
        QUEUE_LOOP(CW_Q5 + 2048 + 64 + 512 * (rep), 512, gla_pass1_unit(F, idx >> 2, idx & 3)) }
#define PHASE4(rep) { compress_l2(F); gla_pass2(F); }
#define PHASE5(rep) { \
        if (P5_MASK & 1) { QUEUE_LOOP(CW_Q5 + 512 * (rep), 128, nsa_sample_unit(F, idx >> 2, idx & 3)) if (P5_DBL & 1) { QUEUE_LOOP(CW_Q5 + 1024, 128, nsa_sample_unit(F, idx >> 2, idx & 3)) } } \
        if (P5_MASK & 2) { QUEUE_LOOP(CW_Q5 + 64 + 512 * (rep), 512, nsa_prompt_unit(F, 127 - (idx >> 2), idx & 3)) if (P5_DBL & 2) { QUEUE_LOOP(CW_Q5 + 1024 + 64, 512, nsa_prompt_unit(F, 127 - (idx >> 2), idx & 3)) } } \
        if (P5_MASK & 4) { QUEUE_LOOP(CW_Q5 + 128 + 512 * (rep), 512, gla_pass3_unit(F, idx >> 2, idx & 3)) if (P5_DBL & 4) { QUEUE_LOOP(CW_Q5 + 1024 + 128, 512, gla_pass3_unit(F, idx >> 2, idx & 3)) } } }
#define PHASE6(rep) { { SEpiMergeCat SE{WSP(const bf16, WS_MN), WSP(const bf16, WS_MG), WSP(bf16, WS_MERGED)}; wave_gemm_tiles<SEpiMergeCat>(F, WSP(const bf16, WS_OCAT), 2048, WSP(const bf16, WS_WCAT), 2048, TP, 8, 64, 2048, SE); } \
        pg8::Gemm g{WSP(const bf16, WS_OCAT), WSP(const bf16, WS_WCAT), TP, DM, 1024, 2048, 1024}; pg8::StaticOrderZ2 S; S.init(TP, DM, F.G, (int)blockIdx.x); \
        EpiMergeZ E{WSP(const bf16, WS_MN), WSP(const bf16, WS_MG), WSP(bf16, WS_MERGED)}; pg8::gemm_phase<EpiMergeZ, pg8::StaticOrderZ2, true, true>(ring, g, S, E); }
#define PHASE7(rep) { { SEpiOut SE{F.x_s, WSP(const long long, WS_MOD), F.out, WSP(float, WS_RSS)}; wave_gemm_tiles<SEpiOut>(F, WSP(const bf16, WS_MERGED), 2048, WSP(const bf16, WS_WOUT), 2048, TP, 8, 64, 2048, SE); } \
        pg8::Gemm g{WSP(const bf16, WS_MERGED), WSP(const bf16, WS_WOUT), TP, DM, DM}; pg8::StaticOrder S; S.init(TP, DM, F.G, (int)blockIdx.x); \
        EpiOut E{F.x_p, F.x_s, WSP(const long long, WS_MOD), F.out, WSP(float, WS_RSS)}; pg8::gemm_phase<EpiOut, pg8::StaticOrder, true, true>(ring, g, S, E); }
#define PHASE8(rep) { final_norm(F); }
#define RUN(k) do { if (IN(k)) { LOAD_INPUTS(); PHASE##k(0) if ((DBL_MASK >> (k)) & 1) { if (use_bar) xcd_barrier(bar); PHASE##k(1) } } SEAM(k); } while (0)
    RUN(0); RUN(1); RUN(2); RUN(3); RUN(4); RUN(5); RUN(6); RUN(7);
    if (IN(8)) { LOAD_INPUTS(); PHASE8(0) }
#ifdef SELF_CHECK
    if (use_bar) { self_check_kc(F); xcd_barrier(bar); if (blockIdx.x == 0 && F.tid == 0 && __hip_atomic_load((unsigned*)(F.ctl + CW_Q5 + 4096), RLX_AGENT) != 0u) F.out[O_YS] = __builtin_nanf(""); }
#endif
#undef IN
#undef SEAM
}

extern "C" void kernel_launch(void* const* d_in, const int* in_sizes, int n_in, void* d_out, int out_size, void* d_ws, size_t ws_size, hipStream_t stream) {
    static int grid = 0;
    if (grid == 0) {
        if (n_in != 25 || (size_t)out_size != O_TOTAL || ws_size < WS_END) {
            fprintf(stderr, "kernel_launch: built for 25 inputs, %zu outputs, >= %zu bytes of workspace; got n_in %d, out %d, ws %zu; nothing launched\n", (size_t)O_TOTAL, (size_t)WS_END, n_in, out_size, ws_size); grid = -1; return; }
        int dev = 0, cus = 0, per_cu = 0;
        if (hipGetDevice(&dev) != hipSuccess || hipDeviceGetAttribute(&cus, hipDeviceAttributeMultiprocessorCount, dev) != hipSuccess) { fprintf(stderr, "kernel_launch: device query failed\n"); grid = -1; return; }
        if (hipFuncSetAttribute((const void*)nsa_gla_fwd, hipFuncAttributeMaxDynamicSharedMemorySize, LDS_BYTES) != hipSuccess) { fprintf(stderr, "kernel_launch: hipFuncSetAttribute failed\n"); grid = -1; return; }
        if (hipOccupancyMaxActiveBlocksPerMultiprocessor(&per_cu, (const void*)nsa_gla_fwd, NWAVES * 64, LDS_BYTES) != hipSuccess || per_cu < 1)
            fprintf(stderr, "kernel_launch: note: occupancy query reports %d workgroups per CU\n", per_cu);
        (void)hipGetLastError();
        grid = cus;
    }
    if (grid < 0) return;
    if (hipMemsetAsync((char*)d_ws + WS_CTL, 0, CTL_ZERO_BYTES, stream) != hipSuccess || hipMemsetAsync((char*)d_ws + WS_MOD, 0, MOD_BYTES, stream) != hipSuccess) { fprintf(stderr, "kernel_launch: memset failed\n"); return; }
    Args a{};
    for (int i = 0; i < 25; ++i) a.in[i] = d_in[i];
    a.out = (float*)d_out; a.ws = (unsigned char*)d_ws;
#ifndef DBL_LAUNCH
#define DBL_LAUNCH 0
#endif
    int seq[2 * NPH + 4], rp[2 * NPH + 4], ns = 0;
    if (N_LAUNCHES == 1) { seq[ns] = -1; rp[ns++] = 0; }
    else for (int k = 0; k < NPH; ++k) {
        seq[ns] = k; rp[ns++] = 0;
        if ((DBL_LAUNCH >> k) & 1) { if (k == 8) { seq[ns] = k - 1; rp[ns++] = 1; } seq[ns] = k; rp[ns++] = 1; }
    }
    for (int li = 0; li < ns; ++li) {
        if (seq[li] < 0) { a.ph_lo = 0; a.ph_hi = NPH; } else { a.ph_lo = seq[li]; a.ph_hi = seq[li] + 1; }
        a.rpt = rp[li]; a.pad = 0;
        hipLaunchKernelGGL(nsa_gla_fwd, dim3(grid), dim3(NWAVES * 64), LDS_BYTES, stream, a);
        const hipError_t le = hipPeekAtLastError();
        if (le != hipSuccess) { fprintf(stderr, "kernel_launch: launch %d failed: %s\n", li, hipGetErrorName(le)); break; }
    }
}
```

```cpp
#include <hip/hip_runtime.h>
#include <cstdio>
#include <cstdint>
#define MK_N_LAUNCHES 1
namespace pg8 {
#define PG8_LAS __attribute__((address_space(3)))
typedef unsigned short bf16_t;
typedef short bf16x8 __attribute__((ext_vector_type(8)));
typedef float f32x4 __attribute__((ext_vector_type(4)));
typedef unsigned u32x4 __attribute__((ext_vector_type(4)));
constexpr int BM = 256, BK = 64, HALF = 128, HTB = HALF * BK * 2  , STAGE_BYTES = 8 * HTB, NXCD = 8, WGM = 8;

__host__ __device__ __forceinline__ int lds_byte(int r, int c) { const int st = (r >> 4) * 2 + (c >> 5), rr = r & 15, cc = c & 31, ob = rr * 64 + cc * 2; return st * 1024 + (ob ^ (((ob >> 9) & 1) << 5)); }
__host__ __device__ __forceinline__ void stage_rc(int b, int& R, int& C) { const int st = b / 1024, sb = b % 1024, swz = sb ^ (((sb >> 9) & 1) << 5); R = (st >> 1) * 16 + swz / 64; C = (st & 1) * 32 + (swz % 64) / 2; }
__host__ __device__ __forceinline__ int perm32(int rho) { const int n = rho >> 4, i = rho & 15; return 8 * (i >> 2) + 4 * n + (i & 3); }

struct Unit { int pm, pn, z; };
struct Gemm { const bf16_t* A; const bf16_t* Bt; int M, N, K, ld, zoff; };

struct StaticOrder {
    int nM, nN, nwg, G, c;
    __host__ __device__ void init(int M, int N, int G_, int c_) { nM = M / BM; nN = N / BM; nwg = nM * nN; G = G_; c = c_; }
    __host__ __device__ bool next(int i, Unit& u) const {
        const long L = (long)i * G + c; if (L >= nwg) return false;
        int wgid = (int)L; { const int q = nwg / NXCD, r = nwg % NXCD, xcd = wgid % NXCD, off = wgid / NXCD; wgid = (xcd < r ? xcd * (q + 1) : r * (q + 1) + (xcd - r) * q) + off; }
        const int nig = WGM * nN, gid = wgid / nig, fm = gid * WGM, gsz = (nM - fm) < WGM ? (nM - fm) : WGM;
        u.pm = fm + ((wgid % nig) % gsz); u.pn = (wgid % nig) / gsz; u.z = 0; return true;
    }
    __device__ __forceinline__ void a_ready(const Unit&) const {}
    __device__ __forceinline__ void done(const Unit&) const {}
};

struct StaticOrderZ2 {
    StaticOrder so;
    __host__ __device__ void init(int M, int N, int G_, int c_) { so.init(M, N, G_, c_); }
    __host__ __device__ bool next(int i, Unit& u) const { if (!so.next(i >> 1, u)) return false; u.z = i & 1; return true; }
    __device__ __forceinline__ void a_ready(const Unit&) const {}
    __device__ __forceinline__ void done(const Unit&) const {}
};

__device__ __forceinline__ unsigned cvt_pk_bf16(float lo, float hi) { unsigned r; asm volatile("v_cvt_pk_bf16_f32 %0, %1, %2" : "=v"(r) : "v"(lo), "v"(hi)); return r; }
typedef float f32x2 __attribute__((ext_vector_type(2)));

template <class Epi, class Sched, bool ALIGN_EPI = false, bool SP2 = false>
__device__ __forceinline__ void gemm_phase(PG8_LAS unsigned char* lds, const Gemm g, const Sched& S, const Epi& E) {
    const int tid = threadIdx.x, wid = __builtin_amdgcn_readfirstlane(tid >> 6), lane = tid & 63, wr = wid >> 2, wc = wid & 3, fr = lane & 15, fq = lane >> 4;
    const int K = g.K, nt = K / BK, LD = g.ld ? g.ld : K;
    unsigned voffA[2], voffB[2];
#pragma unroll
    for (int i = 0; i < 2; ++i) { int R, C; stage_rc(tid * 16 + i * 8192, R, C); const int Rb = Epi::PERM ? ((R & ~31) + perm32(R & 31)) : R;
        voffA[i] = (unsigned)(R * LD + C) * 2u; voffB[i] = (unsigned)(Rb * LD + C) * 2u; }
    const size_t kstep = (size_t)(BK * 2);
    const size_t hstep = (size_t)HALF * LD * 2;
    const size_t tstep = 2 * hstep;
    const unsigned ldsw = (unsigned)wid * 1024u;
    const int aoff = lds_byte(wr * 64 + fr, fq * 8), boff = lds_byte(wc * 32 + fr, fq * 8);
#define PG8_SA(b, h) (((b) * 2 + (h)) * HTB)
#define PG8_SB(b, h) ((4 + (b) * 2 + (h)) * HTB)
#define PG8_STAGE(bufoff, gbase, voff) do { _Pragma("unroll") for (int _i = 0; _i < 2; ++_i) \
        __builtin_amdgcn_global_load_lds((const unsigned*)((const char*)(gbase) + (voff)[_i]), (PG8_LAS unsigned*)(lds + (bufoff) + ldsw + _i * 8192), 16, 0, 0); } while (0)
#define PG8_LDA(dst, b, h) do { _Pragma("unroll") for (int m = 0; m < 4; ++m) _Pragma("unroll") for (int k = 0; k < 2; ++k) dst[m][k] = *(const PG8_LAS bf16x8*)(lds + PG8_SA(b, h) + aoff + m * 2048 + k * 1024); } while (0)
#define PG8_LDB(dst, b, h) do { _Pragma("unroll") for (int n = 0; n < 2; ++n) _Pragma("unroll") for (int k = 0; k < 2; ++k) dst[n][k] = *(const PG8_LAS bf16x8*)(lds + PG8_SB(b, h) + boff + n * 2048 + k * 1024); } while (0)
#define PG8_MMA(ai, bj, At, Bt) do { __builtin_amdgcn_s_setprio(1); _Pragma("unroll") for (int m = 0; m < 4; ++m) _Pragma("unroll") for (int n = 0; n < 2; ++n) _Pragma("unroll") for (int k = 0; k < 2; ++k) \
        acc[ai][bj][m][n] = __builtin_amdgcn_mfma_f32_16x16x32_bf16(Bt[n][k], At[m][k], acc[ai][bj][m][n], 0, 0, 0); __builtin_amdgcn_s_setprio(0); } while (0)
#define PG8_WAIT_V(n) asm volatile("s_waitcnt vmcnt(" #n ")" ::: "memory")
#define PG8_WAIT_L(n) asm volatile("s_waitcnt lgkmcnt(" #n ")" ::: "memory")
#define PG8_BAR __builtin_amdgcn_s_barrier()
#define PG8_SCHED __builtin_amdgcn_sched_barrier(0)
    Unit cur, nxt; int ui = 0;
    if (!S.next(0, cur)) return;
    f32x4 acc[2][2][4][2];
#pragma unroll
    for (int a = 0; a < 2; ++a)
#pragma unroll
        for (int b = 0; b < 2; ++b)
#pragma unroll
            for (int m = 0; m < 4; ++m)
#pragma unroll
                for (int n = 0; n < 2; ++n) acc[a][b][m][n] = (f32x4){0.f, 0.f, 0.f, 0.f};
    bf16x8 At[4][2], B0[2][2], B1[2][2];
    const char* cA = (const char*)g.A + (size_t)cur.pm * tstep + (size_t)cur.z * g.zoff * 2; const char* cB = (const char*)g.Bt + (size_t)cur.pn * tstep + (size_t)cur.z * g.zoff * 2;
    S.a_ready(cur);
    if constexpr (SP2) {
        PG8_STAGE(PG8_SB(0, 0), cB, voffB); PG8_STAGE(PG8_SB(0, 1), cB + hstep, voffB); PG8_STAGE(PG8_SA(0, 0), cA, voffA); PG8_STAGE(PG8_SA(0, 1), cA + hstep, voffA);
        if (wr == 1) PG8_BAR;
        PG8_WAIT_V(2); PG8_BAR;
        PG8_STAGE(PG8_SB(1, 0), cB + kstep, voffB); PG8_STAGE(PG8_SA(1, 0), cA + kstep, voffA); PG8_STAGE(PG8_SB(1, 1), cB + hstep + kstep, voffB);
        PG8_WAIT_V(6); PG8_BAR;
    } else {
        PG8_STAGE(PG8_SB(0, 0), cB, voffB); PG8_STAGE(PG8_SA(0, 0), cA, voffA); PG8_STAGE(PG8_SB(0, 1), cB + hstep, voffB); PG8_STAGE(PG8_SA(0, 1), cA + hstep, voffA);
        if (wr == 1) PG8_BAR;
        PG8_WAIT_V(4); PG8_BAR;
        PG8_STAGE(PG8_SB(1, 0), cB + kstep, voffB); PG8_STAGE(PG8_SA(1, 0), cA + kstep, voffA); PG8_STAGE(PG8_SB(1, 1), cB + hstep + kstep, voffB);
        PG8_WAIT_V(6); PG8_BAR;
    }
    for (;;) {
        const bool has_next = S.next(ui + 1, nxt);
        const char* nA = has_next ? (const char*)g.A + (size_t)nxt.pm * tstep + (size_t)nxt.z * g.zoff * 2 : cA; const char* nB = has_next ? (const char*)g.Bt + (size_t)nxt.pn * tstep + (size_t)nxt.z * g.zoff * 2 : cB;
        for (int t = 0; t < nt; t += 2) {
            const bool last = (t == nt - 2);
            const char* a1 = cA + (size_t)(t + 1) * kstep;
            const char* a2 = last ? nA : cA + (size_t)(t + 2) * kstep; const char* b2 = last ? nB : cB + (size_t)(t + 2) * kstep;
            const char* a3 = a2 + kstep; const char* b3 = b2 + kstep;
            if (last && has_next) S.a_ready(nxt);
            if constexpr (SP2) {
            PG8_LDB(B0, 0, 0); PG8_LDB(B1, 0, 1); PG8_SCHED; PG8_LDA(At, 0, 0); PG8_STAGE(PG8_SA(1, 1), a1 + hstep, voffA);
            PG8_WAIT_V(8); PG8_WAIT_L(0); PG8_BAR; PG8_MMA(0, 0, At, B0); PG8_MMA(0, 1, At, B1); PG8_BAR; PG8_SCHED;
            PG8_LDA(At, 0, 1); PG8_STAGE(PG8_SB(0, 0), b2, voffB); PG8_STAGE(PG8_SB(0, 1), b2 + hstep, voffB); PG8_STAGE(PG8_SA(0, 0), a2, voffA);
            PG8_WAIT_V(8); PG8_WAIT_L(0); PG8_BAR; PG8_MMA(1, 0, At, B0); PG8_MMA(1, 1, At, B1); PG8_BAR; PG8_SCHED;
            PG8_LDB(B0, 1, 0); PG8_LDB(B1, 1, 1); PG8_SCHED; PG8_LDA(At, 1, 0); PG8_STAGE(PG8_SA(0, 1), a2 + hstep, voffA);
            PG8_WAIT_V(8); PG8_WAIT_L(0); PG8_BAR; PG8_MMA(0, 0, At, B0); PG8_MMA(0, 1, At, B1); PG8_BAR; PG8_SCHED;
            PG8_LDA(At, 1, 1); PG8_STAGE(PG8_SB(1, 0), b3, voffB); PG8_STAGE(PG8_SB(1, 1), b3 + hstep, voffB); PG8_STAGE(PG8_SA(1, 0), a3, voffA);
            PG8_WAIT_V(8); PG8_WAIT_L(0); PG8_BAR; PG8_MMA(1, 0, At, B0); PG8_MMA(1, 1, At, B1); PG8_BAR; PG8_SCHED;
            } else {
            PG8_LDB(B0, 0, 0); PG8_SCHED; PG8_LDA(At, 0, 0); PG8_STAGE(PG8_SA(1, 1), a1 + hstep, voffA);
            PG8_WAIT_L(8); PG8_BAR; PG8_WAIT_L(0); PG8_MMA(0, 0, At, B0); PG8_BAR; PG8_SCHED;
            PG8_LDB(B1, 0, 1); PG8_STAGE(PG8_SB(0, 0), b2, voffB);
            PG8_BAR; PG8_WAIT_L(0); PG8_MMA(0, 1, At, B1); PG8_BAR;
            PG8_LDA(At, 0, 1); PG8_STAGE(PG8_SA(0, 0), a2, voffA);
            PG8_BAR; PG8_WAIT_L(0); PG8_MMA(1, 0, At, B0); PG8_BAR; PG8_SCHED;
            PG8_STAGE(PG8_SB(0, 1), b2 + hstep, voffB);
            PG8_WAIT_V(6); PG8_BAR; PG8_MMA(1, 1, At, B1); PG8_BAR;
            PG8_LDB(B0, 1, 0); PG8_SCHED; PG8_LDA(At, 1, 0); PG8_STAGE(PG8_SA(0, 1), a2 + hstep, voffA);
            PG8_WAIT_L(8); PG8_BAR; PG8_WAIT_L(0); PG8_MMA(0, 0, At, B0); PG8_BAR; PG8_SCHED;
            PG8_LDB(B1, 1, 1); PG8_STAGE(PG8_SB(1, 0), b3, voffB);
            PG8_BAR; PG8_WAIT_L(0); PG8_MMA(0, 1, At, B1); PG8_BAR;
            PG8_LDA(At, 1, 1); PG8_STAGE(PG8_SA(1, 0), a3, voffA);
            PG8_BAR; PG8_WAIT_L(0); PG8_MMA(1, 0, At, B0); PG8_BAR; PG8_SCHED;
            PG8_STAGE(PG8_SB(1, 1), b3 + hstep, voffB);
            PG8_WAIT_V(6); PG8_BAR; PG8_MMA(1, 1, At, B1); PG8_BAR;
            }
        }
        if constexpr (ALIGN_EPI) { if (wr == 0) PG8_BAR; }
        if constexpr (!Epi::AFTER_DRAIN) { E(acc, cur, wr, wc, fr, fq); S.done(cur); }
        if (!has_next) break;
#pragma unroll
        for (int a = 0; a < 2; ++a)
#pragma unroll
            for (int b = 0; b < 2; ++b)
#pragma unroll
                for (int m = 0; m < 4; ++m)
#pragma unroll
                    for (int n = 0; n < 2; ++n) acc[a][b][m][n] = (f32x4){0.f, 0.f, 0.f, 0.f};
        cur = nxt; cA = nA; cB = nB; ++ui;
        if constexpr (ALIGN_EPI) { if (wr == 1) PG8_BAR; }
    }
    PG8_WAIT_V(0);
    if constexpr (!ALIGN_EPI) { if (wr == 0) PG8_BAR; }
    PG8_BAR;
    if constexpr (Epi::AFTER_DRAIN) { E.fused(acc, cur, wr, wc, fr, fq, lds, wid, lane); S.done(cur); }
#undef PG8_SA
#undef PG8_SB
#undef PG8_STAGE
#undef PG8_LDA
#undef PG8_LDB
#undef PG8_MMA
#undef PG8_WAIT_V
#undef PG8_WAIT_L
#undef PG8_BAR
#undef PG8_SCHED
}
}

constexpr int NWAVES = 8;
constexpr int DM = 2048, TP = 8192, TS = 256, MROWS = TP + TS, NINP = 11008, NMOD = 6144;
constexpr int NBATCH_S = 32, TSEQ_S = 8, NPAGE = 64;
constexpr float QSCALE = 0.125f * 1.4426950408889634f;
constexpr float GQSCALE = 0.08838834764831845f;
constexpr size_t O_YP = 0, O_YS = 16777216, O_CMPP = 17301504, O_CMPS = 21495808, O_SELP = 21626880, O_SELS = 25821184,
                 O_WINP = 25952256, O_WINS = 26214400, O_STP = 34603008, O_STS = 34734080, O_TOTAL = 38928384;
constexpr size_t MiB = 1u << 20;
constexpr size_t WS_CTL = 0, CTL_ZERO_BYTES = 1 * MiB;
constexpr size_t WS_MOD = 786 * MiB;
constexpr size_t MOD_BYTES = (size_t)33 * 6144 * 8;
constexpr float MOD_SCALE = 4294967296.f, MOD_INV = 1.f / 4294967296.f;
constexpr size_t WS_ROPE = 2 * MiB;
constexpr size_t WS_POSB = 5 * MiB;
constexpr size_t WS_W1T = 6 * MiB;
constexpr size_t WS_WIN = 7 * MiB;
constexpr size_t WS_WCAT = 50 * MiB, WS_WOUT = 58 * MiB;
constexpr size_t WS_H = 66 * MiB;
constexpr size_t WS_QB = 99 * MiB;
constexpr size_t WS_KVB = 116 * MiB;
constexpr size_t WS_CB = 132 * MiB;
constexpr size_t CB_X = (size_t)33 * 4 * 8192 * 64;
constexpr size_t WS_PART = 397 * MiB;
constexpr int CROWS = 33 * 4 * 512;
constexpr size_t WS_KC = 464 * MiB;
constexpr size_t WS_ZN = 481 * MiB, WS_ZG = 498 * MiB;
constexpr size_t WS_MN = 515 * MiB, WS_MG = 548 * MiB;
constexpr size_t WS_QG = 581 * MiB, WS_KG = 590 * MiB;
constexpr size_t WS_VGT = 599 * MiB;
constexpr size_t WS_VGS = 615 * MiB;
constexpr size_t WS_AG = 616 * MiB;
constexpr size_t WS_GB = 617 * MiB;
constexpr size_t WS_LT = 619 * MiB;
constexpr size_t WS_DC = 683 * MiB;
constexpr size_t WS_ST = 684 * MiB;
constexpr size_t WS_OCAT = 716 * MiB;
constexpr size_t WS_MERGED = 750 * MiB;
constexpr size_t WS_RSS = 783 * MiB;
constexpr size_t WS_END = 788 * MiB;
constexpr int CW_BAR = 4096;
constexpr int CW_Q5 = 8192;
constexpr int RING_BYTES = 131072;
constexpr int LDSCTL_OFF = RING_BYTES;
constexpr int LDS_BYTES = 147456;

constexpr int KTLD = 72;
#define GAS __attribute__((address_space(1)))
#define LAS __attribute__((address_space(3)))
typedef unsigned short bf16;
typedef short bf16x8 __attribute__((ext_vector_type(8)));
typedef short s16x4 __attribute__((ext_vector_type(4)));
typedef float f32x4 __attribute__((ext_vector_type(4)));
typedef float f32x2 __attribute__((ext_vector_type(2)));
typedef float f32x16 __attribute__((ext_vector_type(16)));
typedef unsigned u32x4 __attribute__((ext_vector_type(4)));
typedef unsigned u32x2 __attribute__((ext_vector_type(2)));
typedef GAS unsigned gu32;
#define RLX_AGENT __ATOMIC_RELAXED, __HIP_MEMORY_SCOPE_AGENT
#define LDS_WAIT() asm volatile("s_waitcnt lgkmcnt(0)" ::: "memory")

__device__ __forceinline__ unsigned f2bf(float f) { unsigned u = __builtin_bit_cast(unsigned, f); return (u + 0x7fffu + ((u >> 16) & 1u)) >> 16; }
__device__ __forceinline__ unsigned pk2(float lo, float hi) { return f2bf(lo) | (f2bf(hi) << 16); }
__device__ __forceinline__ u32x4 pack8(const f32x4 a, const f32x4 b) { u32x4 o; o.x = pk2(a.x, a.y); o.y = pk2(a.z, a.w); o.z = pk2(b.x, b.y); o.w = pk2(b.z, b.w); return o; }
__device__ __forceinline__ u32x2 pack4(const f32x4 a) { u32x2 o; o.x = pk2(a.x, a.y); o.y = pk2(a.z, a.w); return o; }
__device__ __forceinline__ float bf2f(unsigned b) { return __builtin_bit_cast(float, b << 16); }
__device__ __forceinline__ float bflo(unsigned w) { return __builtin_bit_cast(float, w << 16); }
__device__ __forceinline__ float bfhi(unsigned w) { return __builtin_bit_cast(float, w & 0xffff0000u); }
__device__ __forceinline__ float sigm(float x) { return 1.f / (1.f + __expf(-x)); }
__device__ __forceinline__ float silu(float x) { return x / (1.f + __expf(-x)); }
__device__ __forceinline__ float ex2(float x) { return __builtin_amdgcn_exp2f(x); }
__device__ __forceinline__ float wave_sum(float v) {
#pragma unroll
    for (int o = 1; o < 64; o <<= 1) v += __shfl_xor(v, o);
    return v;
}
#define XB_TMO      128
#define XB_XCNT(j)  (256  + 64 * (j))
#define XB_XSUB(j)  (1280 + 64 * (j))
#define XB_XGEN(j)  (2304 + 64 * (j))
#define XB_TOP      3328
#define XB_TOPGEN   3392
#define XCD_BAR_WORDS 3456
#define XB_SPIN_CAP (1u << 18)

__device__ __forceinline__ unsigned xb_ld(unsigned* p)              { return __hip_atomic_load(p, __ATOMIC_RELAXED, __HIP_MEMORY_SCOPE_AGENT); }
__device__ __forceinline__ unsigned xb_add(unsigned* p, unsigned v) { return __hip_atomic_fetch_add(p, v, __ATOMIC_RELAXED, __HIP_MEMORY_SCOPE_AGENT); }
__device__ __forceinline__ unsigned xb_xcc_id() { return (unsigned)__builtin_amdgcn_s_getreg((3 << 11) | 20) & 0xFu; }
#define XB_SPIN(cond, bar) do { unsigned _sp = 0; while (cond) { __builtin_amdgcn_s_sleep(1); \
    if ((++_sp & 255u) == 0u) { if (xb_ld(&(bar)[XB_TMO])) break; if (_sp > XB_SPIN_CAP) { atomicAdd(&(bar)[XB_TMO], 1u); break; } } } } while (0)

struct XcdBarrier {
    unsigned* bar; unsigned x;
    volatile LAS unsigned* st;
};

__device__ __forceinline__ XcdBarrier xcd_barrier_post(unsigned* bar, volatile LAS unsigned* st) {
    XcdBarrier b; b.bar = bar; b.x = xb_xcc_id(); b.st = st;
    if (threadIdx.x == 0) (void)xb_add(&bar[XB_XCNT(b.x)], 1u);
    return b;
}
__device__ __forceinline__ void xcd_barrier_complete(unsigned* bar, unsigned x, unsigned& nloc, unsigned& nx) {
    const unsigned G = gridDim.x * gridDim.y * gridDim.z;
    unsigned sum, cnt, mine, sp = 0u;
    for (;;) {
        sum = 0u; cnt = 0u; mine = 0u;
#pragma unroll
        for (unsigned j = 0; j < 16; ++j) { const unsigned c = xb_ld(&bar[XB_XCNT(j)]); sum += c; cnt += (c > 0u) ? 1u : 0u; mine = (j == x) ? c : mine; }
        if (sum == G) break;
        __builtin_amdgcn_s_sleep(1);
        if ((++sp & 255u) == 0u) { if (xb_ld(&bar[XB_TMO])) break; if (sp > XB_SPIN_CAP) { atomicAdd(&bar[XB_TMO], 1u); break; } }
    }
    nloc = mine > 0u ? mine : 1u; nx = cnt > 0u ? cnt : 1u;
}

__device__ __forceinline__ void xcd_barrier(const XcdBarrier& b) {
    asm volatile("s_waitcnt vmcnt(0)" ::: "memory");
    __syncthreads();
    if (threadIdx.x == 0) {
        unsigned* bar = b.bar;
        __builtin_amdgcn_s_waitcnt(0);
        unsigned nloc = b.st[0], nx = b.st[1];
        if (nloc == 0u) { xcd_barrier_complete(bar, b.x, nloc, nx); b.st[0] = nloc; b.st[1] = nx; }
        const unsigned old = xb_add(&bar[XB_XSUB(b.x)], 1u);
        const unsigned gen = old / nloc;
        if (old + 1u == (gen + 1u) * nloc) {
            __builtin_amdgcn_fence(__ATOMIC_RELEASE, "agent");
            asm volatile("s_waitcnt vmcnt(0)" ::: "memory");
            const unsigned og = xb_add(&bar[XB_TOP], 1u);
            const unsigned tg = og / nx;
            if (og + 1u == (tg + 1u) * nx) xb_add(&bar[XB_TOPGEN], 1u);
            else XB_SPIN(xb_ld(&bar[XB_TOPGEN]) == tg, bar);
            __builtin_amdgcn_fence(__ATOMIC_ACQUIRE, "agent");
            xb_add(&bar[XB_XGEN(b.x)], 1u);
            asm volatile("s_waitcnt vmcnt(0)" ::: "memory");
        } else {
            XB_SPIN(xb_ld(&bar[XB_XGEN(b.x)]) == gen, bar);
            __builtin_amdgcn_fence(__ATOMIC_ACQUIRE, "agent");
            asm volatile("s_waitcnt vmcnt(0)" ::: "memory");
        }
    }
    __syncthreads();
}

struct Frame {
    LAS unsigned char* lds;
    volatile LAS unsigned* MISC;
    gu32* ctl;
    int tid, lane, wave, G, gw, NGW;
    const float *x_p, *x_s, *c_cmp, *c_sel, *c_win, *state, *c_p, *c_s, *norm_w, *w_ada, *b_ada, *w_in, *cmp_pos, *cmp_w1, *cmp_b1, *cmp_w2, *cmp_b2,
                *w_a2, *b_a, *gnw, *w_on, *w_og, *w_out, *fnw;
    const int* ptab;
    float* out;
    unsigned char* ws;
};
#define WSP(T, off) ((T*)(F.ws + (off)))

__device__ __forceinline__ int ropeperm(int pp) { const int j8 = pp >> 3, e = pp & 7; return e < 4 ? 4 * j8 + e : 32 + 4 * j8 + (e - 4); }
__device__ __forceinline__ int in_col(int n) {
    const int tile = n >> 8, pc = n & 255;
    if (tile < 4) return (tile * 4 + (pc >> 6)) * 64 + ropeperm(pc & 63);
    if (tile < 10) { const int t = tile - 4, br = t >> 1, x = t & 1, pp = pc & 63; return 1024 + br * 512 + x * 256 + (pc >> 6) * 64 + (x == 0 ? ropeperm(pp) : pp); }
    if (tile < 14) return 2608 + (n - 10 * 256);
    if (tile < 16) return 3632 + (n - 14 * 256);
    if (tile < 18) return 4144 + (n - 16 * 256);
    if (tile < 22) return 4656 + (n - 18 * 256);
    if (tile < 26) return 5696 + (n - 22 * 256);
    if (tile < 34) return 6720 + (n - 26 * 256);
    if (tile < 42) return 8768 + (n - 34 * 256);
    if (pc < 48) return 2560 + pc;
    if (pc < 64) return 5680 + (pc - 48);
    return -1;
}
template <bool MAPPED>
__device__ __forceinline__ void transpose_item(const float* __restrict__ W, int ldw, int K, bf16* WT, int row_off, LAS float* scr, int k0, int n0, int lane) {
    int col = n0 + (lane & 31);
    if (MAPPED) col = in_col(col);
#pragma unroll 8
    for (int i = 0; i < 32; ++i) { const int kk = 2 * i + (lane >> 5); scr[kk * 33 + (lane & 31)] = (col >= 0) ? W[(size_t)(k0 + kk) * ldw + col] : 0.f; }
    LDS_WAIT(); asm volatile("" ::: "memory");
    const int c = lane & 7;
#pragma unroll
    for (int j = 0; j < 4; ++j) { const int n = (lane >> 3) + 8 * j; const LAS float* s = scr + (8 * c) * 33 + n;
        u32x4 o; o.x = pk2(s[0 * 33], s[1 * 33]); o.y = pk2(s[2 * 33], s[3 * 33]); o.z = pk2(s[4 * 33], s[5 * 33]); o.w = pk2(s[6 * 33], s[7 * 33]);
        *(u32x4*)(WT + (size_t)(row_off + n0 + n) * K + k0 + 8 * c) = o; }
    LDS_WAIT(); asm volatile("" ::: "memory");
}
__device__ const float INVF[32] = {1.000000000e+00f, 7.498942018e-01f, 5.623413324e-01f, 4.216965139e-01f, 3.162277639e-01f, 2.371373773e-01f, 1.778279394e-01f, 1.333521456e-01f,
    1.000000015e-01f, 7.498942316e-02f, 5.623413250e-02f, 4.216964915e-02f, 3.162277490e-02f, 2.371373773e-02f, 1.778279431e-02f, 1.333521400e-02f,
    9.999999776e-03f, 7.498942316e-03f, 5.623413250e-03f, 4.216964822e-03f, 3.162277630e-03f, 2.371373819e-03f, 1.778279431e-03f, 1.333521446e-03f,
    1.000000047e-03f, 7.498941850e-04f, 5.623413017e-04f, 4.216965172e-04f, 3.162277571e-04f, 2.371373703e-04f, 1.778279402e-04f, 1.333521504e-04f};
__device__ __forceinline__ void sincos_acc(float a, float& s, float& c) {
    const double x = (double)a;
    const double kq = __builtin_rint(x * 0.63661977236758134308);
    double r = __builtin_fma(-kq, 1.5707963267948966192, x); r = __builtin_fma(-kq, 6.123233995736766e-17, r);
    const int q = ((int)kq) & 3;
    const double z = r * r;
    double sp = 1.0 / 6227020800.0; sp = sp * z - 1.0 / 39916800.0; sp = sp * z + 1.0 / 362880.0; sp = sp * z - 1.0 / 5040.0; sp = sp * z + 1.0 / 120.0; sp = sp * z - 1.0 / 6.0; sp = sp * z + 1.0; sp *= r;
    double cp = 1.0 / 479001600.0; cp = cp * z - 1.0 / 3628800.0; cp = cp * z + 1.0 / 40320.0; cp = cp * z - 1.0 / 720.0; cp = cp * z + 1.0 / 24.0; cp = cp * z - 0.5; cp = cp * z + 1.0;
    const double ss = (q == 0) ? sp : (q == 1) ? cp : (q == 2) ? -sp : -cp;
    const double cc = (q == 0) ? cp : (q == 1) ? -sp : (q == 2) ? -cp : sp;
    s = (float)ss; c = (float)cc;
}

__device__ __forceinline__ void p0_prologue(Frame& F, const int rep) {
    LAS float* scr = (LAS float*)(F.lds + F.wave * 16384);
    const int lane = F.lane;
    constexpr int I_IN = 32 * 344;
    for (int it = F.gw; it < I_IN; it += F.NGW) transpose_item<true>(F.w_in, 10816, 2048, WSP(bf16, WS_WIN), 0, scr, 64 * (it / 344), 32 * (it % 344), lane);
    for (int r = F.gw; r < 4 * 16 * 4 + 2 * 2 * 2; r += F.NGW) {
        if (r < 256) { const int xj = r / 64, rr = r % 64;
            transpose_item<false>(F.cmp_w1 + (size_t)xj * 1024 * 128, 128, 1024, WSP(bf16, WS_W1T) + (size_t)(xj >> 1) * 256 * 1024, (xj & 1) * 128, scr, 64 * (rr / 4), 32 * (rr % 4), lane); }
        else { const int x = (r - 256) / 4, rr = (r - 256) % 4;
            transpose_item<false>(F.cmp_w2 + (size_t)x * 128 * 64, 64, 128, WSP(bf16, WS_POSB + 4096) + (size_t)x * 64 * 128, 0, scr, 64 * (rr / 2), 32 * (rr % 2), lane); }
    }
    for (int it = F.gw; it < 256; it += F.NGW) {
        const int x = it >> 7, e = it & 127; float s = 0.f;
        for (int i = 0; i < 32; ++i) { const int ld = i * 64 + lane; s += F.cmp_pos[x * 2048 + ld] * F.cmp_w1[((size_t)x * 2048 + ld) * 128 + e]; }
        s = wave_sum(s);
        if (lane == 0) WSP(float, WS_POSB)[it] = s + F.cmp_b1[it];
    }
    for (int i = F.gw * 64 + lane; i < 8200 * 32; i += F.NGW * 64) {
        const int pos = i >> 5, j = i & 31; const float ang = (float)pos * INVF[j]; float s, c; sincos_acc(ang, s, c);
        WSP(float, WS_ROPE)[pos * 64 + j] = c; WSP(float, WS_ROPE)[pos * 64 + 32 + j] = s;
    }
    for (int item = blockIdx.x; item < (rep ? 0 : 256); item += F.G) {
        const int cg = item & 31, ks = item >> 5;
        LAS float* cl = (LAS float*)(F.lds);
        LAS float* accl = (LAS float*)(F.lds + 33 * 256 * 4);
        __syncthreads();
        for (int i = F.tid; i < 33 * 256; i += 512) { const int r = i >> 8, kk = i & 255; cl[i] = (r == 0) ? F.c_p[ks * 256 + kk] : F.c_s[(r - 1) * 2048 + ks * 256 + kk]; }
        for (int i = F.tid; i < 33 * 192; i += 512) accl[i] = 0.f;
        __syncthreads();
#pragma unroll 1
        for (int g3 = 0; g3 < 3; ++g3) {
            f32x4 acc[11];
#pragma unroll
            for (int r = 0; r < 11; ++r) acc[r] = (f32x4){0.f, 0.f, 0.f, 0.f};
            if (lane < 48) {
                const float* wp = F.w_ada + (size_t)(ks * 256 + F.wave * 32) * NMOD + cg * 192 + lane * 4;
                const LAS float* clg = cl + g3 * 11 * 256 + F.wave * 32;
#pragma unroll 1
                for (int kk0 = 0; kk0 < 32; kk0 += 8) {
                    f32x4 w[8];
#pragma unroll
                    for (int j = 0; j < 8; ++j) w[j] = *(const f32x4*)(wp + (size_t)(kk0 + j) * NMOD);
#pragma unroll
                    for (int j = 0; j < 8; ++j)
#pragma unroll
                        for (int r = 0; r < 11; ++r) acc[r] += w[j] * clg[r * 256 + kk0 + j];
                }
            }
#pragma unroll 1
            for (int ww = 0; ww < 8; ++ww) {
                if (F.wave == ww && lane < 48) {
#pragma unroll
                    for (int r = 0; r < 11; ++r) { LAS f32x4* a = (LAS f32x4*)(accl + (g3 * 11 + r) * 192 + lane * 4); *a = *a + acc[r]; }
                }
                __syncthreads();
            }
        }
        for (int i = F.tid; i < 33 * 192; i += 512) { const int r = i / 192, cc = i % 192;
            const float v = accl[i] + ((ks == 0) ? F.b_ada[cg * 192 + cc] : 0.f);
            atomicAdd(WSP(unsigned long long, WS_MOD) + (size_t)r * NMOD + cg * 192 + cc, (unsigned long long)(long long)__builtin_rintf(v * MOD_SCALE)); }
        __syncthreads();
    }
}

constexpr int D_CMP = NBATCH_S * 2 * 8;
constexpr int D_TR_W = 2 * 16 * 64 + 32 * 64;
constexpr int D_TR = D_TR_W / 8;
constexpr int D_WIN = (NBATCH_S * 504 * 128) / 4096;
constexpr int D_TOTAL = D_CMP + D_TR + D_WIN;
static_assert((NBATCH_S * 504 * 128) % 4096 == 0 && D_TR_W % 8 == 0, "deferred items");
__device__ __forceinline__ void compress_sample_unit(Frame& F, int idx) {
    const int tid = F.tid, lane = F.lane, w = F.wave, c = lane & 31, h = lane >> 5;
    const int b = idx >> 4, x = (idx >> 3) & 1, pj = (idx & 7) * 8 + w;
    const int page = F.ptab[b * NPAGE + pj];
    LAS bf16* Bs = (LAS bf16*)F.lds;
    LAS bf16* As = (LAS bf16*)(F.lds + 73728) + w * 32 * KTLD;
    const bf16* W = WSP(bf16, WS_W1T) + (size_t)x * 256 * 1024 + (size_t)(tid >> 1) * 1024 + (tid & 1) * 32;
    const float* ap = F.c_cmp + (size_t)page * 128 * 512 + x * 256 + lane * 4;
    const int ast = (lane >> 4) * KTLD + (lane & 15) * 4;
    const int bst = (tid >> 1) * KTLD + (tid & 1) * 32;
    f32x16 acc[8];
#pragma unroll
    for (int nt = 0; nt < 8; ++nt)
#pragma unroll
        for (int r = 0; r < 16; ++r) acc[nt][r] = 0.f;
    u32x4 breg[4]; f32x4 areg[8];
#pragma unroll
    for (int i = 0; i < 4; ++i) breg[i] = *(const u32x4*)(W + 8 * i);
#pragma unroll
    for (int i = 0; i < 8; ++i) areg[i] = *(const f32x4*)(ap + (size_t)(16 * i) * 512);
#pragma unroll 1
    for (int s = 0; s < 16; ++s) {
        LAS bf16* Bb = Bs + (s & 1) * 256 * KTLD;
        asm volatile("" ::: "memory");
#pragma unroll
        for (int i = 0; i < 4; ++i) *(LAS u32x4*)(Bb + bst + 8 * i) = breg[i];
#pragma unroll
        for (int i = 0; i < 8; ++i) *(LAS u32x2*)(As + 4 * i * KTLD + ast) = pack4(areg[i]);
        asm volatile("" ::: "memory");
        __syncthreads();
        if (s + 1 < 16) {
#pragma unroll
            for (int i = 0; i < 4; ++i) breg[i] = *(const u32x4*)(W + 64 * (s + 1) + 8 * i);
#pragma unroll
            for (int i = 0; i < 8; ++i) areg[i] = *(const f32x4*)(ap + (size_t)(16 * i + s + 1) * 512);
        }
#pragma unroll
        for (int ks = 0; ks < 4; ++ks) {
            const bf16x8 af = *(const LAS bf16x8*)(As + c * KTLD + 16 * ks + 8 * h);
#pragma unroll
            for (int nt = 0; nt < 8; ++nt) { const bf16x8 bv = *(const LAS bf16x8*)(Bb + (32 * nt + c) * KTLD + 16 * ks + 8 * h); acc[nt] = __builtin_amdgcn_mfma_f32_32x32x16_bf16(af, bv, acc[nt], 0, 0, 0); }
        }
    }
    bf16* PART = WSP(bf16, WS_PART) + (size_t)x * CROWS * 256;
#pragma unroll
    for (int nt = 0; nt < 8; ++nt)
#pragma unroll
        for (int r = 0; r < 16; ++r) { const int m = (r & 3) + 8 * (r >> 2) + 4 * h; const size_t row = (size_t)(b * 4 + (m & 3)) * 512 + pj * 8 + (m >> 2);
            PART[row * 256 + 32 * nt + c] = (bf16)f2bf(acc[nt][r]); }
    __syncthreads();
}
__device__ __forceinline__ void p2_deferred_item(Frame& F, int item) {
    const int lane = F.lane;
    if (item < D_CMP) { compress_sample_unit(F, item); return; }
    item -= D_CMP;
    if (item < D_TR) {
        LAS float* scr = (LAS float*)(F.lds + F.wave * 16384);
        constexpr int I_ON = 16 * 64;
        int r = item * 8 + F.wave;
        if (r < I_ON) { transpose_item<false>(F.w_on, 2048, 2048, WSP(bf16, WS_WCAT), 0, scr, 64 * (r / 64), 32 * (r % 64), lane); return; } r -= I_ON;
        if (r < I_ON) { transpose_item<false>(F.w_og, 2048, 2048, WSP(bf16, WS_WCAT) + 1024, 0, scr, 64 * (r / 64), 32 * (r % 64), lane); return; } r -= I_ON;
        transpose_item<false>(F.w_out, 2048, 2048, WSP(bf16, WS_WOUT), 0, scr, 64 * (r / 64), 32 * (r % 64), lane);
        return;
    }
    item -= D_TR;
    {
        const f32x4* src = (const f32x4*)F.c_win; f32x4* dst = (f32x4*)(F.out + O_WINS);
        f32x4 v[8]; size_t di[8];
#pragma unroll
        for (int j = 0; j < 8; ++j) { const int i = item * 4096 + j * 512 + F.tid; const int b = i / (504 * 128), o = i % (504 * 128);
            di[j] = (size_t)b * 512 * 128 + o; v[j] = src[di[j] + 8 * 128]; }
#pragma unroll
        for (int j = 0; j < 8; ++j) dst[di[j]] = v[j];
    }
}

__device__ __forceinline__ void p1_modnorm(Frame& F) {
    const long long* MOD = WSP(long long, WS_MOD);
    bf16* H = WSP(bf16, WS_H);
    for (int r = F.gw; r < MROWS; r += F.NGW) {
        const float* xr = (r < TP) ? F.x_p + (size_t)r * DM : F.x_s + (size_t)(r - TP) * DM;
        const long long* mr = MOD + (size_t)((r < TP) ? 0 : 1 + ((r - TP) >> 3)) * NMOD;
        f32x4 v[8]; float ss = 0.f;
#pragma unroll
        for (int j = 0; j < 8; ++j) { v[j] = *(const f32x4*)(xr + (j * 64 + F.lane) * 4); ss += (v[j].x * v[j].x + v[j].y * v[j].y) + (v[j].z * v[j].z + v[j].w * v[j].w); }
        const float rstd = 1.f / sqrtf(wave_sum(ss) * (1.f / DM) + 1e-6f);
#pragma unroll
        for (int j = 0; j < 8; ++j) {
            const int c = (j * 64 + F.lane) * 4;
            const f32x4 nw = *(const f32x4*)(F.norm_w + c);
            const f32x4 sh = (f32x4){(float)mr[c], (float)mr[c + 1], (float)mr[c + 2], (float)mr[c + 3]} * MOD_INV;
            const f32x4 sc = (f32x4){(float)mr[2048 + c], (float)mr[2048 + c + 1], (float)mr[2048 + c + 2], (float)mr[2048 + c + 3]} * MOD_INV;
            const f32x4 hv = (v[j] * rstd) * nw * (sc + 1.0f) + sh;
            u32x2 o; o.x = pk2(hv.x, hv.y); o.y = pk2(hv.z, hv.w);
            *(u32x2*)(H + (size_t)r * DM + c) = o;
        }
    }
}


struct EpiPlainBf16 {
    static constexpr bool PERM = true, AFTER_DRAIN = false;
    bf16* O; int ldc;
    __device__ __forceinline__ void operator()(const f32x4 (&acc)[2][2][4][2], const pg8::Unit& u, int wr, int wc, int fr, int fq) const {
#pragma unroll
        for (int ai = 0; ai < 2; ++ai)
#pragma unroll
            for (int m = 0; m < 4; ++m) { const size_t row = (size_t)u.pm * 256 + ai * 128 + wr * 64 + m * 16 + fr;
#pragma unroll
                for (int bj = 0; bj < 2; ++bj) { const int col = u.pn * 256 + bj * 128 + wc * 32 + fq * 8;
                    *(u32x4*)(O + row * ldc + col) = pack8(acc[ai][bj][m][0], acc[ai][bj][m][1]); } }
    }
};

struct EpiIn {
    static constexpr bool PERM = true, AFTER_DRAIN = false;
    float* out; unsigned char* ws;
    __device__ __forceinline__ void operator()(const f32x4 (&acc)[2][2][4][2], const pg8::Unit& u, int wr, int wc, int fr, int fq) const {
        const int tile = u.pn;
        const float* ROPE = (const float*)(ws + WS_ROPE);
#pragma unroll
        for (int ai = 0; ai < 2; ++ai)
#pragma unroll
            for (int m = 0; m < 4; ++m) {
                const int row = u.pm * 256 + ai * 128 + wr * 64 + m * 16 + fr;
                const int pos = (row < TP) ? row : TP + ((row - TP) & 7);
#pragma unroll
                for (int bj = 0; bj < 2; ++bj) {
                    const int pc = bj * 128 + wc * 32 + fq * 8;
                    f32x4 v0 = acc[ai][bj][m][0], v1 = acc[ai][bj][m][1];
                    if (tile < 10) {
                        const int hh = pc >> 6, pp = pc & 63, j8 = pp >> 3;
                        const bool is_q = tile < 4; const int t = tile - 4, br = t >> 1, x = t & 1;
                        int d0, d1;
                        if (is_q || x == 0) {
                            const f32x4 cs = *(const f32x4*)(ROPE + (size_t)pos * 64 + 4 * j8), sn = *(const f32x4*)(ROPE + (size_t)pos * 64 + 32 + 4 * j8);
                            const f32x4 lo = v0 * cs - v1 * sn, hi = v1 * cs + v0 * sn; v0 = lo; v1 = hi; d0 = 4 * j8; d1 = 32 + 4 * j8;
                        } else { d0 = pp; d1 = pp + 4; }
                        if (is_q) {
                            bf16* q = (bf16*)(ws + WS_QB) + (size_t)row * 1024 + (tile * 4 + hh) * 64;
                            *(u32x2*)(q + d0) = pack4(v0 * QSCALE); *(u32x2*)(q + d1) = pack4(v1 * QSCALE);
                        } else {
                            const int co = x * 256 + hh * 64;
                            float* o = nullptr;
                            if (row < TP) {
                                if (br == 0) o = out + O_CMPP + (size_t)row * 512 + co;
                                else if (br == 1) o = out + O_SELP + (size_t)row * 512 + co;
                                else if (row >= TP - 512) o = out + O_WINP + (size_t)(row - (TP - 512)) * 512 + co;
                                bf16* kb = (br == 0) ? (bf16*)(ws + WS_CB) + (size_t)x * CB_X + ((size_t)(32 * 4 + hh) * 8192 + row) * 64
                                                     : (bf16*)(ws + WS_KVB) + ((size_t)(((br - 1) * 2 + x) * 4 + hh) * 8192 + row) * 64;
                                *(u32x2*)(kb + d0) = pack4(v0); *(u32x2*)(kb + d1) = pack4(v1);
                            } else {
                                const int sr = row - TP;
                                if (br == 0) o = out + O_CMPS + (size_t)sr * 512 + co;
                                else if (br == 1) o = out + O_SELS + (size_t)sr * 512 + co;
                                else o = out + O_WINS + ((size_t)(sr >> 3) * 512 + 504 + (sr & 7)) * 512 + co;
                            }
                            if (o) { *(f32x4*)(o + d0) = v0; *(f32x4*)(o + d1) = v1; }
                        }
                    } else if (tile < 14) {
                        const int col = (tile - 10) * 256 + pc;
                        v0 = (f32x4){silu(v0.x), silu(v0.y), silu(v0.z), silu(v0.w)}; v1 = (f32x4){silu(v1.x), silu(v1.y), silu(v1.z), silu(v1.w)};
                        *(u32x4*)((bf16*)(ws + WS_ZN) + (size_t)row * 1024 + col) = pack8(v0, v1);
                    } else if (tile < 16) {
                        *(u32x4*)((bf16*)(ws + WS_QG) + (size_t)row * 512 + (tile - 14) * 256 + pc) = pack8(v0 * GQSCALE, v1 * GQSCALE);
                    } else if (tile < 18) {
                        *(u32x4*)((bf16*)(ws + WS_KG) + (size_t)row * 512 + (tile - 16) * 256 + pc) = pack8(v0, v1);
                    } else if (tile < 22) {
                        const int col = (tile - 18) * 256 + pc;
                        if (row < TP) {
                            bf16* vt = (bf16*)(ws + WS_VGT) + ((size_t)(row >> 6) * 1024 + col) * 64 + (row & 63);
                            vt[0 * 64] = (bf16)f2bf(v0.x); vt[1 * 64] = (bf16)f2bf(v0.y); vt[2 * 64] = (bf16)f2bf(v0.z); vt[3 * 64] = (bf16)f2bf(v0.w);
                            vt[4 * 64] = (bf16)f2bf(v1.x); vt[5 * 64] = (bf16)f2bf(v1.y); vt[6 * 64] = (bf16)f2bf(v1.z); vt[7 * 64] = (bf16)f2bf(v1.w);
                        } else {
                            float* vs = (float*)(ws + WS_VGS) + (size_t)(row - TP) * 1024 + col;
                            *(f32x4*)vs = v0; *(f32x4*)(vs + 4) = v1;
                        }
                    } else if (tile < 26) {
                        const int col = (tile - 22) * 256 + pc;
                        v0 = (f32x4){silu(v0.x), silu(v0.y), silu(v0.z), silu(v0.w)}; v1 = (f32x4){silu(v1.x), silu(v1.y), silu(v1.z), silu(v1.w)};
                        *(u32x4*)((bf16*)(ws + WS_ZG) + (size_t)row * 1024 + col) = pack8(v0, v1);
                    } else if (tile < 42) {
                        const bool mn = tile < 34; const int col = (tile - (mn ? 26 : 34)) * 256 + pc;
                        v0 = (f32x4){sigm(v0.x), sigm(v0.y), sigm(v0.z), sigm(v0.w)}; v1 = (f32x4){sigm(v1.x), sigm(v1.y), sigm(v1.z), sigm(v1.w)};
                        *(u32x4*)((bf16*)(ws + (mn ? WS_MN : WS_MG)) + (size_t)row * 2048 + col) = pack8(v0, v1);
                    } else {
                        if (pc < 48) {
                            v0 = (f32x4){sigm(v0.x), sigm(v0.y), sigm(v0.z), sigm(v0.w)}; v1 = (f32x4){sigm(v1.x), sigm(v1.y), sigm(v1.z), sigm(v1.w)};
                            float* g = (float*)(ws + WS_GB) + (size_t)row * 48 + pc; *(f32x4*)g = v0; *(f32x4*)(g + 4) = v1;
                        } else if (pc < 64) {
                            float* a = (float*)(ws + WS_AG) + (size_t)row * 16 + (pc - 48); *(f32x4*)a = v0; *(f32x4*)(a + 4) = v1;
                        }
                    }
                }
            }
    }
};

struct EpiMergeZ {
    static constexpr bool PERM = true, AFTER_DRAIN = false;
    const bf16* GN; const bf16* GG; bf16* O;
    __device__ __forceinline__ void operator()(const f32x4 (&acc)[2][2][4][2], const pg8::Unit& u, int wr, int wc, int fr, int fq) const {
        const bf16* G = u.z ? GG : GN;
#pragma unroll
        for (int ai = 0; ai < 2; ++ai)
#pragma unroll
            for (int m = 0; m < 4; ++m) { const size_t row = (size_t)u.pm * 256 + ai * 128 + wr * 64 + m * 16 + fr;
#pragma unroll
                for (int bj = 0; bj < 2; ++bj) { const int col = u.pn * 256 + bj * 128 + wc * 32 + fq * 8;
                    const u32x4 g = *(const u32x4*)(G + row * 2048 + col);
                    f32x4 v0 = acc[ai][bj][m][0] * (f32x4){bflo(g.x), bfhi(g.x), bflo(g.y), bfhi(g.y)};
                    f32x4 v1 = acc[ai][bj][m][1] * (f32x4){bflo(g.z), bfhi(g.z), bflo(g.w), bfhi(g.w)};
                    if (u.z) { const u32x4 p = *(const u32x4*)(O + row * 2048 + col);
                        v0 += (f32x4){bflo(p.x), bfhi(p.x), bflo(p.y), bfhi(p.y)}; v1 += (f32x4){bflo(p.z), bfhi(p.z), bflo(p.w), bfhi(p.w)}; }
                    *(u32x4*)(O + row * 2048 + col) = pack8(v0, v1); } }
    }
};
struct EpiOut {
    static constexpr bool PERM = true, AFTER_DRAIN = false;
    const float* x_p; const float* x_s; const long long* MOD; float* out; float* RSS;
    __device__ __forceinline__ void operator()(const f32x4 (&acc)[2][2][4][2], const pg8::Unit& u, int wr, int wc, int fr, int fq) const {
#pragma unroll
        for (int ai = 0; ai < 2; ++ai)
#pragma unroll
            for (int m = 0; m < 4; ++m) { const int row = u.pm * 256 + ai * 128 + wr * 64 + m * 16 + fr;
                const float* xr = (row < TP) ? x_p + (size_t)row * DM : x_s + (size_t)(row - TP) * DM;
                const long long* gr = MOD + (size_t)((row < TP) ? 0 : 1 + ((row - TP) >> 3)) * NMOD + 4096;
                float* yr = out + ((row < TP) ? O_YP + (size_t)row * DM : O_YS + (size_t)(row - TP) * DM);
                float ss = 0.f;
#pragma unroll
                for (int bj = 0; bj < 2; ++bj) { const int col = u.pn * 256 + bj * 128 + wc * 32 + fq * 8;
#pragma unroll
                    for (int n = 0; n < 2; ++n) { const long long* gp = gr + col + 4 * n; const f32x4 gt = (f32x4){(float)gp[0], (float)gp[1], (float)gp[2], (float)gp[3]} * MOD_INV;
                        const f32x4 y = *(const f32x4*)(xr + col + 4 * n) + gt * acc[ai][bj][m][n];
                        *(f32x4*)(yr + col + 4 * n) = y; ss += (y.x * y.x + y.y * y.y) + (y.z * y.z + y.w * y.w); } }
                ss += __shfl_xor(ss, 16); ss += __shfl_xor(ss, 32);
                if (fq == 0) RSS[(size_t)row * 64 + u.pn * 4 + wc] = ss; }
    }
};


template <class Epi>
__device__ __forceinline__ void wave_gemm_tiles(Frame& F, const bf16* A, int lda, const bf16* Bt, int ldb, int m0, int mtiles, int ntiles, int K, const Epi& E) {
    const int lane = F.lane, c = lane & 31, h = lane >> 5, grp = F.wave >> 2, ks = F.wave & 3, kq = K >> 2;
    LAS float* red = (LAS float*)(F.lds) + (grp * 3) * 1024;
    const int T = mtiles * ntiles;
    for (int t2 = blockIdx.x; 2 * t2 < T; t2 += F.G) {
        const int t = 2 * t2 + grp;
        const int tm = t / ntiles, tn = t % ntiles;
        const bf16* ap = A + (size_t)(m0 + 32 * tm + c) * lda + ks * kq + 8 * h;
        const bf16* bp = Bt + (size_t)(32 * tn + c) * ldb + ks * kq + 8 * h;
        f32x16 acc;
#pragma unroll
        for (int r = 0; r < 16; ++r) acc[r] = 0.f;
#pragma unroll 4
        for (int k = 0; k < kq; k += 16) { const bf16x8 a = *(const bf16x8*)(ap + k), b = *(const bf16x8*)(bp + k); acc = __builtin_amdgcn_mfma_f32_32x32x16_bf16(a, b, acc, 0, 0, 0); }
        if constexpr (Epi::PRE) E.pre(acc, m0 + 32 * tm, 32 * tn, ks, lane);
        __syncthreads();
        if (ks != 0) {
#pragma unroll
            for (int r = 0; r < 16; ++r) red[((ks - 1) * 16 + r) * 64 + lane] = acc[r];
        }
        __syncthreads();
        if (ks == 0) {
#pragma unroll
            for (int r = 0; r < 16; ++r) acc[r] += (red[(0 * 16 + r) * 64 + lane] + red[(1 * 16 + r) * 64 + lane]) + red[(2 * 16 + r) * 64 + lane];
            E(acc, m0 + 32 * tm, 32 * tn, tn, lane);
        }
    }
    __syncthreads();
}
struct SEpiPlain { static constexpr bool PRE = false; bf16* O; int ldc;
    __device__ __forceinline__ void operator()(const f32x16& acc, int m0, int n0, int tn, int lane) const { const int c = lane & 31, h = lane >> 5;
#pragma unroll
        for (int r = 0; r < 16; ++r) O[(size_t)(m0 + (r & 3) + 8 * (r >> 2) + 4 * h) * ldc + n0 + c] = (bf16)f2bf(acc[r]); } };
struct SEpiMergeCat { static constexpr bool PRE = true; const bf16* GN; const bf16* GG; bf16* O;
    __device__ __forceinline__ void pre(f32x16& acc, int m0, int n0, int ks, int lane) const { const int c = lane & 31, h = lane >> 5; const bf16* G = (ks < 2) ? GN : GG;
#pragma unroll
        for (int r = 0; r < 16; ++r) acc[r] *= bf2f(G[(size_t)(m0 + (r & 3) + 8 * (r >> 2) + 4 * h) * 2048 + n0 + c]); }
    __device__ __forceinline__ void operator()(const f32x16& acc, int m0, int n0, int tn, int lane) const { const int c = lane & 31, h = lane >> 5;
#pragma unroll
        for (int r = 0; r < 16; ++r) O[(size_t)(m0 + (r & 3) + 8 * (r >> 2) + 4 * h) * 2048 + n0 + c] = (bf16)f2bf(acc[r]); } };
struct SEpiOut { static constexpr bool PRE = false; const float* x_s; const long long* MOD; float* out; float* RSS;
    __device__ __forceinline__ void operator()(const f32x16& acc, int m0, int n0, int tn, int lane) const { const int c = lane & 31, h = lane >> 5;
#pragma unroll
        for (int r = 0; r < 16; ++r) { const int row = m0 + (r & 3) + 8 * (r >> 2) + 4 * h, sr = row - TP;
            const float y = x_s[(size_t)sr * DM + n0 + c] + ((float)MOD[(size_t)(1 + (sr >> 3)) * NMOD + 4096 + n0 + c] * MOD_INV) * acc[r];
            out[O_YS + (size_t)sr * DM + n0 + c] = y;
            float ss = y * y; ss += __shfl_xor(ss, 1); ss += __shfl_xor(ss, 2); ss += __shfl_xor(ss, 4); ss += __shfl_xor(ss, 8); ss += __shfl_xor(ss, 16);
            if (c == 0) RSS[(size_t)row * 64 + tn] = ss; } } };

__device__ __forceinline__ void compress_l2(Frame& F) {
    const int lane = F.lane, c32 = lane & 31, h = lane >> 5;
    const float* POSB = WSP(float, WS_POSB);
    for (int x = 0; x < 2; ++x) {
        const bf16* W2T = WSP(bf16, WS_POSB + 4096) + (size_t)x * 64 * 128;
        const bf16* PART = WSP(bf16, WS_PART) + (size_t)x * CROWS * 256;
        bf16* KC = WSP(bf16, WS_KC) + (size_t)x * CROWS * 64;
        bf16x8 bfr[2][8];
#pragma unroll
        for (int dt = 0; dt < 2; ++dt)
#pragma unroll
            for (int ks = 0; ks < 8; ++ks) bfr[dt][ks] = *(const bf16x8*)(W2T + (size_t)(32 * dt + c32) * 128 + 16 * ks + 8 * h);
        const float b2a = F.cmp_b2[x * 64 + c32], b2b = F.cmp_b2[x * 64 + 32 + c32];
        for (int it = F.gw; it < CROWS / 32; it += F.NGW) {
            const size_t row = (size_t)it * 32 + c32;
            f32x16 o0, o1;
#pragma unroll
            for (int r = 0; r < 16; ++r) { o0[r] = 0.f; o1[r] = 0.f; }
#pragma unroll
            for (int ks = 0; ks < 8; ++ks) {
                const int e0 = 16 * ks + 8 * h;
                const u32x4 p0 = *(const u32x4*)(PART + row * 256 + e0), p1 = *(const u32x4*)(PART + (row + 1) * 256 + 128 + e0);
                const f32x4 ba = *(const f32x4*)(POSB + x * 128 + e0), bb = *(const f32x4*)(POSB + x * 128 + e0 + 4);
                f32x4 a = (f32x4){bflo(p0.x) + bflo(p1.x), bfhi(p0.x) + bfhi(p1.x), bflo(p0.y) + bflo(p1.y), bfhi(p0.y) + bfhi(p1.y)} + ba;
                f32x4 b = (f32x4){bflo(p0.z) + bflo(p1.z), bfhi(p0.z) + bfhi(p1.z), bflo(p0.w) + bflo(p1.w), bfhi(p0.w) + bfhi(p1.w)} + bb;
                a = (f32x4){silu(a.x), silu(a.y), silu(a.z), silu(a.w)}; b = (f32x4){silu(b.x), silu(b.y), silu(b.z), silu(b.w)};
                const u32x4 hp = pack8(a, b); const bf16x8 hf = __builtin_bit_cast(bf16x8, hp);
                o0 = __builtin_amdgcn_mfma_f32_32x32x16_bf16(hf, bfr[0][ks], o0, 0, 0, 0);
                o1 = __builtin_amdgcn_mfma_f32_32x32x16_bf16(hf, bfr[1][ks], o1, 0, 0, 0);
            }
#pragma unroll
            for (int r = 0; r < 16; ++r) {
                const size_t orow = (size_t)it * 32 + (r & 3) + 8 * (r >> 2) + 4 * h;
                const bool dead = (orow & 511) == 511;
                KC[orow * 64 + c32] = dead ? (bf16)0 : (bf16)f2bf(o0[r] + b2a);
                KC[orow * 64 + 32 + c32] = dead ? (bf16)0 : (bf16)f2bf(o1[r] + b2b);
            }
        }
    }
}

__device__ __forceinline__ void final_norm(Frame& F) {
    const float* RSS = WSP(float, WS_RSS);
    for (int r = F.gw; r < MROWS; r += F.NGW) {
        float* yr = F.out + ((r < TP) ? O_YP + (size_t)r * DM : O_YS + (size_t)(r - TP) * DM);
        float ss = (F.lane < 32 || r >= TP) ? RSS[(size_t)r * 64 + F.lane] : 0.f;
        const float rstd = 1.f / sqrtf(wave_sum(ss) * (1.f / DM) + 1e-6f);
#pragma unroll
        for (int j = 0; j < 8; ++j) { const int c = (j * 64 + F.lane) * 4;
            const f32x4 v = *(const f32x4*)(yr + c) * rstd * *(const f32x4*)(F.fnw + c); *(f32x4*)(yr + c) = v; }
    }
}

typedef short v4i16_t __attribute__((ext_vector_type(4)));
__device__ __forceinline__ s16x4 tr_read(const LAS bf16* p) { return __builtin_bit_cast(s16x4, __builtin_amdgcn_ds_read_tr16_b64_v4i16((LAS v4i16_t*)p)); }
typedef __bf16 bf16x2_t __attribute__((ext_vector_type(2)));
__device__ __forceinline__ unsigned cvtpk(float lo, float hi) { const f32x2 v = {lo, hi}; const bf16x2_t b = __builtin_convertvector(v, bf16x2_t); return __builtin_bit_cast(unsigned, b); }

struct QLds { const LAS bf16x8* p; __device__ __forceinline__ bf16x8 get(int ks) const { return p[ks * 64]; } };
__device__ __forceinline__ bf16x8 qget(const bf16x8 (&q)[4], int ks) { return q[ks]; }
__device__ __forceinline__ bf16x8 qget(const QLds& q, int ks) { return q.get(ks); }
template <int NKT, class QT>
__device__ __forceinline__ void qk_scores(f32x16 (&s)[NKT], const LAS bf16* Kt, const QT& qf, int lane) {
    const int c = lane & 31, h = lane >> 5;
#pragma unroll
    for (int kt = 0; kt < NKT; ++kt) {
#pragma unroll
        for (int r = 0; r < 16; ++r) s[kt][r] = 0.f;
#pragma unroll
        for (int ks = 0; ks < 4; ++ks) {
            const bf16x8 a = *(const LAS bf16x8*)(Kt + (32 * kt + c) * KTLD + 16 * ks + 8 * h);
            s[kt] = __builtin_amdgcn_mfma_f32_32x32x16_bf16(a, qget(qf, ks), s[kt], 0, 0, 0);
        }
    }
}
template <int NKT>
__device__ __forceinline__ void pv_accum(f32x16 (&o)[2], const f32x16 (&p)[NKT], const LAS bf16* Vt, int lane) {
    const int i16 = lane & 15, g16 = lane >> 4, h = lane >> 5;
    const LAS bf16* vb = Vt + (4 * h + (i16 >> 2)) * KTLD + 16 * (g16 & 1) + 4 * (i16 & 3);
#pragma unroll
    for (int kt = 0; kt < NKT; ++kt)
#pragma unroll
        for (int s2 = 0; s2 < 2; ++s2) {
            u32x4 pw; pw.x = cvtpk(p[kt][8 * s2 + 0], p[kt][8 * s2 + 1]); pw.y = cvtpk(p[kt][8 * s2 + 2], p[kt][8 * s2 + 3]);
            pw.z = cvtpk(p[kt][8 * s2 + 4], p[kt][8 * s2 + 5]); pw.w = cvtpk(p[kt][8 * s2 + 6], p[kt][8 * s2 + 7]);
            const bf16x8 pf = __builtin_bit_cast(bf16x8, pw);
#pragma unroll
            for (int dt = 0; dt < 2; ++dt) {
                const s16x4 lo = tr_read(vb + (32 * kt + 16 * s2) * KTLD + 32 * dt), hi = tr_read(vb + (32 * kt + 16 * s2 + 8) * KTLD + 32 * dt);
                const bf16x8 vf = (bf16x8){lo[0], lo[1], lo[2], lo[3], hi[0], hi[1], hi[2], hi[3]};
                o[dt] = __builtin_amdgcn_mfma_f32_32x32x16_bf16(vf, pf, o[dt], 0, 0, 0);
            }
            __builtin_amdgcn_sched_barrier(0);
        }
}
template <int NKT>
__device__ __forceinline__ float mask_max(f32x16 (&s)[NKT], int lo, int hi, int h) {
    const int lo2 = lo - 4 * h, hi2 = hi - 4 * h; float mx = -1e30f;
#pragma unroll
    for (int kt = 0; kt < NKT; ++kt)
#pragma unroll
        for (int r = 0; r < 16; ++r) { const int ko = 32 * kt + (r & 3) + 8 * (r >> 2); const bool v = (ko >= lo2) && (ko <= hi2);
            const float x = v ? s[kt][r] : -1e30f; s[kt][r] = x; mx = fmaxf(mx, x); }
    return fmaxf(mx, __shfl_xor(mx, 32));
}
struct FlashSt { float m, l; f32x16 o[2]; };
__device__ __forceinline__ void flash_init(FlashSt& st) { st.m = -1e30f; st.l = 0.f;
#pragma unroll
    for (int r = 0; r < 16; ++r) { st.o[0][r] = 0.f; st.o[1][r] = 0.f; } }
template <int NKT, int mode, class QT>
__device__ __forceinline__ void flash_tile(FlashSt& st, const LAS bf16* Kt, const LAS bf16* Vt, const QT& qf, bool sel, int lo, int hi, int lane) {
    f32x16 s[NKT];
    qk_scores<NKT>(s, Kt, qf, lane);
    float mx;
    if (mode == 2) mx = mask_max<NKT>(s, lo, hi, lane >> 5);
    else {
        float a = -1e30f;
#pragma unroll
        for (int kt = 0; kt < NKT; ++kt)
#pragma unroll
            for (int r = 0; r < 16; ++r) a = fmaxf(a, s[kt][r]);
        if (mode == 1) {
            a = sel ? a : -1e30f;
#pragma unroll
            for (int kt = 0; kt < NKT; ++kt)
#pragma unroll
                for (int r = 0; r < 16; ++r) s[kt][r] = sel ? s[kt][r] : -1e30f;
        }
        mx = fmaxf(a, __shfl_xor(a, 32));
    }
    const float mn = fmaxf(st.m, mx), alpha = ex2(st.m - mn); st.m = mn;
    float ps = 0.f;
    if (mode == 0) {
#pragma unroll
        for (int kt = 0; kt < NKT; ++kt)
#pragma unroll
            for (int r = 0; r < 16; ++r) { const float p = ex2(s[kt][r] - mn); s[kt][r] = p; ps += p; }
    } else {
#pragma unroll
        for (int kt = 0; kt < NKT; ++kt)
#pragma unroll
            for (int r = 0; r < 16; ++r) { const float x = s[kt][r]; const float p = (x > -1e29f) ? ex2(x - mn) : 0.f; s[kt][r] = p; ps += p; }
    }
    st.l = st.l * alpha + ps;
#pragma unroll
    for (int r = 0; r < 16; ++r) { st.o[0][r] *= alpha; st.o[1][r] *= alpha; }
    pv_accum<NKT>(st.o, s, Vt, lane);
}
template <int NKT>
__device__ __forceinline__ void stats_tile(float& m, float& l, const LAS bf16* Kt, const bf16x8 (&qf)[4], int lo, int hi, int lane) {
    f32x16 s[NKT];
    qk_scores<NKT>(s, Kt, qf, lane);
    const float mx = mask_max<NKT>(s, lo, hi, lane >> 5);
    const float mn = fmaxf(m, mx), alpha = ex2(m - mn); m = mn;
    float ps = 0.f;
#pragma unroll
    for (int kt = 0; kt < NKT; ++kt)
#pragma unroll
        for (int r = 0; r < 16; ++r) { const float x = s[kt][r]; ps += (x > -1e29f) ? ex2(x - mn) : 0.f; }
    l = l * alpha + ps;
}
template <int NKT>
__device__ __forceinline__ void cmp2_tile(f32x16 (&o)[2], const LAS bf16* Kt, const LAS bf16* Vt, const bf16x8 (&qf)[4], int lo, int hi, float M, float invL,
                                          LAS float* impA, LAS float* impB, int q, int impld, int n_base, int lane) {
    f32x16 s[NKT];
    qk_scores<NKT>(s, Kt, qf, lane);
    (void)mask_max<NKT>(s, lo, hi, lane >> 5);
#pragma unroll
    for (int kt = 0; kt < NKT; ++kt)
#pragma unroll
        for (int r = 0; r < 16; ++r) { const float x = s[kt][r]; s[kt][r] = (x > -1e29f) ? ex2(x - M) * invL : 0.f; }
    const int h = lane >> 5;
#pragma unroll
    for (int kt = 0; kt < NKT; ++kt)
#pragma unroll
        for (int k4 = 0; k4 < 4; ++k4) {
            float s4 = (s[kt][4 * k4] + s[kt][4 * k4 + 1]) + (s[kt][4 * k4 + 2] + s[kt][4 * k4 + 3]), p3 = s[kt][4 * k4 + 3];
            s4 += __shfl_xor(s4, 8); s4 += __shfl_xor(s4, 16); p3 += __shfl_xor(p3, 8); p3 += __shfl_xor(p3, 16);
            if ((lane & 24) == 0) { const int n0 = n_base + 8 * kt + 2 * k4 + h; impA[q * impld + n0] = s4; impB[q * impld + n0 + 1] = p3; }
        }
    pv_accum<NKT>(o, s, Vt, lane);
}

constexpr int IMPLD = 130;
__device__ __forceinline__ void nsa_prompt_unit(Frame& F, int qt, int kvh) {
    const int tid = F.tid, lane = F.lane, w = F.wave, c = lane & 31, h = lane >> 5, qi = c & 7, g = c >> 3;
    LAS bf16* Kt0 = (LAS bf16*)(F.lds);
    LAS bf16* Vt0 = (LAS bf16*)(F.lds + 18432);
    LAS float* impA = (LAS float*)(F.lds + 36864);
    LAS float* impB = (LAS float*)(F.lds + 36864 + 33280);
    LAS unsigned* selb = (LAS unsigned*)(F.lds + 36864 + 66560);
    const int q_off = 8 * w + qi, token = 64 * qt + q_off, head = kvh * 4 + g;
    const bf16* QB = WSP(bf16, WS_QB);
    bf16x8 qf[4];
#pragma unroll
    for (int ks = 0; ks < 4; ++ks) qf[ks] = *(const bf16x8*)(QB + (size_t)token * 1024 + head * 64 + 16 * ks + 8 * h);
    const float* gbp = WSP(float, WS_GB) + (size_t)token * 48 + head * 3;
    const float gb_c = gbp[0], gb_s = gbp[1], gb_w = gbp[2];
    f32x16 oacc[2];
#pragma unroll
    for (int r = 0; r < 16; ++r) { oacc[0][r] = 0.f; oacc[1][r] = 0.f; }
    const int srow = tid >> 3, sch = tid & 7;
    const int lds_st = srow * KTLD + sch * 8;

    {
        const bf16* KCk = WSP(bf16, WS_KC) + ((size_t)(32 * 4 + kvh) * 512) * 64;
        const bf16* KCv = WSP(bf16, WS_KC) + (size_t)CROWS * 64 + ((size_t)(32 * 4 + kvh) * 512) * 64;
        int cmax = (token - 31) >> 4; if (cmax > 510) cmax = 510;
        const int nT = ((4 * qt + 2) >> 6) + 1;
        float m = -1e30f, l = 0.f;
        u32x4 kreg = *(const u32x4*)(KCk + (size_t)srow * 64 + sch * 8), vreg;
        for (int t = 0; t < nT; ++t) {
            LAS bf16* Kt = Kt0 + (t & 1) * 64 * KTLD;
            *(LAS u32x4*)(Kt + lds_st) = kreg;
            __syncthreads();
            if (t + 1 < nT) kreg = *(const u32x4*)(KCk + (size_t)((t + 1) * 64 + srow) * 64 + sch * 8);
            int hi = cmax - 64 * t; if (hi > 63) hi = 63;
            stats_tile<2>(m, l, Kt, qf, 0, hi, lane);
        }
        l += __shfl_xor(l, 32);
        const float invL = (l > 0.f) ? 1.f / l : 0.f;
        __syncthreads();
        kreg = *(const u32x4*)(KCk + (size_t)srow * 64 + sch * 8); vreg = *(const u32x4*)(KCv + (size_t)srow * 64 + sch * 8);
        f32x16 o[2];
#pragma unroll
        for (int r = 0; r < 16; ++r) { o[0][r] = 0.f; o[1][r] = 0.f; }
        for (int t = 0; t < nT; ++t) {
            LAS bf16* Kt = Kt0 + (t & 1) * 64 * KTLD; LAS bf16* Vt = Vt0 + (t & 1) * 64 * KTLD;
            *(LAS u32x4*)(Kt + lds_st) = kreg; *(LAS u32x4*)(Vt + lds_st) = vreg;
            __syncthreads();
            if (t + 1 < nT) { kreg = *(const u32x4*)(KCk + (size_t)((t + 1) * 64 + srow) * 64 + sch * 8); vreg = *(const u32x4*)(KCv + (size_t)((t + 1) * 64 + srow) * 64 + sch * 8); }
            int hi = cmax - 64 * t; if (hi > 63) hi = 63;
            cmp2_tile<2>(o, Kt, Vt, qf, 0, hi, m, invL, impA, impB, q_off, IMPLD, 16 * t, lane);
        }
#pragma unroll
        for (int r = 0; r < 16; ++r) { oacc[0][r] += gb_c * o[0][r]; oacc[1][r] += gb_c * o[1][r]; }
    }
    __syncthreads();
    if (tid < 256) selb[tid] = 0u;
    __syncthreads();
    if (qt <= 15) {
        if (tid < 64) selb[tid * 4] = (1u << (qt + 1)) - 1u;
    } else {
        const int q = tid >> 3, sub = tid & 7, nhi = qt - 2;
#pragma unroll 1
        for (int i = 0; i < 16; ++i) { const int n = sub + 8 * i; if (n >= 1 && n <= nhi) impA[q * IMPLD + n] += impB[q * IMPLD + n]; }
        __syncthreads();
#pragma unroll 1
        for (int i = 0; i < 16; ++i) {
            const int n = sub + 8 * i; bool sel;
            if (n >= 1 && n <= nhi) {
                const float v = impA[q * IMPLD + n]; int rank = 0;
#pragma unroll 4
                for (int mm = 1; mm <= nhi; ++mm) { const float vm = impA[q * IMPLD + mm]; rank += (vm > v || (vm == v && mm < n)) ? 1 : 0; }
                sel = rank < 13;
            } else sel = (n == 0 || n == qt || n == qt - 1);
            if (sel) atomicOr((unsigned*)&selb[q * 4 + (n >> 5)], 1u << (n & 31));
        }
    }
    __syncthreads();
    const unsigned sw0 = selb[q_off * 4 + 0], sw1 = selb[q_off * 4 + 1], sw2 = selb[q_off * 4 + 2], sw3 = selb[q_off * 4 + 3];
    __syncthreads();
    LAS bf16x8* Qs = (LAS bf16x8*)(F.lds + 73728) + w * 256;
#pragma unroll
    for (int ks = 0; ks < 4; ++ks) Qs[ks * 64 + lane] = qf[ks];
    asm volatile("" ::: "memory");
    const QLds ql{(const LAS bf16x8*)Qs + lane};
    {
        const bf16* Kg = WSP(bf16, WS_KVB) + ((size_t)((0 * 2 + 0) * 4 + kvh) * 8192) * 64;
        const bf16* Vg = WSP(bf16, WS_KVB) + ((size_t)((0 * 2 + 1) * 4 + kvh) * 8192) * 64;
        FlashSt st; flash_init(st);
        LAS bf16* KS = (LAS bf16*)(F.lds); LAS bf16* VS = (LAS bf16*)(F.lds + 36864);
#define LDT(kr, vr, blkn) { kr = *(const u32x4*)(Kg + (size_t)((blkn) * 64 + srow) * 64 + sch * 8); vr = *(const u32x4*)(Vg + (size_t)((blkn) * 64 + srow) * 64 + sch * 8); }
#define STT(kr, vr, slot) { *(LAS u32x4*)(KS + (slot) * 64 * KTLD + lds_st) = kr; *(LAS u32x4*)(VS + (slot) * 64 * KTLD + lds_st) = vr; }
#define SEL_TILE(slot, blk) { const unsigned swd = ((blk) < 32) ? sw0 : ((blk) < 64) ? sw1 : ((blk) < 96) ? sw2 : sw3; const bool sq = (swd >> ((blk) & 31)) & 1u; \
            const unsigned long long bal = __ballot(sq); \
            if (bal != 0ull) { const int md = ((blk) == qt) ? 2 : ((bal == ~0ull) ? 0 : 1); const int lo = sq ? 0 : 1, hi = sq ? (((blk) == qt) ? q_off : 63) : 0; \
                if (md == 2) flash_tile<2, 2>(st, KS + (slot) * 64 * KTLD, VS + (slot) * 64 * KTLD, ql, sq, lo, hi, lane); \
                else if (md == 1) flash_tile<2, 1>(st, KS + (slot) * 64 * KTLD, VS + (slot) * 64 * KTLD, ql, sq, lo, hi, lane); \
                else flash_tile<2, 0>(st, KS + (slot) * 64 * KTLD, VS + (slot) * 64 * KTLD, ql, sq, lo, hi, lane); } }
        u32x4 k0, v0, k1 = (u32x4){0u, 0u, 0u, 0u}, v1 = k1;
        LDT(k0, v0, 0) if (qt >= 1) LDT(k1, v1, 1)
        for (int blk = 0; blk <= qt; blk += 2) {
            const int sb = blk & 2; const bool two = (blk + 1 <= qt);
            STT(k0, v0, sb) if (two) STT(k1, v1, sb + 1)
            __syncthreads();
            if (blk + 2 <= qt) LDT(k0, v0, blk + 2)
            if (blk + 3 <= qt) LDT(k1, v1, blk + 3)
            SEL_TILE(sb, blk)
            if (two) SEL_TILE(sb + 1, blk + 1)
        }
#undef SEL_TILE
        const float lt = st.l + __shfl_xor(st.l, 32); const float sc = (lt > 0.f) ? gb_s / lt : 0.f;
#pragma unroll
        for (int r = 0; r < 16; ++r) { oacc[0][r] += sc * st.o[0][r]; oacc[1][r] += sc * st.o[1][r]; }
    }
    __syncthreads();
    {
        const bf16* Kg = WSP(bf16, WS_KVB) + ((size_t)((1 * 2 + 0) * 4 + kvh) * 8192) * 64;
        const bf16* Vg = WSP(bf16, WS_KVB) + ((size_t)((1 * 2 + 1) * 4 + kvh) * 8192) * 64;
        const int b0 = (qt >= 8) ? qt - 8 : 0;
        FlashSt st; flash_init(st);
        LAS bf16* KS = (LAS bf16*)(F.lds); LAS bf16* VS = (LAS bf16*)(F.lds + 36864);
#define WIN_TILE(slot, blk) { const int lo = ((blk) == qt - 8) ? q_off + 1 : 0, hi = ((blk) == qt) ? q_off : 63; const int md = ((blk) == qt || (blk) == qt - 8) ? 2 : 0; \
            if (md == 2) flash_tile<2, 2>(st, KS + (slot) * 64 * KTLD, VS + (slot) * 64 * KTLD, ql, true, lo, hi, lane); \
            else flash_tile<2, 0>(st, KS + (slot) * 64 * KTLD, VS + (slot) * 64 * KTLD, ql, true, lo, hi, lane); }
        u32x4 k0, v0, k1 = (u32x4){0u, 0u, 0u, 0u}, v1 = k1;
        LDT(k0, v0, b0) if (b0 + 1 <= qt) LDT(k1, v1, b0 + 1)
        for (int blk = b0; blk <= qt; blk += 2) {
            const int sb = (blk - b0) & 2; const bool two = (blk + 1 <= qt);
            STT(k0, v0, sb) if (two) STT(k1, v1, sb + 1)
            __syncthreads();
            if (blk + 2 <= qt) LDT(k0, v0, blk + 2)
            if (blk + 3 <= qt) LDT(k1, v1, blk + 3)
            WIN_TILE(sb, blk)
            if (two) WIN_TILE(sb + 1, blk + 1)
        }
#undef WIN_TILE
#undef STT
#undef LDT
        const float lt = st.l + __shfl_xor(st.l, 32); const float sc = (lt > 0.f) ? gb_w / lt : 0.f;
#pragma unroll
        for (int r = 0; r < 16; ++r) { oacc[0][r] += sc * st.o[0][r]; oacc[1][r] += sc * st.o[1][r]; }
    }
    __syncthreads();
    {
        const bf16* zn = WSP(bf16, WS_ZN) + (size_t)token * 1024 + head * 64;
        bf16* on = WSP(bf16, WS_OCAT) + (size_t)token * 2048 + head * 64;
#pragma unroll
        for (int dt = 0; dt < 2; ++dt)
#pragma unroll
            for (int k4 = 0; k4 < 4; ++k4) { const int d = 32 * dt + 8 * k4 + 4 * h;
                const u32x2 z = *(const u32x2*)(zn + d);
                const f32x4 v = (f32x4){oacc[dt][4 * k4] * bflo(z.x), oacc[dt][4 * k4 + 1] * bfhi(z.x), oacc[dt][4 * k4 + 2] * bflo(z.y), oacc[dt][4 * k4 + 3] * bfhi(z.y)};
                *(u32x2*)(on + d) = pack4(v); }
    }
}

__device__ __forceinline__ void stage_half_f32(LAS bf16* dst, const float* base, int nvalid, int lane) {
    const int r4 = lane >> 4, c4 = (lane & 15) * 4;
    f32x4 v[8];
#pragma unroll
    for (int i = 0; i < 8; ++i) { const int row = 4 * i + r4; v[i] = (row < nvalid) ? *(const f32x4*)(base + (size_t)row * 512 + c4) : (f32x4){0.f, 0.f, 0.f, 0.f}; }
#pragma unroll
    for (int i = 0; i < 8; ++i) *(LAS u32x2*)(dst + (4 * i + r4) * KTLD + c4) = pack4(v[i]);
}
__device__ __forceinline__ void stage_half_bf16(LAS bf16* dst, const bf16* base, int lane) {
    const int row = lane >> 1, hf = lane & 1;
#pragma unroll
    for (int i = 0; i < 4; ++i) *(LAS u32x4*)(dst + row * KTLD + hf * 32 + 8 * i) = *(const u32x4*)(base + (size_t)row * 64 + hf * 32 + 8 * i);
}
__device__ __forceinline__ void merge_partials(const LAS float* mlb, const LAS float* comb, int lane, f32x16 (&o)[2], float& L) {
    const int c = lane & 31;
    float M = -1e30f;
#pragma unroll
    for (int ww = 0; ww < 8; ++ww) M = fmaxf(M, mlb[(ww * 64 + lane) * 2]);
    L = 0.f;
#pragma unroll
    for (int r = 0; r < 16; ++r) { o[0][r] = 0.f; o[1][r] = 0.f; }
#pragma unroll 1
    for (int ww = 0; ww < 8; ++ww) {
        const float f = ex2(mlb[(ww * 64 + lane) * 2] - M);
        L += (mlb[(ww * 64 + c) * 2 + 1] + mlb[(ww * 64 + c + 32) * 2 + 1]) * f;
#pragma unroll
        for (int r = 0; r < 16; ++r) { o[0][r] += comb[(ww * 32 + r) * 64 + lane] * f; o[1][r] += comb[(ww * 32 + 16 + r) * 64 + lane] * f; }
    }
}
__device__ __forceinline__ void nsa_sample_unit(Frame& F, int b, int kvh) {
    const int tid = F.tid, lane = F.lane, w = F.wave, c = lane & 31, h = lane >> 5, qi = c & 7, g = c >> 3;
    LAS bf16* Kw = (LAS bf16*)(F.lds + w * 9216); LAS bf16* Vw = Kw + 32 * KTLD;
    LAS float* comb = (LAS float*)F.lds;
    LAS float* mlb = (LAS float*)(F.lds + 65536);
    LAS float* impA = (LAS float*)(F.lds + 73728);
    LAS float* impB = impA + 8 * IMPLD;
    LAS unsigned* selb = (LAS unsigned*)(impB + 8 * IMPLD);
    const int token = TP + 8 * b + qi, head = kvh * 4 + g;
    const bf16* QB = WSP(bf16, WS_QB);
    bf16x8 qf[4];
#pragma unroll
    for (int ks = 0; ks < 4; ++ks) qf[ks] = *(const bf16x8*)(QB + (size_t)token * 1024 + head * 64 + 16 * ks + 8 * h);
    const float* gbp = WSP(float, WS_GB) + (size_t)token * 48 + head * 3;
    const float gb_c = gbp[0], gb_s = gbp[1], gb_w = gbp[2];
    f32x16 oacc[2];
#pragma unroll
    for (int r = 0; r < 16; ++r) { oacc[0][r] = 0.f; oacc[1][r] = 0.f; }
    __syncthreads();
    {
        const bf16* KCk = WSP(bf16, WS_KC) + ((size_t)(b * 4 + kvh) * 512) * 64;
        const bf16* KCv = KCk + (size_t)CROWS * 64;
        float m = -1e30f, l = 0.f;
        for (int ti = w; ti < 16; ti += 8) {
            stage_half_bf16(Kw, KCk + (size_t)ti * 32 * 64, lane);
            int hi = 510 - 32 * ti; if (hi > 31) hi = 31;
            stats_tile<1>(m, l, Kw, qf, 0, hi, lane);
        }
        __syncthreads();
        mlb[(w * 64 + lane) * 2] = m; mlb[(w * 64 + lane) * 2 + 1] = l;
        __syncthreads();
        float M = -1e30f;
#pragma unroll
        for (int ww = 0; ww < 8; ++ww) M = fmaxf(M, mlb[(ww * 64 + lane) * 2]);
        float L = 0.f;
#pragma unroll
        for (int ww = 0; ww < 8; ++ww) L += (mlb[(ww * 64 + c) * 2 + 1] + mlb[(ww * 64 + c + 32) * 2 + 1]) * ex2(mlb[(ww * 64 + lane) * 2] - M);
        const float invL = (L > 0.f) ? 1.f / L : 0.f;
        __syncthreads();
        f32x16 o[2];
#pragma unroll
        for (int r = 0; r < 16; ++r) { o[0][r] = 0.f; o[1][r] = 0.f; }
        for (int ti = w; ti < 16; ti += 8) {
            stage_half_bf16(Kw, KCk + (size_t)ti * 32 * 64, lane); stage_half_bf16(Vw, KCv + (size_t)ti * 32 * 64, lane);
            int hi = 510 - 32 * ti; if (hi > 31) hi = 31;
            cmp2_tile<1>(o, Kw, Vw, qf, 0, hi, M, invL, impA, impB, qi, IMPLD, 8 * ti, lane);
        }
        __syncthreads();
#pragma unroll
        for (int r = 0; r < 16; ++r) { comb[(w * 32 + r) * 64 + lane] = o[0][r]; comb[(w * 32 + 16 + r) * 64 + lane] = o[1][r]; }
        __syncthreads();
        if (w == 0) {
#pragma unroll 1
            for (int ww = 0; ww < 8; ++ww)
#pragma unroll
                for (int r = 0; r < 16; ++r) { oacc[0][r] += gb_c * comb[(ww * 32 + r) * 64 + lane]; oacc[1][r] += gb_c * comb[(ww * 32 + 16 + r) * 64 + lane]; }
        }
    }
    __syncthreads();
    if (tid < 64) selb[tid] = 0u;
    {
        const int q = w;
#pragma unroll 1
        for (int i = 0; i < 2; ++i) { const int n = lane + 64 * i; if (n >= 1 && n <= 126) impA[q * IMPLD + n] += impB[q * IMPLD + n]; }
        __syncthreads();
#pragma unroll 1
        for (int i = 0; i < 2; ++i) {
            const int n = lane + 64 * i; bool sel = true;
            if (n >= 1 && n <= 126) {
                const float v = impA[q * IMPLD + n]; int rank = 0;
#pragma unroll 4
                for (int mm = 1; mm <= 126; ++mm) { const float vm = impA[q * IMPLD + mm]; rank += (vm > v || (vm == v && mm < n)) ? 1 : 0; }
                sel = rank < 13;
            }
            if (sel) atomicOr((unsigned*)&selb[q * 8 + (n >> 5)], 1u << (n & 31));
        }
        if (lane == 0) atomicOr((unsigned*)&selb[q * 8 + 4], 1u);
    }
    __syncthreads();
    {
        FlashSt st; flash_init(st);
        int cnt = 0;
        for (int blk = 0; blk <= 128; ++blk) {
            unsigned uw = 0u;
#pragma unroll
            for (int q = 0; q < 8; ++q) uw |= selb[q * 8 + (blk >> 5)];
            uw = __builtin_amdgcn_readfirstlane(uw);
            if (!((uw >> (blk & 31)) & 1u)) continue;
            const int nh = (blk == 128) ? 1 : 2;
            for (int hf = 0; hf < nh; ++hf) {
                if (((cnt++) & 7) != w) continue;
                const float* base; int nvalid;
                if (blk < 128) { const int page = F.ptab[b * NPAGE + (blk >> 1)]; base = F.c_sel + ((size_t)page * 128 + (blk & 1) * 64 + hf * 32) * 512 + kvh * 64; nvalid = 32; }
                else { base = F.out + O_SELS + (size_t)(b * 8) * 512 + kvh * 64; nvalid = 8; }
                stage_half_f32(Kw, base, nvalid, lane); stage_half_f32(Vw, base + 256, nvalid, lane);
                const bool sq = (selb[qi * 8 + (blk >> 5)] >> (blk & 31)) & 1u;
                const int lo = sq ? 0 : 1, hi = sq ? ((blk == 128) ? qi : 31) : 0;
                flash_tile<1, 2>(st, Kw, Vw, qf, sq, lo, hi, lane);
            }
        }
        __syncthreads();
        mlb[(w * 64 + lane) * 2] = st.m; mlb[(w * 64 + lane) * 2 + 1] = st.l;
#pragma unroll
        for (int r = 0; r < 16; ++r) { comb[(w * 32 + r) * 64 + lane] = st.o[0][r]; comb[(w * 32 + 16 + r) * 64 + lane] = st.o[1][r]; }
        __syncthreads();
        if (w == 0) { f32x16 o[2]; float L; merge_partials(mlb, comb, lane, o, L); const float sc = (L > 0.f) ? gb_s / L : 0.f;
#pragma unroll
            for (int r = 0; r < 16; ++r) { oacc[0][r] += sc * o[0][r]; oacc[1][r] += sc * o[1][r]; } }
    }
    __syncthreads();
    {
        FlashSt st; flash_init(st);
        for (int ti = w; ti < 17; ti += 8) {
            const float* base; int nvalid;
            if (ti < 16) { base = F.c_win + ((size_t)b * 512 + 32 * ti) * 512 + kvh * 64; nvalid = 32; }
            else { base = F.out + O_WINS + ((size_t)b * 512 + 504) * 512 + kvh * 64; nvalid = 8; }
            stage_half_f32(Kw, base, nvalid, lane); stage_half_f32(Vw, base + 256, nvalid, lane);
            const int lo = (ti == 0) ? 1 + qi : 0, hi = (ti == 16) ? qi : 31;
            flash_tile<1, 2>(st, Kw, Vw, qf, true, lo, hi, lane);
        }
        __syncthreads();
        mlb[(w * 64 + lane) * 2] = st.m; mlb[(w * 64 + lane) * 2 + 1] = st.l;
#pragma unroll
        for (int r = 0; r < 16; ++r) { comb[(w * 32 + r) * 64 + lane] = st.o[0][r]; comb[(w * 32 + 16 + r) * 64 + lane] = st.o[1][r]; }
        __syncthreads();
        if (w == 0) { f32x16 o[2]; float L; merge_partials(mlb, comb, lane, o, L); const float sc = (L > 0.f) ? gb_w / L : 0.f;
#pragma unroll
            for (int r = 0; r < 16; ++r) { oacc[0][r] += sc * o[0][r]; oacc[1][r] += sc * o[1][r]; } }
    }
    if (w == 0) {
        const bf16* zn = WSP(bf16, WS_ZN) + (size_t)token * 1024 + head * 64;
        bf16* on = WSP(bf16, WS_OCAT) + (size_t)token * 2048 + head * 64;
#pragma unroll
        for (int dt = 0; dt < 2; ++dt)
#pragma unroll
            for (int k4 = 0; k4 < 4; ++k4) { const int d = 32 * dt + 8 * k4 + 4 * h;
                const u32x2 z = *(const u32x2*)(zn + d);
                const f32x4 v = (f32x4){oacc[dt][4 * k4] * bflo(z.x), oacc[dt][4 * k4 + 1] * bfhi(z.x), oacc[dt][4 * k4 + 2] * bflo(z.y), oacc[dt][4 * k4 + 3] * bfhi(z.y)};
                *(u32x2*)(on + d) = pack4(v); }
    }
    __syncthreads();
}


__device__ __forceinline__ float log_sigmoid(float z) { return (z < 0.f) ? z - log1pf(__expf(z)) : -log1pf(__expf(-z)); }
__device__ __forceinline__ void gla_cum(Frame& F, int ch, int hd, LAS float* cum, LAS float* qs, LAS float* agt) {
    const int tid = F.tid, k = tid & 127, tq = tid >> 7;
    const float* AG = WSP(float, WS_AG) + (size_t)(64 * ch) * 16;
    for (int i = tid; i < 64 * 16; i += 512) agt[i] = AG[i];
    float wv[16];
#pragma unroll
    for (int r = 0; r < 16; ++r) wv[r] = F.w_a2[r * 512 + hd * 128 + k];
    const float bias = F.b_a[hd * 128 + k];
    __syncthreads();
    float run = 0.f;
    for (int tt = 0; tt < 16; ++tt) {
        const int t = 16 * tq + tt; float z = bias;
#pragma unroll
        for (int r = 0; r < 16; ++r) z += agt[t * 16 + r] * wv[r];
        run += log_sigmoid(z) * (1.f / 16.f); cum[t * 128 + k] = run;
    }
    qs[tq * 128 + k] = run;
    __syncthreads();
    float off = 0.f;
    for (int j = 0; j < tq; ++j) off += qs[j * 128 + k];
    if (tq > 0) for (int tt = 0; tt < 16; ++tt) cum[(16 * tq + tt) * 128 + k] += off;
    __syncthreads();
}
__device__ __forceinline__ void gla_pass1_unit(Frame& F, int ch, int hd) {
    LAS float* cum = (LAS float*)F.lds; LAS float* qs = cum + 64 * 128; LAS float* agt = qs + 512;
    LAS bf16* KhT = (LAS bf16*)(F.lds + 40960);
    gla_cum(F, ch, hd, cum, qs, agt);
    const int tid = F.tid, k = tid & 127, tq = tid >> 7, lane = F.lane, c = lane & 31, h = lane >> 5, w = F.wave;
    const float cl = cum[63 * 128 + k];
    const bf16* KG = WSP(bf16, WS_KG) + (size_t)(64 * ch) * 512 + hd * 128 + k;
    unsigned pk[8];
#pragma unroll
    for (int j = 0; j < 8; ++j) { const int s = 16 * tq + 2 * j;
        const float v0 = bf2f(KG[(size_t)s * 512]) * __expf(cl - cum[s * 128 + k]), v1 = bf2f(KG[(size_t)(s + 1) * 512]) * __expf(cl - cum[(s + 1) * 128 + k]);
        pk[j] = pk2(v0, v1); }
    *(LAS u32x4*)(KhT + k * 72 + 16 * tq) = (u32x4){pk[0], pk[1], pk[2], pk[3]};
    *(LAS u32x4*)(KhT + k * 72 + 16 * tq + 8) = (u32x4){pk[4], pk[5], pk[6], pk[7]};
    if (tq == 0) WSP(float, WS_DC)[(ch * 4 + hd) * 128 + k] = __expf(cl);
    __syncthreads();
    const bf16* VGT = WSP(bf16, WS_VGT) + ((size_t)ch * 1024 + hd * 256 + 32 * w + c) * 64;
    bf16x8 af[4];
#pragma unroll
    for (int ss = 0; ss < 4; ++ss) af[ss] = *(const bf16x8*)(VGT + 16 * ss + 8 * h);
    float* LT = WSP(float, WS_LT) + ((size_t)(ch * 4 + hd) * 256 + 32 * w) * 128;
#pragma unroll
    for (int kt = 0; kt < 4; ++kt) {
        f32x16 acc;
#pragma unroll
        for (int r = 0; r < 16; ++r) acc[r] = 0.f;
#pragma unroll
        for (int ss = 0; ss < 4; ++ss) { const bf16x8 bv = *(const LAS bf16x8*)(KhT + (32 * kt + c) * 72 + 16 * ss + 8 * h); acc = __builtin_amdgcn_mfma_f32_32x32x16_bf16(af[ss], bv, acc, 0, 0, 0); }
#pragma unroll
        for (int r = 0; r < 16; ++r) LT[(size_t)((r & 3) + 8 * (r >> 2) + 4 * h) * 128 + 32 * kt + c] = acc[r];
    }
    __syncthreads();
}
__device__ __forceinline__ void gla_pass2(Frame& F) {
    const float* __restrict__ LT = WSP(float, WS_LT); const float* __restrict__ DC = WSP(float, WS_DC); bf16* __restrict__ ST = WSP(bf16, WS_ST);
    for (int e = blockIdx.x * 512 + F.tid; e < 4 * 256 * 128; e += F.G * 512) {
        const int k = e & 127, v = (e >> 7) & 255, hd = e >> 15;
        float S = 0.f;
#pragma unroll 8
        for (int cc = 0; cc < 128; ++cc) { const size_t idx = ((size_t)(cc * 4 + hd) * 256 + v) * 128 + k; ST[idx] = (bf16)f2bf(S); S = DC[(cc * 4 + hd) * 128 + k] * S + LT[idx]; }
        F.out[O_STP + ((size_t)hd * 128 + k) * 256 + v] = S;
    }
}
__device__ __forceinline__ void gla_pass3_unit(Frame& F, int ch, int hd) {
    LAS float* cum = (LAS float*)F.lds; LAS float* qs = cum + 64 * 128; LAS float* agt = qs + 512;
    LAS bf16* Qt = (LAS bf16*)(F.lds + 40960);
    LAS bf16* Kt2 = Qt + 64 * 136;
    LAS bf16* Att = Kt2 + 64 * 136;
    LAS float* red = (LAS float*)(F.lds + 84992);
    LAS float* rstdv = red + 512;
    gla_cum(F, ch, hd, cum, qs, agt);
    const int tid = F.tid, k = tid & 127, tq = tid >> 7, lane = F.lane, c = lane & 31, h = lane >> 5, w = F.wave;
    {
        const bf16* QG = WSP(bf16, WS_QG) + (size_t)(64 * ch) * 512 + hd * 128 + k;
        const bf16* KG = WSP(bf16, WS_KG) + (size_t)(64 * ch) * 512 + hd * 128 + k;
        for (int tt = 0; tt < 16; ++tt) { const int t = 16 * tq + tt; const float cu = cum[t * 128 + k];
            Qt[t * 136 + k] = (bf16)f2bf(bf2f(QG[(size_t)t * 512]) * __expf(cu)); Kt2[t * 136 + k] = (bf16)f2bf(bf2f(KG[(size_t)t * 512]) * __expf(-cu)); }
    }
    __syncthreads();
    if (w < 3) {
        const int tt = (w + 1) >> 1, st = w >> 1;
        f32x16 acc;
#pragma unroll
        for (int r = 0; r < 16; ++r) acc[r] = 0.f;
#pragma unroll
        for (int ks = 0; ks < 8; ++ks) { const bf16x8 a = *(const LAS bf16x8*)(Qt + (32 * tt + c) * 136 + 16 * ks + 8 * h), bv = *(const LAS bf16x8*)(Kt2 + (32 * st + c) * 136 + 16 * ks + 8 * h);
            acc = __builtin_amdgcn_mfma_f32_32x32x16_bf16(a, bv, acc, 0, 0, 0); }
#pragma unroll
        for (int r = 0; r < 16; ++r) { const int t = 32 * tt + (r & 3) + 8 * (r >> 2) + 4 * h, s = 32 * st + c; Att[t * 72 + s] = (s <= t) ? (bf16)f2bf(acc[r]) : (bf16)0; }
    } else if (w == 3) {
#pragma unroll
        for (int r = 0; r < 16; ++r) { const int t = (r & 3) + 8 * (r >> 2) + 4 * h; Att[t * 72 + 32 + c] = (bf16)0; }
    }
    __syncthreads();
    f32x16 acc[2];
    {
        const bf16* VGT = WSP(bf16, WS_VGT) + ((size_t)ch * 1024 + hd * 256 + 32 * w + c) * 64;
        const bf16* STp = WSP(bf16, WS_ST) + ((size_t)(ch * 4 + hd) * 256 + 32 * w + c) * 128;
        bf16x8 bv[4], bs[8];
#pragma unroll
        for (int ss = 0; ss < 4; ++ss) bv[ss] = *(const bf16x8*)(VGT + 16 * ss + 8 * h);
#pragma unroll
        for (int ks = 0; ks < 8; ++ks) bs[ks] = *(const bf16x8*)(STp + 16 * ks + 8 * h);
#pragma unroll
        for (int tt = 0; tt < 2; ++tt) {
#pragma unroll
            for (int r = 0; r < 16; ++r) acc[tt][r] = 0.f;
#pragma unroll
            for (int ss = 0; ss < 4; ++ss) { if (tt == 0 && ss >= 2) continue;
                const bf16x8 a = *(const LAS bf16x8*)(Att + (32 * tt + c) * 72 + 16 * ss + 8 * h); acc[tt] = __builtin_amdgcn_mfma_f32_32x32x16_bf16(a, bv[ss], acc[tt], 0, 0, 0); }
#pragma unroll
            for (int ks = 0; ks < 8; ++ks) { const bf16x8 a = *(const LAS bf16x8*)(Qt + (32 * tt + c) * 136 + 16 * ks + 8 * h); acc[tt] = __builtin_amdgcn_mfma_f32_32x32x16_bf16(a, bs[ks], acc[tt], 0, 0, 0); }
        }
    }
#pragma unroll
    for (int tt = 0; tt < 2; ++tt)
#pragma unroll
        for (int r = 0; r < 16; ++r) { float sq = acc[tt][r] * acc[tt][r];
            sq += __shfl_xor(sq, 1); sq += __shfl_xor(sq, 2); sq += __shfl_xor(sq, 4); sq += __shfl_xor(sq, 8); sq += __shfl_xor(sq, 16);
            if (c == 0) red[w * 64 + 32 * tt + (r & 3) + 8 * (r >> 2) + 4 * h] = sq; }
    __syncthreads();
    if (tid < 64) { float s = 0.f;
#pragma unroll
        for (int ww = 0; ww < 8; ++ww) s += red[ww * 64 + tid];
        rstdv[tid] = 1.f / sqrtf(s * (1.f / 256.f) + 1e-6f); }
    __syncthreads();
    {
        const int col = hd * 256 + 32 * w + c; const float gw = F.gnw[32 * w + c];
        const bf16* ZG = WSP(bf16, WS_ZG); bf16* OG = WSP(bf16, WS_OCAT) + 1024;
#pragma unroll
        for (int tt = 0; tt < 2; ++tt)
#pragma unroll
            for (int r = 0; r < 16; ++r) { const int t = 32 * tt + (r & 3) + 8 * (r >> 2) + 4 * h; const size_t row = (size_t)(64 * ch + t);
                OG[row * 2048 + col] = (bf16)f2bf(acc[tt][r] * rstdv[t] * gw * bf2f(ZG[row * 1024 + col])); }
    }
    __syncthreads();
}
__device__ __forceinline__ void gla_sample_unit(Frame& F, int b, int hd) {
    LAS float* cumS = (LAS float*)F.lds; LAS float* qtl = cumS + 1024; LAS float* khl = qtl + 1024; LAS float* ktl = khl + 1024;
    LAS float* att = ktl + 1024; LAS float* oih = att + 64; LAS float* red = oih + 2048;
    const int tid = F.tid, lane = F.lane, w = F.wave, row0 = TP + 8 * b;
    if (tid < 128) {
        const int k = tid; float wv[16];
#pragma unroll
        for (int r = 0; r < 16; ++r) wv[r] = F.w_a2[r * 512 + hd * 128 + k];
        const float bias = F.b_a[hd * 128 + k]; float run = 0.f;
        const float* AG = WSP(float, WS_AG) + (size_t)row0 * 16;
        for (int t = 0; t < 8; ++t) { float z = bias;
#pragma unroll
            for (int r = 0; r < 16; ++r) z += AG[t * 16 + r] * wv[r];
            run += log_sigmoid(z) * (1.f / 16.f); cumS[t * 128 + k] = run; }
    }
    __syncthreads();
    for (int i = tid; i < 1024; i += 512) { const int t = i >> 7, k = i & 127; const float cu = cumS[i], cl = cumS[7 * 128 + k];
        const float q = bf2f(WSP(bf16, WS_QG)[(size_t)(row0 + t) * 512 + hd * 128 + k]), kk = bf2f(WSP(bf16, WS_KG)[(size_t)(row0 + t) * 512 + hd * 128 + k]);
        qtl[i] = q * __expf(cu); khl[i] = kk * __expf(cl - cu); ktl[i] = kk * __expf(-cu); }
    __syncthreads();
    if (tid < 64) { const int t = tid >> 3, s = tid & 7; float a = 0.f;
        if (s <= t) for (int k = 0; k < 128; ++k) a += qtl[t * 128 + k] * ktl[s * 128 + k];
        att[tid] = a; }
    __syncthreads();
    const int v = tid & 255, kh = tid >> 8;
    float vv[8], oi[8];
#pragma unroll
    for (int s = 0; s < 8; ++s) { vv[s] = WSP(float, WS_VGS)[(size_t)(8 * b + s) * 1024 + hd * 256 + v]; oi[s] = 0.f; }
    const float* S0 = F.state + ((size_t)(b * 4 + hd) * 128) * 256; float* SN = F.out + O_STS + ((size_t)(b * 4 + hd) * 128) * 256;
#pragma unroll 4
    for (int kk = 0; kk < 64; ++kk) { const int k = kh * 64 + kk; const float s0 = S0[(size_t)k * 256 + v]; float sn = __expf(cumS[7 * 128 + k]) * s0;
#pragma unroll
        for (int s = 0; s < 8; ++s) { sn += khl[s * 128 + k] * vv[s]; oi[s] += qtl[s * 128 + k] * s0; }
        SN[(size_t)k * 256 + v] = sn; }
    if (kh == 1) {
#pragma unroll
        for (int t = 0; t < 8; ++t) oih[t * 256 + v] = oi[t]; }
    __syncthreads();
    if (kh == 0) {
#pragma unroll
        for (int t = 0; t < 8; ++t) { float o = oi[t] + oih[t * 256 + v];
#pragma unroll
            for (int s = 0; s < 8; ++s) if (s <= t) o += att[t * 8 + s] * vv[s];
            oi[t] = o; } }
#pragma unroll
    for (int t = 0; t < 8; ++t) { float sq = (kh == 0) ? oi[t] * oi[t] : 0.f; sq = wave_sum(sq); if (lane == 0) red[w * 8 + t] = sq; }
    __syncthreads();
    if (kh == 0) { const float gw = F.gnw[v];
#pragma unroll
        for (int t = 0; t < 8; ++t) { const float ssum = (red[t] + red[8 + t]) + (red[16 + t] + red[24 + t]); const float rstd = 1.f / sqrtf(ssum * (1.f / 256.f) + 1e-6f);
            const size_t row = (size_t)(row0 + t);
            WSP(bf16, WS_OCAT)[row * 2048 + 1024 + hd * 256 + v] = (bf16)f2bf(oi[t] * rstd * gw * bf2f(WSP(bf16, WS_ZG)[row * 1024 + hd * 256 + v])); } }
    __syncthreads();
}


#ifdef SELF_CHECK
__device__ __forceinline__ void self_check_kc(Frame& F) {
    const int lane = F.lane;
    unsigned* errw = (unsigned*)(F.ctl + CW_Q5 + 4096);
    for (int sidx = F.gw; sidx < 4096; sidx += F.NGW) {
        unsigned hsh = (unsigned)sidx * 2654435761u; hsh ^= hsh >> 15; hsh *= 2246822519u; hsh ^= hsh >> 13;
        const int x = hsh & 1, b = (hsh >> 1) % 33, hh = (hsh >> 8) & 3, cc = (hsh >> 10) % 511, d = (hsh >> 20) & 63;
        float part = 0.f;
        for (int ee = 0; ee < 2; ++ee) {
            const int e = lane + 64 * ee; float hid = F.cmp_b1[x * 128 + e];
            for (int l = 0; l < 32; ++l) {
                const int pos = 16 * cc + l;
                const float* row = (b < 32) ? F.c_cmp + ((size_t)F.ptab[b * NPAGE + (pos >> 7)] * 128 + (pos & 127)) * 512 + x * 256 + hh * 64
                                            : F.out + O_CMPP + (size_t)pos * 512 + x * 256 + hh * 64;
                for (int dd = 0; dd < 64; ++dd) hid += (row[dd] + F.cmp_pos[(x * 32 + l) * 64 + dd]) * F.cmp_w1[(((size_t)x * 32 + l) * 64 + dd) * 128 + e];
            }
            part += silu(hid) * F.cmp_w2[((size_t)x * 128 + e) * 64 + d];
        }
        part = wave_sum(part) + F.cmp_b2[x * 64 + d];
        const float got = bf2f(WSP(bf16, WS_KC)[(size_t)x * CROWS * 64 + ((size_t)(b * 4 + hh) * 512 + cc) * 64 + d]);
        if (lane == 0 && !(fabsf(got - part) <= 0.05f * fabsf(part) + 0.02f)) atomicAdd(errw, 1u);
    }
}
#endif
#ifndef MK_N_LAUNCHES
#define MK_N_LAUNCHES 1
#endif
constexpr int NPH = 9;
constexpr int N_LAUNCHES = MK_N_LAUNCHES;
struct Args { const void* in[25]; float* out; unsigned char* ws; int ph_lo, ph_hi, rpt, pad; };

__global__ void __launch_bounds__(NWAVES * 64, 2) nsa_gla_fwd(Args args) {
    extern __shared__ __attribute__((aligned(16))) unsigned char lds[];
    Frame F;
    F.lds = (LAS unsigned char*)lds;
    F.MISC = (volatile LAS unsigned*)(F.lds + LDSCTL_OFF);
    F.tid = threadIdx.x; F.lane = F.tid & 63; F.wave = __builtin_amdgcn_readfirstlane(F.tid >> 6);
    F.G = gridDim.x; F.gw = blockIdx.x * NWAVES + F.wave; F.NGW = F.G * NWAVES;
    F.ws = args.ws; F.out = args.out; F.ctl = (gu32*)(args.ws + WS_CTL);
#define LOAD_INPUTS() do { \
    F.x_p = (const float*)args.in[0]; F.x_s = (const float*)args.in[1]; F.c_cmp = (const float*)args.in[2]; F.c_sel = (const float*)args.in[3]; \
    F.c_win = (const float*)args.in[4]; F.state = (const float*)args.in[5]; F.ptab = (const int*)args.in[6]; F.c_p = (const float*)args.in[7]; \
    F.c_s = (const float*)args.in[8]; F.norm_w = (const float*)args.in[9]; F.w_ada = (const float*)args.in[10]; F.b_ada = (const float*)args.in[11]; \
    F.w_in = (const float*)args.in[12]; F.cmp_pos = (const float*)args.in[13]; F.cmp_w1 = (const float*)args.in[14]; F.cmp_b1 = (const float*)args.in[15]; \
    F.cmp_w2 = (const float*)args.in[16]; F.cmp_b2 = (const float*)args.in[17]; F.w_a2 = (const float*)args.in[18]; F.b_a = (const float*)args.in[19]; \
    F.gnw = (const float*)args.in[20]; F.w_on = (const float*)args.in[21]; F.w_og = (const float*)args.in[22]; F.w_out = (const float*)args.in[23]; \
    F.fnw = (const float*)args.in[24]; } while (0)
    LOAD_INPUTS();
    for (int u = F.tid; u < (LDS_BYTES - LDSCTL_OFF) / 4; u += NWAVES * 64) ((LAS unsigned*)(F.lds + LDSCTL_OFF))[u] = 0u;
    __syncthreads();
    const int lo = args.ph_lo, hi = args.ph_hi;
    const bool use_bar = (hi - lo) > 1;
    XcdBarrier bar; bar.bar = (unsigned*)(F.ctl + CW_BAR); bar.x = 0; bar.st = nullptr;
    if (use_bar) bar = xcd_barrier_post((unsigned*)(F.ctl + CW_BAR), F.MISC + 8);
#ifndef PH_MASK
#define PH_MASK 0x1ff
#endif
#define IN(k) (((PH_MASK >> (k)) & 1) && lo <= (k) && (k) < hi)
#define SEAM(k) do { if (IN(k) && IN((k) + 1)) xcd_barrier(bar); } while (0)
    LAS unsigned char* ring = F.lds;

#ifndef DBL_MASK
#define DBL_MASK 0
#endif
#ifndef P5_MASK
#define P5_MASK 7
#endif
#ifndef P5_DBL
#define P5_DBL 0
#endif
#define QUEUE_LOOP(word, N, BODY) for (;;) { if (F.tid == 0) F.MISC[0] = __hip_atomic_fetch_add((unsigned*)(F.ctl + (word) + 16384 * args.rpt), 1u, RLX_AGENT); __syncthreads(); \
            const int idx = (int)F.MISC[0]; __syncthreads(); if (idx >= (N)) break; BODY; }
#define PHASE0(rep) { p0_prologue(F, (rep) | args.rpt); }
#define PHASE1(rep) { p1_modnorm(F); }
#define PHASE2(rep) { const int GG = (F.G == 256) ? 256 : F.G;     \
        if ((int)blockIdx.x < GG) { pg8::Gemm g{WSP(const bf16, WS_H), WSP(const bf16, WS_WIN), MROWS, NINP, DM}; pg8::StaticOrder S; S.init(MROWS, NINP, GG, (int)blockIdx.x); \
            EpiIn E{F.out, F.ws}; pg8::gemm_phase<EpiIn, pg8::StaticOrder, true, true>(ring, g, S, E); __syncthreads(); } \
        QUEUE_LOOP(CW_Q5 + 3072 + 64 * (rep), D_TOTAL, p2_deferred_item(F, idx)) }
#define PHASE3X(XX) { SEpiPlain SE{WSP(bf16, WS_PART) + (size_t)(XX) * CROWS * 256, 256}; \
          wave_gemm_tiles<SEpiPlain>(F, WSP(const bf16, WS_CB) + (size_t)(XX) * CB_X, 1024, WSP(const bf16, WS_W1T) + (size_t)(XX) * 256 * 1024, 1024, 65536, 64, 8, 1024, SE); }
#define PHASE3(rep) { PHASE3X(0) PHASE3X(1) \
        QUEUE_LOOP(CW_Q5 + 2048 + 512 * (rep), 128, gla_sample_unit(F, idx >> 2, idx & 3)) \
        QUEUE_LOOP(CW_Q5 + 2048 + 64 + 512 * (rep), 512, gla_pass1_unit(F, idx >> 2, idx & 3)) }
#define PHASE4(rep) { compress_l2(F); gla_pass2(F); }
#define PHASE5(rep) { \
        if (P5_MASK & 1) { QUEUE_LOOP(CW_Q5 + 512 * (rep), 128, nsa_sample_unit(F, idx >> 2, idx & 3)) if (P5_DBL & 1) { QUEUE_LOOP(CW_Q5 + 1024, 128, nsa_sample_unit(F, idx >> 2, idx & 3)) } } \
        if (P5_MASK & 2) { QUEUE_LOOP(CW_Q5 + 64 + 512 * (rep), 512, nsa_prompt_unit(F, 127 - (idx >> 2), idx & 3)) if (P5_DBL & 2) { QUEUE_LOOP(CW_Q5 + 1024 + 64, 512, nsa_prompt_unit(F, 127 - (idx >> 2), idx & 3)) } } \
        if (P5_MASK & 4) { QUEUE_LOOP(CW_Q5 + 128 + 512 * (rep), 512, gla_pass3_unit(F, idx >> 2, idx & 3)) if (P5_DBL & 4) { QUEUE_LOOP(CW_Q5 + 1024 + 128, 512, gla_pass3_unit(F, idx >> 2, idx & 3)) } } }
#define PHASE6(rep) { { SEpiMergeCat SE{WSP(const bf16, WS_MN), WSP(const bf16, WS_MG), WSP(bf16, WS_MERGED)}; wave_gemm_tiles<SEpiMergeCat>(F, WSP(const bf16, WS_OCAT), 2048, WSP(const bf16, WS_WCAT), 2048, TP, 8, 64, 2048, SE); } \
        pg8::Gemm g{WSP(const bf16, WS_OCAT), WSP(const bf16, WS_WCAT), TP, DM, 1024, 2048, 1024}; pg8::StaticOrderZ2 S; S.init(TP, DM, F.G, (int)blockIdx.x); \
        EpiMergeZ E{WSP(const bf16, WS_MN), WSP(const bf16, WS_MG), WSP(bf16, WS_MERGED)}; pg8::gemm_phase<EpiMergeZ, pg8::StaticOrderZ2, true, true>(ring, g, S, E); }
#define PHASE7(rep) { { SEpiOut SE{F.x_s, WSP(const long long, WS_MOD), F.out, WSP(float, WS_RSS)}; wave_gemm_tiles<SEpiOut>(F, WSP(const bf16, WS_MERGED), 2048, WSP(const bf16, WS_WOUT), 2048, TP, 8, 64, 2048, SE); } \
        pg8::Gemm g{WSP(const bf16, WS_MERGED), WSP(const bf16, WS_WOUT), TP, DM, DM}; pg8::StaticOrder S; S.init(TP, DM, F.G, (int)blockIdx.x); \
        EpiOut E{F.x_p, F.x_s, WSP(const long long, WS_MOD), F.out, WSP(float, WS_RSS)}; pg8::gemm_phase<EpiOut, pg8::StaticOrder, true, true>(ring, g, S, E); }
#define PHASE8(rep) { final_norm(F); }
#define RUN(k) do { if (IN(k)) { LOAD_INPUTS(); PHASE##k(0) if ((DBL_MASK >> (k)) & 1) { if (use_bar) xcd_barrier(bar); PHASE##k(1) } } SEAM(k); } while (0)
    RUN(0); RUN(1); RUN(2); RUN(3); RUN(4); RUN(5); RUN(6); RUN(7);
    if (IN(8)) { LOAD_INPUTS(); PHASE8(0) }
#ifdef SELF_CHECK
    if (use_bar) { self_check_kc(F); xcd_barrier(bar); if (blockIdx.x == 0 && F.tid == 0 && __hip_atomic_load((unsigned*)(F.ctl + CW_Q5 + 4096), RLX_AGENT) != 0u) F.out[O_YS] = __builtin_nanf(""); }
#endif
#undef IN
#undef SEAM
}

extern "C" void kernel_launch(void* const* d_in, const int* in_sizes, int n_in, void* d_out, int out_size, void* d_ws, size_t ws_size, hipStream_t stream) {
    static int grid = 0;
    if (grid == 0) {
        if (n_in != 25 || (size_t)out_size != O_TOTAL || ws_size < WS_END) {
            fprintf(stderr, "kernel_launch: built for 25 inputs, %zu outputs, >= %zu bytes of workspace; got n_in %d, out %d, ws %zu; nothing launched\n", (size_t)O_TOTAL, (size_t)WS_END, n_in, out_size, ws_size); grid = -1; return; }
        int dev = 0, cus = 0, per_cu = 0;
        if (hipGetDevice(&dev) != hipSuccess || hipDeviceGetAttribute(&cus, hipDeviceAttributeMultiprocessorCount, dev) != hipSuccess) { fprintf(stderr, "kernel_launch: device query failed\n"); grid = -1; return; }
        if (hipFuncSetAttribute((const void*)nsa_gla_fwd, hipFuncAttributeMaxDynamicSharedMemorySize, LDS_BYTES) != hipSuccess) { fprintf(stderr, "kernel_launch: hipFuncSetAttribute failed\n"); grid = -1; return; }
        if (hipOccupancyMaxActiveBlocksPerMultiprocessor(&per_cu, (const void*)nsa_gla_fwd, NWAVES * 64, LDS_BYTES) != hipSuccess || per_cu < 1)
            fprintf(stderr, "kernel_launch: note: occupancy query reports %d workgroups per CU\n", per_cu);
        (void)hipGetLastError();
        grid = cus;
    }
    if (grid < 0) return;
    if (hipMemsetAsync((char*)d_ws + WS_CTL, 0, CTL_ZERO_BYTES, stream) != hipSuccess || hipMemsetAsync((char*)d_ws + WS_MOD, 0, MOD_BYTES, stream) != hipSuccess) { fprintf(stderr, "kernel_launch: memset failed\n"); return; }
    Args a{};
    for (int i = 0; i < 25; ++i) a.in[i] = d_in[i];
    a.out = (float*)d_out; a.ws = (unsigned char*)d_ws;
#ifndef DBL_LAUNCH
#define DBL_LAUNCH 0
#endif
    int seq[2 * NPH + 4], rp[2 * NPH + 4], ns = 0;
    if (N_LAUNCHES == 1) { seq[ns] = -1; rp[ns++] = 0; }
    else for (int k = 0; k < NPH; ++k) {
        seq[ns] = k; rp[ns++] = 0;
        if ((DBL_LAUNCH >> k) & 1) { if (k == 8) { seq[ns] = k - 1; rp[ns++] = 1; } seq[ns] = k; rp[ns++] = 1; }
    }
    for (int li = 0; li < ns; ++li) {
        if (seq[li] < 0) { a.ph_lo = 0; a.ph_hi = NPH; } else { a.ph_lo = seq[li]; a.ph_hi = seq[li] + 1; }
        a.rpt = rp[li]; a.pad = 0;
        hipLaunchKernelGGL(nsa_gla_fwd, dim3(grid), dim3(NWAVES * 64), LDS_BYTES, stream, a);
        const hipError_t le = hipPeekAtLastError();
        if (le != hipSuccess) { fprintf(stderr, "kernel_launch: launch %d failed: %s\n", li, hipGetErrorName(le)); break; }
    }
}
```

```cpp
#include <hip/hip_runtime.h>
#include <cstdio>
#include <cstdint>
#define MK_N_LAUNCHES 1
namespace pg8 {
#define PG8_LAS __attribute__((address_space(3)))
typedef unsigned short bf16_t;
typedef short bf16x8 __attribute__((ext_vector_type(8)));
typedef float f32x4 __attribute__((ext_vector_type(4)));
typedef unsigned u32x4 __attribute__((ext_vector_type(4)));
constexpr int BM = 256, BK = 64, HALF = 128, HTB = HALF * BK * 2  , STAGE_BYTES = 8 * HTB, NXCD = 8, WGM = 8;

__host__ __device__ __forceinline__ int lds_byte(int r, int c) { const int st = (r >> 4) * 2 + (c >> 5), rr = r & 15, cc = c & 31, ob = rr * 64 + cc * 2; return st * 1024 + (ob ^ (((ob >> 9) & 1) << 5)); }
__host__ __device__ __forceinline__ void stage_rc(int b, int& R, int& C) { const int st = b / 1024, sb = b % 1024, swz = sb ^ (((sb >> 9) & 1) << 5); R = (st >> 1) * 16 + swz / 64; C = (st & 1) * 32 + (swz % 64) / 2; }
__host__ __device__ __forceinline__ int perm32(int rho) { const int n = rho >> 4, i = rho & 15; return 8 * (i >> 2) + 4 * n + (i & 3); }

struct Unit { int pm, pn, z; };
struct Gemm { const bf16_t* A; const bf16_t* Bt; int M, N, K, ld, zoff; };

struct StaticOrder {
    int nM, nN, nwg, G, c;
    __host__ __device__ void init(int M, int N, int G_, int c_) { nM = M / BM; nN = N / BM; nwg = nM * nN; G = G_; c = c_; }
    __host__ __device__ bool next(int i, Unit& u) const {
        const long L = (long)i * G + c; if (L >= nwg) return false;
        int wgid = (int)L; { const int q = nwg / NXCD, r = nwg % NXCD, xcd = wgid % NXCD, off = wgid / NXCD; wgid = (xcd < r ? xcd * (q + 1) : r * (q + 1) + (xcd - r) * q) + off; }
        const int nig = WGM * nN, gid = wgid / nig, fm = gid * WGM, gsz = (nM - fm) < WGM ? (nM - fm) : WGM;
        u.pm = fm + ((wgid % nig) % gsz); u.pn = (wgid % nig) / gsz; u.z = 0; return true;
    }
    __device__ __forceinline__ void a_ready(const Unit&) const {}
    __device__ __forceinline__ void done(const Unit&) const {}
};

struct StaticOrderZ2 {
    StaticOrder so;
    __host__ __device__ void init(int M, int N, int G_, int c_) { so.init(M, N, G_, c_); }
    __host__ __device__ bool next(int i, Unit& u) const { if (!so.next(i >> 1, u)) return false; u.z = i & 1; return true; }
    __device__ __forceinline__ void a_ready(const Unit&) const {}
    __device__ __forceinline__ void done(const Unit&) const {}
};

__device__ __forceinline__ unsigned cvt_pk_bf16(float lo, float hi) { unsigned r; asm volatile("v_cvt_pk_bf16_f32 %0, %1, %2" : "=v"(r) : "v"(lo), "v"(hi)); return r; }
typedef float f32x2 __attribute__((ext_vector_type(2)));

template <class Epi, class Sched, bool ALIGN_EPI = false, bool SP2 = false>
__device__ __forceinline__ void gemm_phase(PG8_LAS unsigned char* lds, const Gemm g, const Sched& S, const Epi& E) {
    const int tid = threadIdx.x, wid = __builtin_amdgcn_readfirstlane(tid >> 6), lane = tid & 63, wr = wid >> 2, wc = wid & 3, fr = lane & 15, fq = lane >> 4;
    const int K = g.K, nt = K / BK, LD = g.ld ? g.ld : K;
    unsigned voffA[2], voffB[2];
#pragma unroll
    for (int i = 0; i < 2; ++i) { int R, C; stage_rc(tid * 16 + i * 8192, R, C); const int Rb = Epi::PERM ? ((R & ~31) + perm32(R & 31)) : R;
        voffA[i] = (unsigned)(R * LD + C) * 2u; voffB[i] = (unsigned)(Rb * LD + C) * 2u; }
    const size_t kstep = (size_t)(BK * 2);
    const size_t hstep = (size_t)HALF * LD * 2;
    const size_t tstep = 2 * hstep;
    const unsigned ldsw = (unsigned)wid * 1024u;
    const int aoff = lds_byte(wr * 64 + fr, fq * 8), boff = lds_byte(wc * 32 + fr, fq * 8);
#define PG8_SA(b, h) (((b) * 2 + (h)) * HTB)
#define PG8_SB(b, h) ((4 + (b) * 2 + (h)) * HTB)
#define PG8_STAGE(bufoff, gbase, voff) do { _Pragma("unroll") for (int _i = 0; _i < 2; ++_i) \
        __builtin_amdgcn_global_load_lds((const unsigned*)((const char*)(gbase) + (voff)[_i]), (PG8_LAS unsigned*)(lds + (bufoff) + ldsw + _i * 8192), 16, 0, 0); } while (0)
#define PG8_LDA(dst, b, h) do { _Pragma("unroll") for (int m = 0; m < 4; ++m) _Pragma("unroll") for (int k = 0; k < 2; ++k) dst[m][k] = *(const PG8_LAS bf16x8*)(lds + PG8_SA(b, h) + aoff + m * 2048 + k * 1024); } while (0)
#define PG8_LDB(dst, b, h) do { _Pragma("unroll") for (int n = 0; n < 2; ++n) _Pragma("unroll") for (int k = 0; k < 2; ++k) dst[n][k] = *(const PG8_LAS bf16x8*)(lds + PG8_SB(b, h) + boff + n * 2048 + k * 1024); } while (0)
#define PG8_MMA(ai, bj, At, Bt) do { __builtin_amdgcn_s_setprio(1); _Pragma("unroll") for (int m = 0; m < 4; ++m) _Pragma("unroll") for (int n = 0; n < 2; ++n) _Pragma("unroll") for (int k = 0; k < 2; ++k) \
        acc[ai][bj][m][n] = __builtin_amdgcn_mfma_f32_16x16x32_bf16(Bt[n][k], At[m][k], acc[ai][bj][m][n], 0, 0, 0); __builtin_amdgcn_s_setprio(0); } while (0)
#define PG8_WAIT_V(n) asm volatile("s_waitcnt vmcnt(" #n ")" ::: "memory")
#define PG8_WAIT_L(n) asm volatile("s_waitcnt lgkmcnt(" #n ")" ::: "memory")
#define PG8_BAR __builtin_amdgcn_s_barrier()
#define PG8_SCHED __builtin_amdgcn_sched_barrier(0)
    Unit cur, nxt; int ui = 0;
    if (!S.next(0, cur)) return;
    f32x4 acc[2][2][4][2];
#pragma unroll
    for (int a = 0; a < 2; ++a)
#pragma unroll
        for (int b = 0; b < 2; ++b)
#pragma unroll
            for (int m = 0; m < 4; ++m)
#pragma unroll
                for (int n = 0; n < 2; ++n) acc[a][b][m][n] = (f32x4){0.f, 0.f, 0.f, 0.f};
    bf16x8 At[4][2], B0[2][2], B1[2][2];
    const char* cA = (const char*)g.A + (size_t)cur.pm * tstep + (size_t)cur.z * g.zoff * 2; const char* cB = (const char*)g.Bt + (size_t)cur.pn * tstep + (size_t)cur.z * g.zoff * 2;
    S.a_ready(cur);
    if constexpr (SP2) {
        PG8_STAGE(PG8_SB(0, 0), cB, voffB); PG8_STAGE(PG8_SB(0, 1), cB + hstep, voffB); PG8_STAGE(PG8_SA(0, 0), cA, voffA); PG8_STAGE(PG8_SA(0, 1), cA + hstep, voffA);
        if (wr == 1) PG8_BAR;
        PG8_WAIT_V(2); PG8_BAR;
        PG8_STAGE(PG8_SB(1, 0), cB + kstep, voffB); PG8_STAGE(PG8_SA(1, 0), cA + kstep, voffA); PG8_STAGE(PG8_SB(1, 1), cB + hstep + kstep, voffB);
        PG8_WAIT_V(6); PG8_BAR;
    } else {
        PG8_STAGE(PG8_SB(0, 0), cB, voffB); PG8_STAGE(PG8_SA(0, 0), cA, voffA); PG8_STAGE(PG8_SB(0, 1), cB + hstep, voffB); PG8_STAGE(PG8_SA(0, 1), cA + hstep, voffA);
        if (wr == 1) PG8_BAR;
        PG8_WAIT_V(4); PG8_BAR;
        PG8_STAGE(PG8_SB(1, 0), cB + kstep, voffB); PG8_STAGE(PG8_SA(1, 0), cA + kstep, voffA); PG8_STAGE(PG8_SB(1, 1), cB + hstep + kstep, voffB);
        PG8_WAIT_V(6); PG8_BAR;
    }
    for (;;) {
        const bool has_next = S.next(ui + 1, nxt);
        const char* nA = has_next ? (const char*)g.A + (size_t)nxt.pm * tstep + (size_t)nxt.z * g.zoff * 2 : cA; const char* nB = has_next ? (const char*)g.Bt + (size_t)nxt.pn * tstep + (size_t)nxt.z * g.zoff * 2 : cB;
        for (int t = 0; t < nt; t += 2) {
            const bool last = (t == nt - 2);
            const char* a1 = cA + (size_t)(t + 1) * kstep;
            const char* a2 = last ? nA : cA + (size_t)(t + 2) * kstep; const char* b2 = last ? nB : cB + (size_t)(t + 2) * kstep;
            const char* a3 = a2 + kstep; const char* b3 = b2 + kstep;
            if (last && has_next) S.a_ready(nxt);
            if constexpr (SP2) {
            PG8_LDB(B0, 0, 0); PG8_LDB(B1, 0, 1); PG8_SCHED; PG8_LDA(At, 0, 0); PG8_STAGE(PG8_SA(1, 1), a1 + hstep, voffA);
            PG8_WAIT_V(8); PG8_WAIT_L(0); PG8_BAR; PG8_MMA(0, 0, At, B0); PG8_MMA(0, 1, At, B1); PG8_BAR; PG8_SCHED;
            PG8_LDA(At, 0, 1); PG8_STAGE(PG8_SB(0, 0), b2, voffB); PG8_STAGE(PG8_SB(0, 1), b2 + hstep, voffB); PG8_STAGE(PG8_SA(0, 0), a2, voffA);
            PG8_WAIT_V(8); PG8_WAIT_L(0); PG8_BAR; PG8_MMA(1, 0, At, B0); PG8_MMA(1, 1, At, B1); PG8_BAR; PG8_SCHED;
            PG8_LDB(B0, 1, 0); PG8_LDB(B1, 1, 1); PG8_SCHED; PG8_LDA(At, 1, 0); PG8_STAGE(PG8_SA(0, 1), a2 + hstep, voffA);
            PG8_WAIT_V(8); PG8_WAIT_L(0); PG8_BAR; PG8_MMA(0, 0, At, B0); PG8_MMA(0, 1, At, B1); PG8_BAR; PG8_SCHED;
            PG8_LDA(At, 1, 1); PG8_STAGE(PG8_SB(1, 0), b3, voffB); PG8_STAGE(PG8_SB(1, 1), b3 + hstep, voffB); PG8_STAGE(PG8_SA(1, 0), a3, voffA);
            PG8_WAIT_V(8); PG8_WAIT_L(0); PG8_BAR; PG8_MMA(1, 0, At, B0); PG8_MMA(1, 1, At, B1); PG8_BAR; PG8_SCHED;
            } else {
            PG8_LDB(B0, 0, 0); PG8_SCHED; PG8_LDA(At, 0, 0); PG8_STAGE(PG8_SA(1, 1), a1 + hstep, voffA);
            PG8_WAIT_L(8); PG8_BAR; PG8_WAIT_L(0); PG8_MMA(0, 0, At, B0); PG8_BAR; PG8_SCHED;
            PG8_LDB(B1, 0, 1); PG8_STAGE(PG8_SB(0, 0), b2, voffB);
            PG8_BAR; PG8_WAIT_L(0); PG8_MMA(0, 1, At, B1); PG8_BAR;
            PG8_LDA(At, 0, 1); PG8_STAGE(PG8_SA(0, 0), a2, voffA);
            PG8_BAR; PG8_WAIT_L(0); PG8_MMA(1, 0, At, B0); PG8_BAR; PG8_SCHED;
            PG8_STAGE(PG8_SB(0, 1), b2 + hstep, voffB);
            PG8_WAIT_V(6); PG8_BAR; PG8_MMA(1, 1, At, B1); PG8_BAR;
            PG8_LDB(B0, 1, 0); PG8_SCHED; PG8_LDA(At, 1, 0); PG8_STAGE(PG8_SA(0, 1), a2 + hstep, voffA);
            PG8_WAIT_L(8); PG8_BAR; PG8_WAIT_L(0); PG8_MMA(0, 0, At, B0); PG8_BAR; PG8_SCHED;
            PG8_LDB(B1, 1, 1); PG8_STAGE(PG8_SB(1, 0), b3, voffB);
            PG8_BAR; PG8_WAIT_L(0); PG8_MMA(0, 1, At, B1); PG8_BAR;
            PG8_LDA(At, 1, 1); PG8_STAGE(PG8_SA(1, 0), a3, voffA);
            PG8_BAR; PG8_WAIT_L(0); PG8_MMA(1, 0, At, B0); PG8_BAR; PG8_SCHED;
            PG8_STAGE(PG8_SB(1, 1), b3 + hstep, voffB);
            PG8_WAIT_V(6); PG8_BAR; PG8_MMA(1, 1, At, B1); PG8_BAR;
            }
        }
        if constexpr (ALIGN_EPI) { if (wr == 0) PG8_BAR; }
        if constexpr (!Epi::AFTER_DRAIN) { E(acc, cur, wr, wc, fr, fq); S.done(cur); }
        if (!has_next) break;
#pragma unroll
        for (int a = 0; a < 2; ++a)
#pragma unroll
            for (int b = 0; b < 2; ++b)
#pragma unroll
                for (int m = 0; m < 4; ++m)
#pragma unroll
                    for (int n = 0; n < 2; ++n) acc[a][b][m][n] = (f32x4){0.f, 0.f, 0.f, 0.f};
        cur = nxt; cA = nA; cB = nB; ++ui;
        if constexpr (ALIGN_EPI) { if (wr == 1) PG8_BAR; }
    }
    PG8_WAIT_V(0);
    if constexpr (!ALIGN_EPI) { if (wr == 0) PG8_BAR; }
    PG8_BAR;
    if constexpr (Epi::AFTER_DRAIN) { E.fused(acc, cur, wr, wc, fr, fq, lds, wid, lane); S.done(cur); }
#undef PG8_SA
#undef PG8_SB
#undef PG8_STAGE
#undef PG8_LDA
#undef PG8_LDB
#undef PG8_MMA
#undef PG8_WAIT_V
#undef PG8_WAIT_L
#undef PG8_BAR
#undef PG8_SCHED
}
}

constexpr int NWAVES = 8;
constexpr int DM = 2048, TP = 8192, TS = 256, MROWS = TP + TS, NINP = 11008, NMOD = 6144;
constexpr int NBATCH_S = 32, TSEQ_S = 8, NPAGE = 64;
constexpr float QSCALE = 0.125f * 1.4426950408889634f;
constexpr float GQSCALE = 0.08838834764831845f;
constexpr size_t O_YP = 0, O_YS = 16777216, O_CMPP = 17301504, O_CMPS = 21495808, O_SELP = 21626880, O_SELS = 25821184,
                 O_WINP = 25952256, O_WINS = 26214400, O_STP = 34603008, O_STS = 34734080, O_TOTAL = 38928384;
constexpr size_t MiB = 1u << 20;
constexpr size_t WS_CTL = 0, CTL_ZERO_BYTES = 1 * MiB;
constexpr size_t WS_MOD = 786 * MiB;
constexpr size_t MOD_BYTES = (size_t)33 * 6144 * 8;
constexpr float MOD_SCALE = 4294967296.f, MOD_INV = 1.f / 4294967296.f;
constexpr size_t WS_ROPE = 2 * MiB;
constexpr size_t WS_POSB = 5 * MiB;
constexpr size_t WS_W1T = 6 * MiB;
constexpr size_t WS_WIN = 7 * MiB;
constexpr size_t WS_WCAT = 50 * MiB, WS_WOUT = 58 * MiB;
constexpr size_t WS_H = 66 * MiB;
constexpr size_t WS_QB = 99 * MiB;
constexpr size_t WS_KVB = 116 * MiB;
constexpr size_t WS_CB = 132 * MiB;
constexpr size_t CB_X = (size_t)33 * 4 * 8192 * 64;
constexpr size_t WS_PART = 397 * MiB;
constexpr int CROWS = 33 * 4 * 512;
constexpr size_t WS_KC = 464 * MiB;
constexpr size_t WS_ZN = 481 * MiB, WS_ZG = 498 * MiB;
constexpr size_t WS_MN = 515 * MiB, WS_MG = 548 * MiB;
constexpr size_t WS_QG = 581 * MiB, WS_KG = 590 * MiB;
constexpr size_t WS_VGT = 599 * MiB;
constexpr size_t WS_VGS = 615 * MiB;
constexpr size_t WS_AG = 616 * MiB;
constexpr size_t WS_GB = 617 * MiB;
constexpr size_t WS_LT = 619 * MiB;
constexpr size_t WS_DC = 683 * MiB;
constexpr size_t WS_ST = 684 * MiB;
constexpr size_t WS_OCAT = 716 * MiB;
constexpr size_t WS_MERGED = 750 * MiB;
constexpr size_t WS_RSS = 783 * MiB;
constexpr size_t WS_END = 788 * MiB;
constexpr int CW_BAR = 4096;
constexpr int CW_Q5 = 8192;
constexpr int RING_BYTES = 131072;
constexpr int LDSCTL_OFF = RING_BYTES;
constexpr int LDS_BYTES = 147456;

constexpr int KTLD = 72;
#define GAS __attribute__((address_space(1)))
#define LAS __attribute__((address_space(3)))
typedef unsigned short bf16;
typedef short bf16x8 __attribute__((ext_vector_type(8)));
typedef short s16x4 __attribute__((ext_vector_type(4)));
typedef float f32x4 __attribute__((ext_vector_type(4)));
typedef float f32x2 __attribute__((ext_vector_type(2)));
typedef float f32x16 __attribute__((ext_vector_type(16)));
typedef unsigned u32x4 __attribute__((ext_vector_type(4)));
typedef unsigned u32x2 __attribute__((ext_vector_type(2)));
typedef GAS unsigned gu32;
#define RLX_AGENT __ATOMIC_RELAXED, __HIP_MEMORY_SCOPE_AGENT
#define LDS_WAIT() asm volatile("s_waitcnt lgkmcnt(0)" ::: "memory")

__device__ __forceinline__ unsigned f2bf(float f) { unsigned u = __builtin_bit_cast(unsigned, f); return (u + 0x7fffu + ((u >> 16) & 1u)) >> 16; }
__device__ __forceinline__ unsigned pk2(float lo, float hi) { return f2bf(lo) | (f2bf(hi) << 16); }
__device__ __forceinline__ u32x4 pack8(const f32x4 a, const f32x4 b) { u32x4 o; o.x = pk2(a.x, a.y); o.y = pk2(a.z, a.w); o.z = pk2(b.x, b.y); o.w = pk2(b.z, b.w); return o; }
__device__ __forceinline__ u32x2 pack4(const f32x4 a) { u32x2 o; o.x = pk2(a.x, a.y); o.y = pk2(a.z, a.w); return o; }
__device__ __forceinline__ float bf2f(unsigned b) { return __builtin_bit_cast(float, b << 16); }
__device__ __forceinline__ float bflo(unsigned w) { return __builtin_bit_cast(float, w << 16); }
__device__ __forceinline__ float bfhi(unsigned w) { return __builtin_bit_cast(float, w & 0xffff0000u); }
__device__ __forceinline__ float sigm(float x) { return 1.f / (1.f + __expf(-x)); }
__device__ __forceinline__ float silu(float x) { return x / (1.f + __expf(-x)); }
__device__ __forceinline__ float ex2(float x) { return __builtin_amdgcn_exp2f(x); }
__device__ __forceinline__ float wave_sum(float v) {
#pragma unroll
    for (int o = 1; o < 64; o <<= 1) v += __shfl_xor(v, o);
    return v;
}
#define XB_TMO      128
#define XB_XCNT(j)  (256  + 64 * (j))
#define XB_XSUB(j)  (1280 + 64 * (j))
#define XB_XGEN(j)  (2304 + 64 * (j))
#define XB_TOP      3328
#define XB_TOPGEN   3392
#define XCD_BAR_WORDS 3456
#define XB_SPIN_CAP (1u << 18)

__device__ __forceinline__ unsigned xb_ld(unsigned* p)              { return __hip_atomic_load(p, __ATOMIC_RELAXED, __HIP_MEMORY_SCOPE_AGENT); }
__device__ __forceinline__ unsigned xb_add(unsigned* p, unsigned v) { return __hip_atomic_fetch_add(p, v, __ATOMIC_RELAXED, __HIP_MEMORY_SCOPE_AGENT); }
__device__ __forceinline__ unsigned xb_xcc_id() { return (unsigned)__builtin_amdgcn_s_getreg((3 << 11) | 20) & 0xFu; }
#define XB_SPIN(cond, bar) do { unsigned _sp = 0; while (cond) { __builtin_amdgcn_s_sleep(1); \
    if ((++_sp & 255u) == 0u) { if (xb_ld(&(bar)[XB_TMO])) break; if (_sp > XB_SPIN_CAP) { atomicAdd(&(bar)[XB_TMO], 1u); break; } } } } while (0)

struct XcdBarrier {
    unsigned* bar; unsigned x;
    volatile LAS unsigned* st;
};

__device__ __forceinline__ XcdBarrier xcd_barrier_post(unsigned* bar, volatile LAS unsigned* st) {
    XcdBarrier b; b.bar = bar; b.x = xb_xcc_id(); b.st = st;
    if (threadIdx.x == 0) (void)xb_add(&bar[XB_XCNT(b.x)], 1u);
    return b;
}
__device__ __forceinline__ void xcd_barrier_complete(unsigned* bar, unsigned x, unsigned& nloc, unsigned& nx) {
    const unsigned G = gridDim.x * gridDim.y * gridDim.z;
    unsigned sum, cnt, mine, sp = 0u;
    for (;;) {
        sum = 0u; cnt = 0u; mine = 0u;
#pragma unroll
        for (unsigned j = 0; j < 16; ++j) { const unsigned c = xb_ld(&bar[XB_XCNT(j)]); sum += c; cnt += (c > 0u) ? 1u : 0u; mine = (j == x) ? c : mine; }
        if (sum == G) break;
        __builtin_amdgcn_s_sleep(1);
        if ((++sp & 255u) == 0u) { if (xb_ld(&bar[XB_TMO])) break; if (sp > XB_SPIN_CAP) { atomicAdd(&bar[XB_TMO], 1u); break; } }
    }
    nloc = mine > 0u ? mine : 1u; nx = cnt > 0u ? cnt : 1u;
}

__device__ __forceinline__ void xcd_barrier(const XcdBarrier& b) {
    asm volatile("s_waitcnt vmcnt(0)" ::: "memory");
    __syncthreads();
    if (threadIdx.x == 0) {
        unsigned* bar = b.bar;
        __builtin_amdgcn_s_waitcnt(0);
        unsigned nloc = b.st[0], nx = b.st[1];
        if (nloc == 0u) { xcd_barrier_complete(bar, b.x, nloc, nx); b.st[0] = nloc; b.st[1] = nx; }
        const unsigned old = xb_add(&bar[XB_XSUB(b.x)], 1u);
        const unsigned gen = old / nloc;
        if (old + 1u == (gen + 1u) * nloc) {
            __builtin_amdgcn_fence(__ATOMIC_RELEASE, "agent");
            asm volatile("s_waitcnt vmcnt(0)" ::: "memory");
            const unsigned og = xb_add(&bar[XB_TOP], 1u);
            const unsigned tg = og / nx;
            if (og + 1u == (tg + 1u) * nx) xb_add(&bar[XB_TOPGEN], 1u);
            else XB_SPIN(xb_ld(&bar[XB_TOPGEN]) == tg, bar);
            __builtin_amdgcn_fence(__ATOMIC_ACQUIRE, "agent");
            xb_add(&bar[XB_XGEN(b.x)], 1u);
            asm volatile("s_waitcnt vmcnt(0)" ::: "memory");
        } else {
            XB_SPIN(xb_ld(&bar[XB_XGEN(b.x)]) == gen, bar);
            __builtin_amdgcn_fence(__ATOMIC_ACQUIRE, "agent");
            asm volatile("s_waitcnt vmcnt(0)" ::: "memory");
        }
    }
    __syncthreads();
}

struct Frame {
    LAS unsigned char* lds;
    volatile LAS unsigned* MISC;
    gu32* ctl;
    int tid, lane, wave, G, gw, NGW;
    const float *x_p, *x_s, *c_cmp, *c_sel, *c_win, *state, *c_p, *c_s, *norm_w, *w_ada, *b_ada, *w_in, *cmp_pos, *cmp_w1, *cmp_b1, *cmp_w2, *cmp_b2,
                *w_a2, *b_a, *gnw, *w_on, *w_og, *w_out, *fnw;
    const int* ptab;
    float* out;
    unsigned char* ws;
};
#define WSP(T, off) ((T*)(F.ws + (off)))

__device__ __forceinline__ int ropeperm(int pp) { const int j8 = pp >> 3, e = pp & 7; return e < 4 ? 4 * j8 + e : 32 + 4 * j8 + (e - 4); }
__device__ __forceinline__ int in_col(int n) {
    const int tile = n >> 8, pc = n & 255;
    if (tile < 4) return (tile * 4 + (pc >> 6)) * 64 + ropeperm(pc & 63);
    if (tile < 10) { const int t = tile - 4, br = t >> 1, x = t & 1, pp = pc & 63; return 1024 + br * 512 + x * 256 + (pc >> 6) * 64 + (x == 0 ? ropeperm(pp) : pp); }
    if (tile < 14) return 2608 + (n - 10 * 256);
    if (tile < 16) return 3632 + (n - 14 * 256);
    if (tile < 18) return 4144 + (n - 16 * 256);
    if (tile < 22) return 4656 + (n - 18 * 256);
    if (tile < 26) return 5696 + (n - 22 * 256);
    if (tile < 34) return 6720 + (n - 26 * 256);
    if (tile < 42) return 8768 + (n - 34 * 256);
    if (pc < 48) return 2560 + pc;
    if (pc < 64) return 5680 + (pc - 48);
    return -1;
}
template <bool MAPPED>
__device__ __forceinline__ void transpose_item(const float* __restrict__ W, int ldw, int K, bf16* WT, int row_off, LAS float* scr, int k0, int n0, int lane) {
    int col = n0 + (lane & 31);
    if (MAPPED) col = in_col(col);
#pragma unroll 8
    for (int i = 0; i < 32; ++i) { const int kk = 2 * i + (lane >> 5); scr[kk * 33 + (lane & 31)] = (col >= 0) ? W[(size_t)(k0 + kk) * ldw + col] : 0.f; }
    LDS_WAIT(); asm volatile("" ::: "memory");
    const int c = lane & 7;
#pragma unroll
    for (int j = 0; j < 4; ++j) { const int n = (lane >> 3) + 8 * j; const LAS float* s = scr + (8 * c) * 33 + n;
        u32x4 o; o.x = pk2(s[0 * 33], s[1 * 33]); o.y = pk2(s[2 * 33], s[3 * 33]); o.z = pk2(s[4 * 33], s[5 * 33]); o.w = pk2(s[6 * 33], s[7 * 33]);
        *(u32x4*)(WT + (size_t)(row_off + n0 + n) * K + k0 + 8 * c) = o; }
    LDS_WAIT(); asm volatile("" ::: "memory");
}
template <bool MAPPED>
__device__ __forceinline__ void transpose_item_wide(const float* __restrict__ W, int ldw, int K, bf16* WT, LAS float* scr, int k0, int n0, int lane) {
    const int col = MAPPED ? in_col(n0 + 4 * (lane & 15)) : n0 + 4 * (lane & 15);
#pragma unroll
    for (int i = 0; i < 8; ++i) { const int kk = 4 * i + (lane >> 4);
        const f32x4 v = (col >= 0) ? *(const f32x4*)(W + (size_t)(k0 + kk) * ldw + col) : (f32x4){0.f, 0.f, 0.f, 0.f};
        *(LAS f32x4*)(scr + kk * 68 + 4 * (lane & 15)) = v; }
    LDS_WAIT(); asm volatile("" ::: "memory");
#pragma unroll
    for (int j = 0; j < 4; ++j) { const int pr = j * 64 + lane, n = pr >> 2, kg = pr & 3; const LAS float* sp = scr + (8 * kg) * 68 + n;
        u32x4 o; o.x = pk2(sp[0 * 68], sp[1 * 68]); o.y = pk2(sp[2 * 68], sp[3 * 68]); o.z = pk2(sp[4 * 68], sp[5 * 68]); o.w = pk2(sp[6 * 68], sp[7 * 68]);
        *(u32x4*)(WT + (size_t)(n0 + n) * K + k0 + 8 * kg) = o; }
    LDS_WAIT(); asm volatile("" ::: "memory");
}
__device__ const float INVF[32] = {1.000000000e+00f, 7.498942018e-01f, 5.623413324e-01f, 4.216965139e-01f, 3.162277639e-01f, 2.371373773e-01f, 1.778279394e-01f, 1.333521456e-01f,
    1.000000015e-01f, 7.498942316e-02f, 5.623413250e-02f, 4.216964915e-02f, 3.162277490e-02f, 2.371373773e-02f, 1.778279431e-02f, 1.333521400e-02f,
    9.999999776e-03f, 7.498942316e-03f, 5.623413250e-03f, 4.216964822e-03f, 3.162277630e-03f, 2.371373819e-03f, 1.778279431e-03f, 1.333521446e-03f,
    1.000000047e-03f, 7.498941850e-04f, 5.623413017e-04f, 4.216965172e-04f, 3.162277571e-04f, 2.371373703e-04f, 1.778279402e-04f, 1.333521504e-04f};
__device__ __forceinline__ void sincos_acc(float a, float& s, float& c) {
    const double x = (double)a;
    const double kq = __builtin_rint(x * 0.63661977236758134308);
    double r = __builtin_fma(-kq, 1.5707963267948966192, x); r = __builtin_fma(-kq, 6.123233995736766e-17, r);
    const int q = ((int)kq) & 3;
    const double z = r * r;
    double sp = 1.0 / 6227020800.0; sp = sp * z - 1.0 / 39916800.0; sp = sp * z + 1.0 / 362880.0; sp = sp * z - 1.0 / 5040.0; sp = sp * z + 1.0 / 120.0; sp = sp * z - 1.0 / 6.0; sp = sp * z + 1.0; sp *= r;
    double cp = 1.0 / 479001600.0; cp = cp * z - 1.0 / 3628800.0; cp = cp * z + 1.0 / 40320.0; cp = cp * z - 1.0 / 720.0; cp = cp * z + 1.0 / 24.0; cp = cp * z - 0.5; cp = cp * z + 1.0;
    const double ss = (q == 0) ? sp : (q == 1) ? cp : (q == 2) ? -sp : -cp;
    const double cc = (q == 0) ? cp : (q == 1) ? -sp : (q == 2) ? -cp : sp;
    s = (float)ss; c = (float)cc;
}

__device__ __forceinline__ void p0_prologue(Frame& F, const int rep) {
    LAS float* scr = (LAS float*)(F.lds + F.wave * 16384);
    const int lane = F.lane;
    constexpr int I_IN = 64 * 172;
    for (int it = F.gw; it < I_IN; it += F.NGW) transpose_item_wide<true>(F.w_in, 10816, 2048, WSP(bf16, WS_WIN), scr, 32 * (it / 172), 64 * (it % 172), lane);
    for (int r = F.gw; r < 4 * 16 * 4 + 2 * 2 * 2; r += F.NGW) {
        if (r < 256) { const int xj = r / 64, rr = r % 64;
            transpose_item<false>(F.cmp_w1 + (size_t)xj * 1024 * 128, 128, 1024, WSP(bf16, WS_W1T) + (size_t)(xj >> 1) * 256 * 1024, (xj & 1) * 128, scr, 64 * (rr / 4), 32 * (rr % 4), lane); }
        else { const int x = (r - 256) / 4, rr = (r - 256) % 4;
            transpose_item<false>(F.cmp_w2 + (size_t)x * 128 * 64, 64, 128, WSP(bf16, WS_POSB + 4096) + (size_t)x * 64 * 128, 0, scr, 64 * (rr / 2), 32 * (rr % 2), lane); }
    }
    for (int it = F.gw; it < 256; it += F.NGW) {
        const int x = it >> 7, e = it & 127; float s = 0.f;
        for (int i = 0; i < 32; ++i) { const int ld = i * 64 + lane; s += F.cmp_pos[x * 2048 + ld] * F.cmp_w1[((size_t)x * 2048 + ld) * 128 + e]; }
        s = wave_sum(s);
        if (lane == 0) WSP(float, WS_POSB)[it] = s + F.cmp_b1[it];
    }
    for (int i = F.gw * 64 + lane; i < 8200 * 32; i += F.NGW * 64) {
        const int pos = i >> 5, j = i & 31; const float ang = (float)pos * INVF[j]; float s, c; sincos_acc(ang, s, c);
        WSP(float, WS_ROPE)[pos * 64 + j] = c; WSP(float, WS_ROPE)[pos * 64 + 32 + j] = s;
    }
    for (int item = blockIdx.x; item < (rep ? 0 : 256); item += F.G) {
        const int cg = item & 31, ks = item >> 5;
        LAS float* cl = (LAS float*)(F.lds);
        LAS float* accl = (LAS float*)(F.lds + 33 * 256 * 4);
        __syncthreads();
        for (int i = F.tid; i < 33 * 256; i += 512) { const int r = i >> 8, kk = i & 255; cl[i] = (r == 0) ? F.c_p[ks * 256 + kk] : F.c_s[(r - 1) * 2048 + ks * 256 + kk]; }
        for (int i = F.tid; i < 33 * 192; i += 512) accl[i] = 0.f;
        __syncthreads();
#pragma unroll 1
        for (int g3 = 0; g3 < 3; ++g3) {
            f32x4 acc[11];
#pragma unroll
            for (int r = 0; r < 11; ++r) acc[r] = (f32x4){0.f, 0.f, 0.f, 0.f};
            if (lane < 48) {
                const float* wp = F.w_ada + (size_t)(ks * 256 + F.wave * 32) * NMOD + cg * 192 + lane * 4;
                const LAS float* clg = cl + g3 * 11 * 256 + F.wave * 32;
#pragma unroll 1
                for (int kk0 = 0; kk0 < 32; kk0 += 8) {
                    f32x4 w[8];
#pragma unroll
                    for (int j = 0; j < 8; ++j) w[j] = *(const f32x4*)(wp + (size_t)(kk0 + j) * NMOD);
#pragma unroll
                    for (int j = 0; j < 8; ++j)
#pragma unroll
                        for (int r = 0; r < 11; ++r) acc[r] += w[j] * clg[r * 256 + kk0 + j];
                }
            }
#pragma unroll 1
            for (int ww = 0; ww < 8; ++ww) {
                if (F.wave == ww && lane < 48) {
#pragma unroll
                    for (int r = 0; r < 11; ++r) { LAS f32x4* a = (LAS f32x4*)(accl + (g3 * 11 + r) * 192 + lane * 4); *a = *a + acc[r]; }
                }
                __syncthreads();
            }
        }
        for (int i = F.tid; i < 33 * 192; i += 512) { const int r = i / 192, cc = i % 192;
            const float v = accl[i] + ((ks == 0) ? F.b_ada[cg * 192 + cc] : 0.f);
            atomicAdd(WSP(unsigned long long, WS_MOD) + (size_t)r * NMOD + cg * 192 + cc, (unsigned long long)(long long)__builtin_rintf(v * MOD_SCALE)); }
        __syncthreads();
    }
}

constexpr int D_CMP = NBATCH_S * 2 * 8;
constexpr int D_TR_W = 2 * 32 * 32 + 64 * 32;
constexpr int D_TR = D_TR_W / 8;
constexpr int D_WIN = (NBATCH_S * 504 * 128) / 4096;
constexpr int D_TOTAL = D_CMP + D_TR + D_WIN;
static_assert((NBATCH_S * 504 * 128) % 4096 == 0 && D_TR_W % 8 == 0, "deferred items");
__device__ __forceinline__ void compress_sample_unit(Frame& F, int idx) {
    const int tid = F.tid, lane = F.lane, w = F.wave, c = lane & 31, h = lane >> 5;
    const int b = idx >> 4, x = (idx >> 3) & 1, pj = (idx & 7) * 8 + w;
    const int page = F.ptab[b * NPAGE + pj];
    LAS bf16* Bs = (LAS bf16*)F.lds;
    LAS bf16* As = (LAS bf16*)(F.lds + 73728) + w * 32 * KTLD;
    const bf16* W = WSP(bf16, WS_W1T) + (size_t)x * 256 * 1024 + (size_t)(tid >> 1) * 1024 + (tid & 1) * 32;
    const float* ap = F.c_cmp + (size_t)page * 128 * 512 + x * 256 + lane * 4;
    const int ast = (lane >> 4) * KTLD + (lane & 15) * 4;
    const int bst = (tid >> 1) * KTLD + (tid & 1) * 32;
    f32x16 acc[8];
#pragma unroll
    for (int nt = 0; nt < 8; ++nt)
#pragma unroll
        for (int r = 0; r < 16; ++r) acc[nt][r] = 0.f;
    u32x4 breg[4]; f32x4 areg[8];
#pragma unroll
    for (int i = 0; i < 4; ++i) breg[i] = *(const u32x4*)(W + 8 * i);
#pragma unroll
    for (int i = 0; i < 8; ++i) areg[i] = *(const f32x4*)(ap + (size_t)(16 * i) * 512);
#pragma unroll 1
    for (int s = 0; s < 16; ++s) {
        LAS bf16* Bb = Bs + (s & 1) * 256 * KTLD;
        asm volatile("" ::: "memory");
#pragma unroll
        for (int i = 0; i < 4; ++i) *(LAS u32x4*)(Bb + bst + 8 * i) = breg[i];
#pragma unroll
        for (int i = 0; i < 8; ++i) *(LAS u32x2*)(As + 4 * i * KTLD + ast) = pack4(areg[i]);
        asm volatile("" ::: "memory");
        __syncthreads();
        if (s + 1 < 16) {
#pragma unroll
            for (int i = 0; i < 4; ++i) breg[i] = *(const u32x4*)(W + 64 * (s + 1) + 8 * i);
#pragma unroll
            for (int i = 0; i < 8; ++i) areg[i] = *(const f32x4*)(ap + (size_t)(16 * i + s + 1) * 512);
        }
#pragma unroll
        for (int ks = 0; ks < 4; ++ks) {
            const bf16x8 af = *(const LAS bf16x8*)(As + c * KTLD + 16 * ks + 8 * h);
#pragma unroll
            for (int nt = 0; nt < 8; ++nt) { const bf16x8 bv = *(const LAS bf16x8*)(Bb + (32 * nt + c) * KTLD + 16 * ks + 8 * h); acc[nt] = __builtin_amdgcn_mfma_f32_32x32x16_bf16(af, bv, acc[nt], 0, 0, 0); }
        }
    }
    bf16* PART = WSP(bf16, WS_PART) + (size_t)x * CROWS * 256;
#pragma unroll
    for (int nt = 0; nt < 8; ++nt)
#pragma unroll
        for (int r = 0; r < 16; ++r) { const int m = (r & 3) + 8 * (r >> 2) + 4 * h; const size_t row = (size_t)(b * 4 + (m & 3)) * 512 + pj * 8 + (m >> 2);
            PART[row * 256 + 32 * nt + c] = (bf16)f2bf(acc[nt][r]); }
    __syncthreads();
}
__device__ __forceinline__ void p2_deferred_item(Frame& F, int item) {
    const int lane = F.lane;
    if (item < D_CMP) { compress_sample_unit(F, item); return; }
    item -= D_CMP;
    if (item < D_TR) {
        LAS float* scr = (LAS float*)(F.lds + F.wave * 16384);
        constexpr int I_ON = 32 * 32;
        int r = item * 8 + F.wave;
        if (r < I_ON) { transpose_item_wide<false>(F.w_on, 2048, 2048, WSP(bf16, WS_WCAT), scr, 32 * (r / 32), 64 * (r % 32), lane); return; } r -= I_ON;
        if (r < I_ON) { transpose_item_wide<false>(F.w_og, 2048, 2048, WSP(bf16, WS_WCAT) + 1024, scr, 32 * (r / 32), 64 * (r % 32), lane); return; } r -= I_ON;
        transpose_item_wide<false>(F.w_out, 2048, 2048, WSP(bf16, WS_WOUT), scr, 32 * (r / 32), 64 * (r % 32), lane);
        return;
    }
    item -= D_TR;
    {
        const f32x4* src = (const f32x4*)F.c_win; f32x4* dst = (f32x4*)(F.out + O_WINS);
        f32x4 v[8]; size_t di[8];
#pragma unroll
        for (int j = 0; j < 8; ++j) { const int i = item * 4096 + j * 512 + F.tid; const int b = i / (504 * 128), o = i % (504 * 128);
            di[j] = (size_t)b * 512 * 128 + o; v[j] = src[di[j] + 8 * 128]; }
#pragma unroll
        for (int j = 0; j < 8; ++j) dst[di[j]] = v[j];
    }
}

__device__ __forceinline__ void p1_modnorm(Frame& F) {
    const long long* MOD = WSP(long long, WS_MOD);
    bf16* H = WSP(bf16, WS_H);
    for (int r = F.gw; r < MROWS; r += F.NGW) {
        const float* xr = (r < TP) ? F.x_p + (size_t)r * DM : F.x_s + (size_t)(r - TP) * DM;
        const long long* mr = MOD + (size_t)((r < TP) ? 0 : 1 + ((r - TP) >> 3)) * NMOD;
        f32x4 v[8]; float ss = 0.f;
#pragma unroll
        for (int j = 0; j < 8; ++j) { v[j] = *(const f32x4*)(xr + (j * 64 + F.lane) * 4); ss += (v[j].x * v[j].x + v[j].y * v[j].y) + (v[j].z * v[j].z + v[j].w * v[j].w); }
        const float rstd = 1.f / sqrtf(wave_sum(ss) * (1.f / DM) + 1e-6f);
#pragma unroll
        for (int j = 0; j < 8; ++j) {
            const int c = (j * 64 + F.lane) * 4;
            const f32x4 nw = *(const f32x4*)(F.norm_w + c);
            const f32x4 sh = (f32x4){(float)mr[c], (float)mr[c + 1], (float)mr[c + 2], (float)mr[c + 3]} * MOD_INV;
            const f32x4 sc = (f32x4){(float)mr[2048 + c], (float)mr[2048 + c + 1], (float)mr[2048 + c + 2], (float)mr[2048 + c + 3]} * MOD_INV;
            const f32x4 hv = (v[j] * rstd) * nw * (sc + 1.0f) + sh;
            u32x2 o; o.x = pk2(hv.x, hv.y); o.y = pk2(hv.z, hv.w);
            *(u32x2*)(H + (size_t)r * DM + c) = o;
        }
    }
}


struct EpiPlainBf16 {
    static constexpr bool PERM = true, AFTER_DRAIN = false;
    bf16* O; int ldc;
    __device__ __forceinline__ void operator()(const f32x4 (&acc)[2][2][4][2], const pg8::Unit& u, int wr, int wc, int fr, int fq) const {
#pragma unroll
        for (int ai = 0; ai < 2; ++ai)
#pragma unroll
            for (int m = 0; m < 4; ++m) { const size_t row = (size_t)u.pm * 256 + ai * 128 + wr * 64 + m * 16 + fr;
#pragma unroll
                for (int bj = 0; bj < 2; ++bj) { const int col = u.pn * 256 + bj * 128 + wc * 32 + fq * 8;
                    *(u32x4*)(O + row * ldc + col) = pack8(acc[ai][bj][m][0], acc[ai][bj][m][1]); } }
    }
};

struct EpiIn {
    static constexpr bool PERM = true, AFTER_DRAIN = false;
    float* out; unsigned char* ws;
    __device__ __forceinline__ void operator()(const f32x4 (&acc)[2][2][4][2], const pg8::Unit& u, int wr, int wc, int fr, int fq) const {
        const int tile = u.pn;
        const float* ROPE = (const float*)(ws + WS_ROPE);
#pragma unroll
        for (int ai = 0; ai < 2; ++ai)
#pragma unroll
            for (int m = 0; m < 4; ++m) {
                const int row = u.pm * 256 + ai * 128 + wr * 64 + m * 16 + fr;
                const int pos = (row < TP) ? row : TP + ((row - TP) & 7);
#pragma unroll
                for (int bj = 0; bj < 2; ++bj) {
                    const int pc = bj * 128 + wc * 32 + fq * 8;
                    f32x4 v0 = acc[ai][bj][m][0], v1 = acc[ai][bj][m][1];
                    if (tile < 10) {
                        const int hh = pc >> 6, pp = pc & 63, j8 = pp >> 3;
                        const bool is_q = tile < 4; const int t = tile - 4, br = t >> 1, x = t & 1;
                        int d0, d1;
                        if (is_q || x == 0) {
                            const f32x4 cs = *(const f32x4*)(ROPE + (size_t)pos * 64 + 4 * j8), sn = *(const f32x4*)(ROPE + (size_t)pos * 64 + 32 + 4 * j8);
                            const f32x4 lo = v0 * cs - v1 * sn, hi = v1 * cs + v0 * sn; v0 = lo; v1 = hi; d0 = 4 * j8; d1 = 32 + 4 * j8;
                        } else { d0 = pp; d1 = pp + 4; }
                        if (is_q) {
                            bf16* q = (bf16*)(ws + WS_QB) + (size_t)row * 1024 + (tile * 4 + hh) * 64;
                            *(u32x2*)(q + d0) = pack4(v0 * QSCALE); *(u32x2*)(q + d1) = pack4(v1 * QSCALE);
                        } else {
                            const int co = x * 256 + hh * 64;
                            float* o = nullptr;
                            if (row < TP) {
                                if (br == 0) o = out + O_CMPP + (size_t)row * 512 + co;
                                else if (br == 1) o = out + O_SELP + (size_t)row * 512 + co;
                                else if (row >= TP - 512) o = out + O_WINP + (size_t)(row - (TP - 512)) * 512 + co;
                                bf16* kb = (br == 0) ? (bf16*)(ws + WS_CB) + (size_t)x * CB_X + ((size_t)(32 * 4 + hh) * 8192 + row) * 64
                                                     : (bf16*)(ws + WS_KVB) + ((size_t)(((br - 1) * 2 + x) * 4 + hh) * 8192 + row) * 64;
                                *(u32x2*)(kb + d0) = pack4(v0); *(u32x2*)(kb + d1) = pack4(v1);
                            } else {
                                const int sr = row - TP;
                                if (br == 0) o = out + O_CMPS + (size_t)sr * 512 + co;
                                else if (br == 1) o = out + O_SELS + (size_t)sr * 512 + co;
                                else o = out + O_WINS + ((size_t)(sr >> 3) * 512 + 504 + (sr & 7)) * 512 + co;
                            }
                            if (o) { *(f32x4*)(o + d0) = v0; *(f32x4*)(o + d1) = v1; }
                        }
                    } else if (tile < 14) {
                        const int col = (tile - 10) * 256 + pc;
                        v0 = (f32x4){silu(v0.x), silu(v0.y), silu(v0.z), silu(v0.w)}; v1 = (f32x4){silu(v1.x), silu(v1.y), silu(v1.z), silu(v1.w)};
                        *(u32x4*)((bf16*)(ws + WS_ZN) + (size_t)row * 1024 + col) = pack8(v0, v1);
                    } else if (tile < 16) {
                        *(u32x4*)((bf16*)(ws + WS_QG) + (size_t)row * 512 + (tile - 14) * 256 + pc) = pack8(v0 * GQSCALE, v1 * GQSCALE);
                    } else if (tile < 18) {
                        *(u32x4*)((bf16*)(ws + WS_KG) + (size_t)row * 512 + (tile - 16) * 256 + pc) = pack8(v0, v1);
                    } else if (tile < 22) {
                        const int col = (tile - 18) * 256 + pc;
                        if (row < TP) {
                            bf16* vt = (bf16*)(ws + WS_VGT) + ((size_t)(row >> 6) * 1024 + col) * 64 + (row & 63);
                            vt[0 * 64] = (bf16)f2bf(v0.x); vt[1 * 64] = (bf16)f2bf(v0.y); vt[2 * 64] = (bf16)f2bf(v0.z); vt[3 * 64] = (bf16)f2bf(v0.w);
                            vt[4 * 64] = (bf16)f2bf(v1.x); vt[5 * 64] = (bf16)f2bf(v1.y); vt[6 * 64] = (bf16)f2bf(v1.z); vt[7 * 64] = (bf16)f2bf(v1.w);
                        } else {
                            float* vs = (float*)(ws + WS_VGS) + (size_t)(row - TP) * 1024 + col;
                            *(f32x4*)vs = v0; *(f32x4*)(vs + 4) = v1;
                        }
                    } else if (tile < 26) {
                        const int col = (tile - 22) * 256 + pc;
                        v0 = (f32x4){silu(v0.x), silu(v0.y), silu(v0.z), silu(v0.w)}; v1 = (f32x4){silu(v1.x), silu(v1.y), silu(v1.z), silu(v1.w)};
                        *(u32x4*)((bf16*)(ws + WS_ZG) + (size_t)row * 1024 + col) = pack8(v0, v1);
                    } else if (tile < 42) {
                        const bool mn = tile < 34; const int col = (tile - (mn ? 26 : 34)) * 256 + pc;
                        v0 = (f32x4){sigm(v0.x), sigm(v0.y), sigm(v0.z), sigm(v0.w)}; v1 = (f32x4){sigm(v1.x), sigm(v1.y), sigm(v1.z), sigm(v1.w)};
                        *(u32x4*)((bf16*)(ws + (mn ? WS_MN : WS_MG)) + (size_t)row * 2048 + col) = pack8(v0, v1);
                    } else {
                        if (pc < 48) {
                            v0 = (f32x4){sigm(v0.x), sigm(v0.y), sigm(v0.z), sigm(v0.w)}; v1 = (f32x4){sigm(v1.x), sigm(v1.y), sigm(v1.z), sigm(v1.w)};
                            float* g = (float*)(ws + WS_GB) + (size_t)row * 48 + pc; *(f32x4*)g = v0; *(f32x4*)(g + 4) = v1;
                        } else if (pc < 64) {
                            float* a = (float*)(ws + WS_AG) + (size_t)row * 16 + (pc - 48); *(f32x4*)a = v0; *(f32x4*)(a + 4) = v1;
                        }
                    }
                }
            }
    }
};

struct EpiMergeZ {
    static constexpr bool PERM = true, AFTER_DRAIN = false;
    const bf16* GN; const bf16* GG; bf16* O;
    __device__ __forceinline__ void operator()(const f32x4 (&acc)[2][2][4][2], const pg8::Unit& u, int wr, int wc, int fr, int fq) const {
        const bf16* G = u.z ? GG : GN;
#pragma unroll
        for (int ai = 0; ai < 2; ++ai)
#pragma unroll
            for (int m = 0; m < 4; ++m) { const size_t row = (size_t)u.pm * 256 + ai * 128 + wr * 64 + m * 16 + fr;
#pragma unroll
                for (int bj = 0; bj < 2; ++bj) { const int col = u.pn * 256 + bj * 128 + wc * 32 + fq * 8;
                    const u32x4 g = *(const u32x4*)(G + row * 2048 + col);
                    f32x4 v0 = acc[ai][bj][m][0] * (f32x4){bflo(g.x), bfhi(g.x), bflo(g.y), bfhi(g.y)};
                    f32x4 v1 = acc[ai][bj][m][1] * (f32x4){bflo(g.z), bfhi(g.z), bflo(g.w), bfhi(g.w)};
                    if (u.z) { const u32x4 p = *(const u32x4*)(O + row * 2048 + col);
                        v0 += (f32x4){bflo(p.x), bfhi(p.x), bflo(p.y), bfhi(p.y)}; v1 += (f32x4){bflo(p.z), bfhi(p.z), bflo(p.w), bfhi(p.w)}; }
                    *(u32x4*)(O + row * 2048 + col) = pack8(v0, v1); } }
    }
};
struct EpiOut {
    static constexpr bool PERM = true, AFTER_DRAIN = false;
    const float* x_p; const float* x_s; const long long* MOD; float* out; float* RSS;
    __device__ __forceinline__ void operator()(const f32x4 (&acc)[2][2][4][2], const pg8::Unit& u, int wr, int wc, int fr, int fq) const {
#pragma unroll
        for (int ai = 0; ai < 2; ++ai)
#pragma unroll
            for (int m = 0; m < 4; ++m) { const int row = u.pm * 256 + ai * 128 + wr * 64 + m * 16 + fr;
                const float* xr = (row < TP) ? x_p + (size_t)row * DM : x_s + (size_t)(row - TP) * DM;
                const long long* gr = MOD + (size_t)((row < TP) ? 0 : 1 + ((row - TP) >> 3)) * NMOD + 4096;
                float* yr = out + ((row < TP) ? O_YP + (size_t)row * DM : O_YS + (size_t)(row - TP) * DM);
                float ss = 0.f;
#pragma unroll
                for (int bj = 0; bj < 2; ++bj) { const int col = u.pn * 256 + bj * 128 + wc * 32 + fq * 8;
#pragma unroll
                    for (int n = 0; n < 2; ++n) { const long long* gp = gr + col + 4 * n; const f32x4 gt = (f32x4){(float)gp[0], (float)gp[1], (float)gp[2], (float)gp[3]} * MOD_INV;
                        const f32x4 y = *(const f32x4*)(xr + col + 4 * n) + gt * acc[ai][bj][m][n];
                        *(f32x4*)(yr + col + 4 * n) = y; ss += (y.x * y.x + y.y * y.y) + (y.z * y.z + y.w * y.w); } }
                ss += __shfl_xor(ss, 16); ss += __shfl_xor(ss, 32);
                if (fq == 0) RSS[(size_t)row * 64 + u.pn * 4 + wc] = ss; }
    }
};


template <class Epi>
__device__ __forceinline__ void wave_gemm_tiles(Frame& F, const bf16* A, int lda, const bf16* Bt, int ldb, int m0, int mtiles, int ntiles, int K, const Epi& E) {
    const int lane = F.lane, c = lane & 31, h = lane >> 5, grp = F.wave >> 2, ks = F.wave & 3, kq = K >> 2;
    LAS float* red = (LAS float*)(F.lds) + (grp * 3) * 1024;
    const int T = mtiles * ntiles;
    for (int t2 = blockIdx.x; 2 * t2 < T; t2 += F.G) {
        const int t = 2 * t2 + grp;
        const int tm = t / ntiles, tn = t % ntiles;
        const bf16* ap = A + (size_t)(m0 + 32 * tm + c) * lda + ks * kq + 8 * h;
        const bf16* bp = Bt + (size_t)(32 * tn + c) * ldb + ks * kq + 8 * h;
        f32x16 acc;
#pragma unroll
        for (int r = 0; r < 16; ++r) acc[r] = 0.f;
#pragma unroll 4
        for (int k = 0; k < kq; k += 16) { const bf16x8 a = *(const bf16x8*)(ap + k), b = *(const bf16x8*)(bp + k); acc = __builtin_amdgcn_mfma_f32_32x32x16_bf16(a, b, acc, 0, 0, 0); }
        if constexpr (Epi::PRE) E.pre(acc, m0 + 32 * tm, 32 * tn, ks, lane);
        __syncthreads();
        if (ks != 0) {
#pragma unroll
            for (int r = 0; r < 16; ++r) red[((ks - 1) * 16 + r) * 64 + lane] = acc[r];
        }
        __syncthreads();
        if (ks == 0) {
#pragma unroll
            for (int r = 0; r < 16; ++r) acc[r] += (red[(0 * 16 + r) * 64 + lane] + red[(1 * 16 + r) * 64 + lane]) + red[(2 * 16 + r) * 64 + lane];
            E(acc, m0 + 32 * tm, 32 * tn, tn, lane);
        }
    }
    __syncthreads();
}
struct SEpiPlain { static constexpr bool PRE = false; bf16* O; int ldc;
    __device__ __forceinline__ void operator()(const f32x16& acc, int m0, int n0, int tn, int lane) const { const int c = lane & 31, h = lane >> 5;
#pragma unroll
        for (int r = 0; r < 16; ++r) O[(size_t)(m0 + (r & 3) + 8 * (r >> 2) + 4 * h) * ldc + n0 + c] = (bf16)f2bf(acc[r]); } };
struct SEpiMergeCat { static constexpr bool PRE = true; const bf16* GN; const bf16* GG; bf16* O;
    __device__ __forceinline__ void pre(f32x16& acc, int m0, int n0, int ks, int lane) const { const int c = lane & 31, h = lane >> 5; const bf16* G = (ks < 2) ? GN : GG;
#pragma unroll
        for (int r = 0; r < 16; ++r) acc[r] *= bf2f(G[(size_t)(m0 + (r & 3) + 8 * (r >> 2) + 4 * h) * 2048 + n0 + c]); }
    __device__ __forceinline__ void operator()(const f32x16& acc, int m0, int n0, int tn, int lane) const { const int c = lane & 31, h = lane >> 5;
#pragma unroll
        for (int r = 0; r < 16; ++r) O[(size_t)(m0 + (r & 3) + 8 * (r >> 2) + 4 * h) * 2048 + n0 + c] = (bf16)f2bf(acc[r]); } };
struct SEpiOut { static constexpr bool PRE = false; const float* x_s; const long long* MOD; float* out; float* RSS;
    __device__ __forceinline__ void operator()(const f32x16& acc, int m0, int n0, int tn, int lane) const { const int c = lane & 31, h = lane >> 5;
#pragma unroll
        for (int r = 0; r < 16; ++r) { const int row = m0 + (r & 3) + 8 * (r >> 2) + 4 * h, sr = row - TP;
            const float y = x_s[(size_t)sr * DM + n0 + c] + ((float)MOD[(size_t)(1 + (sr >> 3)) * NMOD + 4096 + n0 + c] * MOD_INV) * acc[r];
            out[O_YS + (size_t)sr * DM + n0 + c] = y;
            float ss = y * y; ss += __shfl_xor(ss, 1); ss += __shfl_xor(ss, 2); ss += __shfl_xor(ss, 4); ss += __shfl_xor(ss, 8); ss += __shfl_xor(ss, 16);
            if (c == 0) RSS[(size_t)row * 64 + tn] = ss; } } };

__device__ __forceinline__ void compress_l2(Frame& F) {
    const int lane = F.lane, c32 = lane & 31, h = lane >> 5;
    const float* POSB = WSP(float, WS_POSB);
    for (int x = 0; x < 2; ++x) {
        const bf16* W2T = WSP(bf16, WS_POSB + 4096) + (size_t)x * 64 * 128;
        const bf16* PART = WSP(bf16, WS_PART) + (size_t)x * CROWS * 256;
        bf16* KC = WSP(bf16, WS_KC) + (size_t)x * CROWS * 64;
        bf16x8 bfr[2][8];
#pragma unroll
        for (int dt = 0; dt < 2; ++dt)
#pragma unroll
            for (int ks = 0; ks < 8; ++ks) bfr[dt][ks] = *(const bf16x8*)(W2T + (size_t)(32 * dt + c32) * 128 + 16 * ks + 8 * h);
        const float b2a = F.cmp_b2[x * 64 + c32], b2b = F.cmp_b2[x * 64 + 32 + c32];
        for (int it = F.gw; it < CROWS / 32; it += F.NGW) {
            const size_t row = (size_t)it * 32 + c32;
            f32x16 o0, o1;
#pragma unroll
            for (int r = 0; r < 16; ++r) { o0[r] = 0.f; o1[r] = 0.f; }
#pragma unroll
            for (int ks = 0; ks < 8; ++ks) {
                const int e0 = 16 * ks + 8 * h;
                const u32x4 p0 = *(const u32x4*)(PART + row * 256 + e0), p1 = *(const u32x4*)(PART + (row + 1) * 256 + 128 + e0);
                const f32x4 ba = *(const f32x4*)(POSB + x * 128 + e0), bb = *(const f32x4*)(POSB + x * 128 + e0 + 4);
                f32x4 a = (f32x4){bflo(p0.x) + bflo(p1.x), bfhi(p0.x) + bfhi(p1.x), bflo(p0.y) + bflo(p1.y), bfhi(p0.y) + bfhi(p1.y)} + ba;
                f32x4 b = (f32x4){bflo(p0.z) + bflo(p1.z), bfhi(p0.z) + bfhi(p1.z), bflo(p0.w) + bflo(p1.w), bfhi(p0.w) + bfhi(p1.w)} + bb;
                a = (f32x4){silu(a.x), silu(a.y), silu(a.z), silu(a.w)}; b = (f32x4){silu(b.x), silu(b.y), silu(b.z), silu(b.w)};
                const u32x4 hp = pack8(a, b); const bf16x8 hf = __builtin_bit_cast(bf16x8, hp);
                o0 = __builtin_amdgcn_mfma_f32_32x32x16_bf16(hf, bfr[0][ks], o0, 0, 0, 0);
                o1 = __builtin_amdgcn_mfma_f32_32x32x16_bf16(hf, bfr[1][ks], o1, 0, 0, 0);
            }
#pragma unroll
            for (int r = 0; r < 16; ++r) {
                const size_t orow = (size_t)it * 32 + (r & 3) + 8 * (r >> 2) + 4 * h;
                const bool dead = (orow & 511) == 511;
                KC[orow * 64 + c32] = dead ? (bf16)0 : (bf16)f2bf(o0[r] + b2a);
                KC[orow * 64 + 32 + c32] = dead ? (bf16)0 : (bf16)f2bf(o1[r] + b2b);
            }
        }
    }
}

__device__ __forceinline__ void final_norm(Frame& F) {
    const float* RSS = WSP(float, WS_RSS);
    for (int r = F.gw; r < MROWS; r += F.NGW) {
        float* yr = F.out + ((r < TP) ? O_YP + (size_t)r * DM : O_YS + (size_t)(r - TP) * DM);
        float ss = (F.lane < 32 || r >= TP) ? RSS[(size_t)r * 64 + F.lane] : 0.f;
        const float rstd = 1.f / sqrtf(wave_sum(ss) * (1.f / DM) + 1e-6f);
#pragma unroll
        for (int j = 0; j < 8; ++j) { const int c = (j * 64 + F.lane) * 4;
            const f32x4 v = *(const f32x4*)(yr + c) * rstd * *(const f32x4*)(F.fnw + c); *(f32x4*)(yr + c) = v; }
    }
}

typedef short v4i16_t __attribute__((ext_vector_type(4)));
__device__ __forceinline__ s16x4 tr_read(const LAS bf16* p) { return __builtin_bit_cast(s16x4, __builtin_amdgcn_ds_read_tr16_b64_v4i16((LAS v4i16_t*)p)); }
typedef __bf16 bf16x2_t __attribute__((ext_vector_type(2)));
__device__ __forceinline__ unsigned cvtpk(float lo, float hi) { const f32x2 v = {lo, hi}; const bf16x2_t b = __builtin_convertvector(v, bf16x2_t); return __builtin_bit_cast(unsigned, b); }

struct QLds { const LAS bf16x8* p; __device__ __forceinline__ bf16x8 get(int ks) const { return p[ks * 64]; } };
__device__ __forceinline__ bf16x8 qget(const bf16x8 (&q)[4], int ks) { return q[ks]; }
__device__ __forceinline__ bf16x8 qget(const QLds& q, int ks) { return q.get(ks); }
template <int NKT, class QT>
__device__ __forceinline__ void qk_scores(f32x16 (&s)[NKT], const LAS bf16* Kt, const QT& qf, int lane) {
    const int c = lane & 31, h = lane >> 5;
#pragma unroll
    for (int kt = 0; kt < NKT; ++kt) {
#pragma unroll
        for (int r = 0; r < 16; ++r) s[kt][r] = 0.f;
#pragma unroll
        for (int ks = 0; ks < 4; ++ks) {
            const bf16x8 a = *(const LAS bf16x8*)(Kt + (32 * kt + c) * KTLD + 16 * ks + 8 * h);
            s[kt] = __builtin_amdgcn_mfma_f32_32x32x16_bf16(a, qget(qf, ks), s[kt], 0, 0, 0);
        }
    }
}
template <int NKT>
__device__ __forceinline__ void pv_accum(f32x16 (&o)[2], const f32x16 (&p)[NKT], const LAS bf16* Vt, int lane) {
    const int i16 = lane & 15, g16 = lane >> 4, h = lane >> 5;
    const LAS bf16* vb = Vt + (4 * h + (i16 >> 2)) * KTLD + 16 * (g16 & 1) + 4 * (i16 & 3);
#pragma unroll
    for (int kt = 0; kt < NKT; ++kt)
#pragma unroll
        for (int s2 = 0; s2 < 2; ++s2) {
            u32x4 pw; pw.x = cvtpk(p[kt][8 * s2 + 0], p[kt][8 * s2 + 1]); pw.y = cvtpk(p[kt][8 * s2 + 2], p[kt][8 * s2 + 3]);
            pw.z = cvtpk(p[kt][8 * s2 + 4], p[kt][8 * s2 + 5]); pw.w = cvtpk(p[kt][8 * s2 + 6], p[kt][8 * s2 + 7]);
            const bf16x8 pf = __builtin_bit_cast(bf16x8, pw);
#pragma unroll
            for (int dt = 0; dt < 2; ++dt) {
                const s16x4 lo = tr_read(vb + (32 * kt + 16 * s2) * KTLD + 32 * dt), hi = tr_read(vb + (32 * kt + 16 * s2 + 8) * KTLD + 32 * dt);
                const bf16x8 vf = (bf16x8){lo[0], lo[1], lo[2], lo[3], hi[0], hi[1], hi[2], hi[3]};
                o[dt] = __builtin_amdgcn_mfma_f32_32x32x16_bf16(vf, pf, o[dt], 0, 0, 0);
            }
            __builtin_amdgcn_sched_barrier(0);
        }
}
template <int NKT>
__device__ __forceinline__ float mask_max(f32x16 (&s)[NKT], int lo, int hi, int h) {
    const int lo2 = lo - 4 * h, hi2 = hi - 4 * h; float mx = -1e30f;
#pragma unroll
    for (int kt = 0; kt < NKT; ++kt)
#pragma unroll
        for (int r = 0; r < 16; ++r) { const int ko = 32 * kt + (r & 3) + 8 * (r >> 2); const bool v = (ko >= lo2) && (ko <= hi2);
            const float x = v ? s[kt][r] : -1e30f; s[kt][r] = x; mx = fmaxf(mx, x); }
    return fmaxf(mx, __shfl_xor(mx, 32));
}
struct FlashSt { float m, l; f32x16 o[2]; };
__device__ __forceinline__ void flash_init(FlashSt& st) { st.m = -1e30f; st.l = 0.f;
#pragma unroll
    for (int r = 0; r < 16; ++r) { st.o[0][r] = 0.f; st.o[1][r] = 0.f; } }
template <int NKT, int mode, class QT>
__device__ __forceinline__ void flash_tile(FlashSt& st, const LAS bf16* Kt, const LAS bf16* Vt, const QT& qf, bool sel, int lo, int hi, int lane) {
    f32x16 s[NKT];
    qk_scores<NKT>(s, Kt, qf, lane);
    float mx;
    if (mode == 2) mx = mask_max<NKT>(s, lo, hi, lane >> 5);
    else {
        float a = -1e30f;
#pragma unroll
        for (int kt = 0; kt < NKT; ++kt)
#pragma unroll
            for (int r = 0; r < 16; ++r) a = fmaxf(a, s[kt][r]);
        if (mode == 1) {
            a = sel ? a : -1e30f;
#pragma unroll
            for (int kt = 0; kt < NKT; ++kt)
#pragma unroll
                for (int r = 0; r < 16; ++r) s[kt][r] = sel ? s[kt][r] : -1e30f;
        }
        mx = fmaxf(a, __shfl_xor(a, 32));
    }
    const float mn = fmaxf(st.m, mx), alpha = ex2(st.m - mn); st.m = mn;
    float ps = 0.f;
    if (mode == 0) {
#pragma unroll
        for (int kt = 0; kt < NKT; ++kt)
#pragma unroll
            for (int r = 0; r < 16; ++r) { const float p = ex2(s[kt][r] - mn); s[kt][r] = p; ps += p; }
    } else {
#pragma unroll
        for (int kt = 0; kt < NKT; ++kt)
#pragma unroll
            for (int r = 0; r < 16; ++r) { const float x = s[kt][r]; const float p = (x > -1e29f) ? ex2(x - mn) : 0.f; s[kt][r] = p; ps += p; }
    }
    st.l = st.l * alpha + ps;
#pragma unroll
    for (int r = 0; r < 16; ++r) { st.o[0][r] *= alpha; st.o[1][r] *= alpha; }
    pv_accum<NKT>(st.o, s, Vt, lane);
}
template <int NKT>
__device__ __forceinline__ void stats_tile(float& m, float& l, const LAS bf16* Kt, const bf16x8 (&qf)[4], int lo, int hi, int lane) {
    f32x16 s[NKT];
    qk_scores<NKT>(s, Kt, qf, lane);
    const float mx = mask_max<NKT>(s, lo, hi, lane >> 5);
    const float mn = fmaxf(m, mx), alpha = ex2(m - mn); m = mn;
    float ps = 0.f;
#pragma unroll
    for (int kt = 0; kt < NKT; ++kt)
#pragma unroll
        for (int r = 0; r < 16; ++r) { const float x = s[kt][r]; ps += (x > -1e29f) ? ex2(x - mn) : 0.f; }
    l = l * alpha + ps;
}
template <int NKT>
__device__ __forceinline__ void cmp2_tile(f32x16 (&o)[2], const LAS bf16* Kt, const LAS bf16* Vt, const bf16x8 (&qf)[4], int lo, int hi, float M, float invL,
                                          LAS float* impA, LAS float* impB, int q, int impld, int n_base, int lane) {
    f32x16 s[NKT];
    qk_scores<NKT>(s, Kt, qf, lane);
    (void)mask_max<NKT>(s, lo, hi, lane >> 5);
#pragma unroll
    for (int kt = 0; kt < NKT; ++kt)
#pragma unroll
        for (int r = 0; r < 16; ++r) { const float x = s[kt][r]; s[kt][r] = (x > -1e29f) ? ex2(x - M) * invL : 0.f; }
    const int h = lane >> 5;
#pragma unroll
    for (int kt = 0; kt < NKT; ++kt)
#pragma unroll
        for (int k4 = 0; k4 < 4; ++k4) {
            float s4 = (s[kt][4 * k4] + s[kt][4 * k4 + 1]) + (s[kt][4 * k4 + 2] + s[kt][4 * k4 + 3]), p3 = s[kt][4 * k4 + 3];
            s4 += __shfl_xor(s4, 8); s4 += __shfl_xor(s4, 16); p3 += __shfl_xor(p3, 8); p3 += __shfl_xor(p3, 16);
            if ((lane & 24) == 0) { const int n0 = n_base + 8 * kt + 2 * k4 + h; impA[q * impld + n0] = s4; impB[q * impld + n0 + 1] = p3; }
        }
    pv_accum<NKT>(o, s, Vt, lane);
}

constexpr int IMPLD = 130;
__device__ __forceinline__ void nsa_prompt_unit(Frame& F, int qt, int kvh) {
    const int tid = F.tid, lane = F.lane, w = F.wave, c = lane & 31, h = lane >> 5, qi = c & 7, g = c >> 3;
    LAS bf16* Kt0 = (LAS bf16*)(F.lds);
    LAS bf16* Vt0 = (LAS bf16*)(F.lds + 18432);
    LAS float* impA = (LAS float*)(F.lds + 36864);
    LAS float* impB = (LAS float*)(F.lds + 36864 + 33280);
    LAS unsigned* selb = (LAS unsigned*)(F.lds + 36864 + 66560);
    const int q_off = 8 * w + qi, token = 64 * qt + q_off, head = kvh * 4 + g;
    const bf16* QB = WSP(bf16, WS_QB);
    bf16x8 qf[4];
#pragma unroll
    for (int ks = 0; ks < 4; ++ks) qf[ks] = *(const bf16x8*)(QB + (size_t)token * 1024 + head * 64 + 16 * ks + 8 * h);
    const float* gbp = WSP(float, WS_GB) + (size_t)token * 48 + head * 3;
    const float gb_c = gbp[0], gb_s = gbp[1], gb_w = gbp[2];
    f32x16 oacc[2];
#pragma unroll
    for (int r = 0; r < 16; ++r) { oacc[0][r] = 0.f; oacc[1][r] = 0.f; }
    const int srow = tid >> 3, sch = tid & 7;
    const int lds_st = srow * KTLD + sch * 8;

    {
        const bf16* KCk = WSP(bf16, WS_KC) + ((size_t)(32 * 4 + kvh) * 512) * 64;
        const bf16* KCv = WSP(bf16, WS_KC) + (size_t)CROWS * 64 + ((size_t)(32 * 4 + kvh) * 512) * 64;
        int cmax = (token - 31) >> 4; if (cmax > 510) cmax = 510;
        const int nT = ((4 * qt + 2) >> 6) + 1;
        float m = -1e30f, l = 0.f;
        u32x4 kreg = *(const u32x4*)(KCk + (size_t)srow * 64 + sch * 8), vreg;
        for (int t = 0; t < nT; ++t) {
            LAS bf16* Kt = Kt0 + (t & 1) * 64 * KTLD;
            *(LAS u32x4*)(Kt + lds_st) = kreg;
            __syncthreads();
            if (t + 1 < nT) kreg = *(const u32x4*)(KCk + (size_t)((t + 1) * 64 + srow) * 64 + sch * 8);
            int hi = cmax - 64 * t; if (hi > 63) hi = 63;
            stats_tile<2>(m, l, Kt, qf, 0, hi, lane);
        }
        l += __shfl_xor(l, 32);
        const float invL = (l > 0.f) ? 1.f / l : 0.f;
        __syncthreads();
        kreg = *(const u32x4*)(KCk + (size_t)srow * 64 + sch * 8); vreg = *(const u32x4*)(KCv + (size_t)srow * 64 + sch * 8);
        f32x16 o[2];
#pragma unroll
        for (int r = 0; r < 16; ++r) { o[0][r] = 0.f; o[1][r] = 0.f; }
        for (int t = 0; t < nT; ++t) {
            LAS bf16* Kt = Kt0 + (t & 1) * 64 * KTLD; LAS bf16* Vt = Vt0 + (t & 1) * 64 * KTLD;
            *(LAS u32x4*)(Kt + lds_st) = kreg; *(LAS u32x4*)(Vt + lds_st) = vreg;
            __syncthreads();
            if (t + 1 < nT) { kreg = *(const u32x4*)(KCk + (size_t)((t + 1) * 64 + srow) * 64 + sch * 8); vreg = *(const u32x4*)(KCv + (size_t)((t + 1) * 64 + srow) * 64 + sch * 8); }
            int hi = cmax - 64 * t; if (hi > 63) hi = 63;
            cmp2_tile<2>(o, Kt, Vt, qf, 0, hi, m, invL, impA, impB, q_off, IMPLD, 16 * t, lane);
        }
#pragma unroll
        for (int r = 0; r < 16; ++r) { oacc[0][r] += gb_c * o[0][r]; oacc[1][r] += gb_c * o[1][r]; }
    }
    __syncthreads();
    if (tid < 256) selb[tid] = 0u;
    __syncthreads();
    if (qt <= 15) {
        if (tid < 64) selb[tid * 4] = (1u << (qt + 1)) - 1u;
    } else {
        const int q = tid >> 3, sub = tid & 7, nhi = qt - 2;
#pragma unroll 1
        for (int i = 0; i < 16; ++i) { const int n = sub + 8 * i; if (n >= 1 && n <= nhi) impA[q * IMPLD + n] += impB[q * IMPLD + n]; }
        __syncthreads();
#pragma unroll 1
        for (int i = 0; i < 16; ++i) {
            const int n = sub + 8 * i; bool sel;
            if (n >= 1 && n <= nhi) {
                const float v = impA[q * IMPLD + n]; int rank = 0;
#pragma unroll 4
                for (int mm = 1; mm <= nhi; ++mm) { const float vm = impA[q * IMPLD + mm]; rank += (vm > v || (vm == v && mm < n)) ? 1 : 0; }
                sel = rank < 13;
            } else sel = (n == 0 || n == qt || n == qt - 1);
            if (sel) atomicOr((unsigned*)&selb[q * 4 + (n >> 5)], 1u << (n & 31));
        }
    }
    __syncthreads();
    const unsigned sw0 = selb[q_off * 4 + 0], sw1 = selb[q_off * 4 + 1], sw2 = selb[q_off * 4 + 2], sw3 = selb[q_off * 4 + 3];
    __syncthreads();
    LAS bf16x8* Qs = (LAS bf16x8*)(F.lds + 73728) + w * 256;
#pragma unroll
    for (int ks = 0; ks < 4; ++ks) Qs[ks * 64 + lane] = qf[ks];
    asm volatile("" ::: "memory");
    const QLds ql{(const LAS bf16x8*)Qs + lane};
    {
        const bf16* Kg = WSP(bf16, WS_KVB) + ((size_t)((0 * 2 + 0) * 4 + kvh) * 8192) * 64;
        const bf16* Vg = WSP(bf16, WS_KVB) + ((size_t)((0 * 2 + 1) * 4 + kvh) * 8192) * 64;
        FlashSt st; flash_init(st);
        LAS bf16* KS = (LAS bf16*)(F.lds); LAS bf16* VS = (LAS bf16*)(F.lds + 36864);
#define LDT(kr, vr, blkn) { kr = *(const u32x4*)(Kg + (size_t)((blkn) * 64 + srow) * 64 + sch * 8); vr = *(const u32x4*)(Vg + (size_t)((blkn) * 64 + srow) * 64 + sch * 8); }
#define STT(kr, vr, slot) { *(LAS u32x4*)(KS + (slot) * 64 * KTLD + lds_st) = kr; *(LAS u32x4*)(VS + (slot) * 64 * KTLD + lds_st) = vr; }
#define SEL_TILE(slot, blk) { const unsigned swd = ((blk) < 32) ? sw0 : ((blk) < 64) ? sw1 : ((blk) < 96) ? sw2 : sw3; const bool sq = (swd >> ((blk) & 31)) & 1u; \
            const unsigned long long bal = __ballot(sq); \
            if (bal != 0ull) { const int md = ((blk) == qt) ? 2 : ((bal == ~0ull) ? 0 : 1); const int lo = sq ? 0 : 1, hi = sq ? (((blk) == qt) ? q_off : 63) : 0; \
                if (md == 2) flash_tile<2, 2>(st, KS + (slot) * 64 * KTLD, VS + (slot) * 64 * KTLD, ql, sq, lo, hi, lane); \
                else if (md == 1) flash_tile<2, 1>(st, KS + (slot) * 64 * KTLD, VS + (slot) * 64 * KTLD, ql, sq, lo, hi, lane); \
                else flash_tile<2, 0>(st, KS + (slot) * 64 * KTLD, VS + (slot) * 64 * KTLD, ql, sq, lo, hi, lane); } }
        u32x4 k0, v0, k1 = (u32x4){0u, 0u, 0u, 0u}, v1 = k1;
        LDT(k0, v0, 0) if (qt >= 1) LDT(k1, v1, 1)
        for (int blk = 0; blk <= qt; blk += 2) {
            const int sb = blk & 2; const bool two = (blk + 1 <= qt);
            STT(k0, v0, sb) if (two) STT(k1, v1, sb + 1)
            __syncthreads();
            if (blk + 2 <= qt) LDT(k0, v0, blk + 2)
            if (blk + 3 <= qt) LDT(k1, v1, blk + 3)
            SEL_TILE(sb, blk)
            if (two) SEL_TILE(sb + 1, blk + 1)
        }
#undef SEL_TILE
        const float lt = st.l + __shfl_xor(st.l, 32); const float sc = (lt > 0.f) ? gb_s / lt : 0.f;
#pragma unroll
        for (int r = 0; r < 16; ++r) { oacc[0][r] += sc * st.o[0][r]; oacc[1][r] += sc * st.o[1][r]; }
    }
    __syncthreads();
    {
        const bf16* Kg = WSP(bf16, WS_KVB) + ((size_t)((1 * 2 + 0) * 4 + kvh) * 8192) * 64;
        const bf16* Vg = WSP(bf16, WS_KVB) + ((size_t)((1 * 2 + 1) * 4 + kvh) * 8192) * 64;
        const int b0 = (qt >= 8) ? qt - 8 : 0;
        FlashSt st; flash_init(st);
        LAS bf16* KS = (LAS bf16*)(F.lds); LAS bf16* VS = (LAS bf16*)(F.lds + 36864);
#define WIN_TILE(slot, blk) { const int lo = ((blk) == qt - 8) ? q_off + 1 : 0, hi = ((blk) == qt) ? q_off : 63; const int md = ((blk) == qt || (blk) == qt - 8) ? 2 : 0; \
            if (md == 2) flash_tile<2, 2>(st, KS + (slot) * 64 * KTLD, VS + (slot) * 64 * KTLD, ql, true, lo, hi, lane); \
            else flash_tile<2, 0>(st, KS + (slot) * 64 * KTLD, VS + (slot) * 64 * KTLD, ql, true, lo, hi, lane); }
        u32x4 k0, v0, k1 = (u32x4){0u, 0u, 0u, 0u}, v1 = k1;
        LDT(k0, v0, b0) if (b0 + 1 <= qt) LDT(k1, v1, b0 + 1)
        for (int blk = b0; blk <= qt; blk += 2) {
            const int sb = (blk - b0) & 2; const bool two = (blk + 1 <= qt);
            STT(k0, v0, sb) if (two) STT(k1, v1, sb + 1)
            __syncthreads();
            if (blk + 2 <= qt) LDT(k0, v0, blk + 2)
            if (blk + 3 <= qt) LDT(k1, v1, blk + 3)
            WIN_TILE(sb, blk)
            if (two) WIN_TILE(sb + 1, blk + 1)
        }
#undef WIN_TILE
#undef STT
#undef LDT
        const float lt = st.l + __shfl_xor(st.l, 32); const float sc = (lt > 0.f) ? gb_w / lt : 0.f;
#pragma unroll
        for (int r = 0; r < 16; ++r) { oacc[0][r] += sc * st.o[0][r]; oacc[1][r] += sc * st.o[1][r]; }
    }
    __syncthreads();
    {
        const bf16* zn = WSP(bf16, WS_ZN) + (size_t)token * 1024 + head * 64;
        bf16* on = WSP(bf16, WS_OCAT) + (size_t)token * 2048 + head * 64;
#pragma unroll
        for (int dt = 0; dt < 2; ++dt)
#pragma unroll
            for (int k4 = 0; k4 < 4; ++k4) { const int d = 32 * dt + 8 * k4 + 4 * h;
                const u32x2 z = *(const u32x2*)(zn + d);
                const f32x4 v = (f32x4){oacc[dt][4 * k4] * bflo(z.x), oacc[dt][4 * k4 + 1] * bfhi(z.x), oacc[dt][4 * k4 + 2] * bflo(z.y), oacc[dt][4 * k4 + 3] * bfhi(z.y)};
                *(u32x2*)(on + d) = pack4(v); }
    }
}

__device__ __forceinline__ void stage_half_f32(LAS bf16* dst, const float* base, int nvalid, int lane) {
    const int r4 = lane >> 4, c4 = (lane & 15) * 4;
    f32x4 v[8];
#pragma unroll
    for (int i = 0; i < 8; ++i) { const int row = 4 * i + r4; v[i] = (row < nvalid) ? *(const f32x4*)(base + (size_t)row * 512 + c4) : (f32x4){0.f, 0.f, 0.f, 0.f}; }
#pragma unroll
    for (int i = 0; i < 8; ++i) *(LAS u32x2*)(dst + (4 * i + r4) * KTLD + c4) = pack4(v[i]);
}
__device__ __forceinline__ void stage_half_bf16(LAS bf16* dst, const bf16* base, int lane) {
    const int row = lane >> 1, hf = lane & 1;
#pragma unroll
    for (int i = 0; i < 4; ++i) *(LAS u32x4*)(dst + row * KTLD + hf * 32 + 8 * i) = *(const u32x4*)(base + (size_t)row * 64 + hf * 32 + 8 * i);
}
__device__ __forceinline__ void merge_partials(const LAS float* mlb, const LAS float* comb, int lane, f32x16 (&o)[2], float& L) {
    const int c = lane & 31;
    float M = -1e30f;
#pragma unroll
    for (int ww = 0; ww < 8; ++ww) M = fmaxf(M, mlb[(ww * 64 + lane) * 2]);
    L = 0.f;
#pragma unroll
    for (int r = 0; r < 16; ++r) { o[0][r] = 0.f; o[1][r] = 0.f; }
#pragma unroll 1
    for (int ww = 0; ww < 8; ++ww) {
        const float f = ex2(mlb[(ww * 64 + lane) * 2] - M);
        L += (mlb[(ww * 64 + c) * 2 + 1] + mlb[(ww * 64 + c + 32) * 2 + 1]) * f;
#pragma unroll
        for (int r = 0; r < 16; ++r) { o[0][r] += comb[(ww * 32 + r) * 64 + lane] * f; o[1][r] += comb[(ww * 32 + 16 + r) * 64 + lane] * f; }
    }
}
__device__ __forceinline__ void nsa_sample_unit(Frame& F, int b, int kvh) {
    const int tid = F.tid, lane = F.lane, w = F.wave, c = lane & 31, h = lane >> 5, qi = c & 7, g = c >> 3;
    LAS bf16* Kw = (LAS bf16*)(F.lds + w * 9216); LAS bf16* Vw = Kw + 32 * KTLD;
    LAS float* comb = (LAS float*)F.lds;
    LAS float* mlb = (LAS float*)(F.lds + 65536);
    LAS float* impA = (LAS float*)(F.lds + 73728);
    LAS float* impB = impA + 8 * IMPLD;
    LAS unsigned* selb = (LAS unsigned*)(impB + 8 * IMPLD);
    const int token = TP + 8 * b + qi, head = kvh * 4 + g;
    const bf16* QB = WSP(bf16, WS_QB);
    bf16x8 qf[4];
#pragma unroll
    for (int ks = 0; ks < 4; ++ks) qf[ks] = *(const bf16x8*)(QB + (size_t)token * 1024 + head * 64 + 16 * ks + 8 * h);
    const float* gbp = WSP(float, WS_GB) + (size_t)token * 48 + head * 3;
    const float gb_c = gbp[0], gb_s = gbp[1], gb_w = gbp[2];
    f32x16 oacc[2];
#pragma unroll
    for (int r = 0; r < 16; ++r) { oacc[0][r] = 0.f; oacc[1][r] = 0.f; }
    __syncthreads();
    {
        const bf16* KCk = WSP(bf16, WS_KC) + ((size_t)(b * 4 + kvh) * 512) * 64;
        const bf16* KCv = KCk + (size_t)CROWS * 64;
        float m = -1e30f, l = 0.f;
        for (int ti = w; ti < 16; ti += 8) {
            stage_half_bf16(Kw, KCk + (size_t)ti * 32 * 64, lane);
            int hi = 510 - 32 * ti; if (hi > 31) hi = 31;
            stats_tile<1>(m, l, Kw, qf, 0, hi, lane);
        }
        __syncthreads();
        mlb[(w * 64 + lane) * 2] = m; mlb[(w * 64 + lane) * 2 + 1] = l;
        __syncthreads();
        float M = -1e30f;
#pragma unroll
        for (int ww = 0; ww < 8; ++ww) M = fmaxf(M, mlb[(ww * 64 + lane) * 2]);
        float L = 0.f;
#pragma unroll
        for (int ww = 0; ww < 8; ++ww) L += (mlb[(ww * 64 + c) * 2 + 1] + mlb[(ww * 64 + c + 32) * 2 + 1]) * ex2(mlb[(ww * 64 + lane) * 2] - M);
        const float invL = (L > 0.f) ? 1.f / L : 0.f;
        __syncthreads();
        f32x16 o[2];
#pragma unroll
        for (int r = 0; r < 16; ++r) { o[0][r] = 0.f; o[1][r] = 0.f; }
        for (int ti = w; ti < 16; ti += 8) {
            stage_half_bf16(Kw, KCk + (size_t)ti * 32 * 64, lane); stage_half_bf16(Vw, KCv + (size_t)ti * 32 * 64, lane);
            int hi = 510 - 32 * ti; if (hi > 31) hi = 31;
            cmp2_tile<1>(o, Kw, Vw, qf, 0, hi, M, invL, impA, impB, qi, IMPLD, 8 * ti, lane);
        }
        __syncthreads();
#pragma unroll
        for (int r = 0; r < 16; ++r) { comb[(w * 32 + r) * 64 + lane] = o[0][r]; comb[(w * 32 + 16 + r) * 64 + lane] = o[1][r]; }
        __syncthreads();
        if (w == 0) {
#pragma unroll 1
            for (int ww = 0; ww < 8; ++ww)
#pragma unroll
                for (int r = 0; r < 16; ++r) { oacc[0][r] += gb_c * comb[(ww * 32 + r) * 64 + lane]; oacc[1][r] += gb_c * comb[(ww * 32 + 16 + r) * 64 + lane]; }
        }
    }
    __syncthreads();
    if (tid < 64) selb[tid] = 0u;
    {
        const int q = w;
#pragma unroll 1
        for (int i = 0; i < 2; ++i) { const int n = lane + 64 * i; if (n >= 1 && n <= 126) impA[q * IMPLD + n] += impB[q * IMPLD + n]; }
        __syncthreads();
#pragma unroll 1
        for (int i = 0; i < 2; ++i) {
            const int n = lane + 64 * i; bool sel = true;
            if (n >= 1 && n <= 126) {
                const float v = impA[q * IMPLD + n]; int rank = 0;
#pragma unroll 4
                for (int mm = 1; mm <= 126; ++mm) { const float vm = impA[q * IMPLD + mm]; rank += (vm > v || (vm == v && mm < n)) ? 1 : 0; }
                sel = rank < 13;
            }
            if (sel) atomicOr((unsigned*)&selb[q * 8 + (n >> 5)], 1u << (n & 31));
        }
        if (lane == 0) atomicOr((unsigned*)&selb[q * 8 + 4], 1u);
    }
    __syncthreads();
    {
        FlashSt st; flash_init(st);
        int cnt = 0;
        for (int blk = 0; blk <= 128; ++blk) {
            unsigned uw = 0u;
#pragma unroll
            for (int q = 0; q < 8; ++q) uw |= selb[q * 8 + (blk >> 5)];
            uw = __builtin_amdgcn_readfirstlane(uw);
            if (!((uw >> (blk & 31)) & 1u)) continue;
            const int nh = (blk == 128) ? 1 : 2;
            for (int hf = 0; hf < nh; ++hf) {
                if (((cnt++) & 7) != w) continue;
                const float* base; int nvalid;
                if (blk < 128) { const int page = F.ptab[b * NPAGE + (blk >> 1)]; base = F.c_sel + ((size_t)page * 128 + (blk & 1) * 64 + hf * 32) * 512 + kvh * 64; nvalid = 32; }
                else { base = F.out + O_SELS + (size_t)(b * 8) * 512 + kvh * 64; nvalid = 8; }
                stage_half_f32(Kw, base, nvalid, lane); stage_half_f32(Vw, base + 256, nvalid, lane);
                const bool sq = (selb[qi * 8 + (blk >> 5)] >> (blk & 31)) & 1u;
                const int lo = sq ? 0 : 1, hi = sq ? ((blk == 128) ? qi : 31) : 0;
                flash_tile<1, 2>(st, Kw, Vw, qf, sq, lo, hi, lane);
            }
        }
        __syncthreads();
        mlb[(w * 64 + lane) * 2] = st.m; mlb[(w * 64 + lane) * 2 + 1] = st.l;
#pragma unroll
        for (int r = 0; r < 16; ++r) { comb[(w * 32 + r) * 64 + lane] = st.o[0][r]; comb[(w * 32 + 16 + r) * 64 + lane] = st.o[1][r]; }
        __syncthreads();
        if (w == 0) { f32x16 o[2]; float L; merge_partials(mlb, comb, lane, o, L); const float sc = (L > 0.f) ? gb_s / L : 0.f;
#pragma unroll
            for (int r = 0; r < 16; ++r) { oacc[0][r] += sc * o[0][r]; oacc[1][r] += sc * o[1][r]; } }
    }
    __syncthreads();
    {
        FlashSt st; flash_init(st);
        for (int ti = w; ti < 17; ti += 8) {
            const float* base; int nvalid;
            if (ti < 16) { base = F.c_win + ((size_t)b * 512 + 32 * ti) * 512 + kvh * 64; nvalid = 32; }
            else { base = F.out + O_WINS + ((size_t)b * 512 + 504) * 512 + kvh * 64; nvalid = 8; }
            stage_half_f32(Kw, base, nvalid, lane); stage_half_f32(Vw, base + 256, nvalid, lane);
            const int lo = (ti == 0) ? 1 + qi : 0, hi = (ti == 16) ? qi : 31;
            flash_tile<1, 2>(st, Kw, Vw, qf, true, lo, hi, lane);
        }
        __syncthreads();
        mlb[(w * 64 + lane) * 2] = st.m; mlb[(w * 64 + lane) * 2 + 1] = st.l;
#pragma unroll
        for (int r = 0; r < 16; ++r) { comb[(w * 32 + r) * 64 + lane] = st.o[0][r]; comb[(w * 32 + 16 + r) * 64 + lane] = st.o[1][r]; }
        __syncthreads();
        if (w == 0) { f32x16 o[2]; float L; merge_partials(mlb, comb, lane, o, L); const float sc = (L > 0.f) ? gb_w / L : 0.f;
#pragma unroll
            for (int r = 0; r < 16; ++r) { oacc[0][r] += sc * o[0][r]; oacc[1][r] += sc * o[1][r]; } }
    }
    if (w == 0) {
        const bf16* zn = WSP(bf16, WS_ZN) + (size_t)token * 1024 + head * 64;
        bf16* on = WSP(bf16, WS_OCAT) + (size_t)token * 2048 + head * 64;
#pragma unroll
        for (int dt = 0; dt < 2; ++dt)
#pragma unroll
            for (int k4 = 0; k4 < 4; ++k4) { const int d = 32 * dt + 8 * k4 + 4 * h;
                const u32x2 z = *(const u32x2*)(zn + d);
                const f32x4 v = (f32x4){oacc[dt][4 * k4] * bflo(z.x), oacc[dt][4 * k4 + 1] * bfhi(z.x), oacc[dt][4 * k4 + 2] * bflo(z.y), oacc[dt][4 * k4 + 3] * bfhi(z.y)};
                *(u32x2*)(on + d) = pack4(v); }
    }
    __syncthreads();
}


__device__ __forceinline__ float log_sigmoid(float z) { return (z < 0.f) ? z - log1pf(__expf(z)) : -log1pf(__expf(-z)); }
__device__ __forceinline__ void gla_cum(Frame& F, int ch, int hd, LAS float* cum, LAS float* qs, LAS float* agt) {
    const int tid = F.tid, k = tid & 127, tq = tid >> 7;
    const float* AG = WSP(float, WS_AG) + (size_t)(64 * ch) * 16;
    for (int i = tid; i < 64 * 16; i += 512) agt[i] = AG[i];
    float wv[16];
#pragma unroll
    for (int r = 0; r < 16; ++r) wv[r] = F.w_a2[r * 512 + hd * 128 + k];
    const float bias = F.b_a[hd * 128 + k];
    __syncthreads();
    float run = 0.f;
    for (int tt = 0; tt < 16; ++tt) {
        const int t = 16 * tq + tt; float z = bias;
#pragma unroll
        for (int r = 0; r < 16; ++r) z += agt[t * 16 + r] * wv[r];
        run += log_sigmoid(z) * (1.f / 16.f); cum[t * 128 + k] = run;
    }
    qs[tq * 128 + k] = run;
    __syncthreads();
    float off = 0.f;
    for (int j = 0; j < tq; ++j) off += qs[j * 128 + k];
    if (tq > 0) for (int tt = 0; tt < 16; ++tt) cum[(16 * tq + tt) * 128 + k] += off;
    __syncthreads();
}
__device__ __forceinline__ void gla_pass1_unit(Frame& F, int ch, int hd) {
    LAS float* cum = (LAS float*)F.lds; LAS float* qs = cum + 64 * 128; LAS float* agt = qs + 512;
    LAS bf16* KhT = (LAS bf16*)(F.lds + 40960);
    const int tid = F.tid, lane = F.lane, c = lane & 31, h = lane >> 5, w = F.wave;
    const bf16* VGT = WSP(bf16, WS_VGT) + ((size_t)ch * 1024 + hd * 256 + 32 * w + c) * 64;
    bf16x8 af[4];
#pragma unroll
    for (int ss = 0; ss < 4; ++ss) af[ss] = *(const bf16x8*)(VGT + 16 * ss + 8 * h);
    const int s_ = tid >> 3, k16 = (tid & 7) * 16;
    const bf16* KGp = WSP(bf16, WS_KG) + (size_t)(64 * ch + s_) * 512 + hd * 128 + k16;
    const u32x4 kr0 = *(const u32x4*)KGp, kr1 = *(const u32x4*)(KGp + 8);
    gla_cum(F, ch, hd, cum, qs, agt);
    {
        const unsigned kw[8] = {kr0.x, kr0.y, kr0.z, kr0.w, kr1.x, kr1.y, kr1.z, kr1.w};
#pragma unroll
        for (int j = 0; j < 8; ++j) { const int k = k16 + 2 * j;
            const float e0 = __expf(cum[63 * 128 + k] - cum[s_ * 128 + k]), e1 = __expf(cum[63 * 128 + k + 1] - cum[s_ * 128 + k + 1]);
            KhT[k * 72 + s_] = (bf16)f2bf(bflo(kw[j]) * e0); KhT[(k + 1) * 72 + s_] = (bf16)f2bf(bfhi(kw[j]) * e1); }
        if (tid < 128) WSP(float, WS_DC)[(ch * 4 + hd) * 128 + tid] = __expf(cum[63 * 128 + tid]);
    }
    __syncthreads();
    float* LT = WSP(float, WS_LT) + ((size_t)(ch * 4 + hd) * 256 + 32 * w) * 128;
#pragma unroll
    for (int kt = 0; kt < 4; ++kt) {
        f32x16 acc;
#pragma unroll
        for (int r = 0; r < 16; ++r) acc[r] = 0.f;
#pragma unroll
        for (int ss = 0; ss < 4; ++ss) { const bf16x8 bv = *(const LAS bf16x8*)(KhT + (32 * kt + c) * 72 + 16 * ss + 8 * h); acc = __builtin_amdgcn_mfma_f32_32x32x16_bf16(af[ss], bv, acc, 0, 0, 0); }
#pragma unroll
        for (int r = 0; r < 16; ++r) LT[(size_t)((r & 3) + 8 * (r >> 2) + 4 * h) * 128 + 32 * kt + c] = acc[r];
    }
    __syncthreads();
}
__device__ __forceinline__ void gla_pass2(Frame& F) {
    const float* __restrict__ LT = WSP(float, WS_LT); const float* __restrict__ DC = WSP(float, WS_DC); bf16* __restrict__ ST = WSP(bf16, WS_ST);
    for (int e = blockIdx.x * 512 + F.tid; e < 4 * 256 * 128; e += F.G * 512) {
        const int k = e & 127, v = (e >> 7) & 255, hd = e >> 15;
        float S = 0.f;
#pragma unroll 8
        for (int cc = 0; cc < 128; ++cc) { const size_t idx = ((size_t)(cc * 4 + hd) * 256 + v) * 128 + k; ST[idx] = (bf16)f2bf(S); S = DC[(cc * 4 + hd) * 128 + k] * S + LT[idx]; }
        F.out[O_STP + ((size_t)hd * 128 + k) * 256 + v] = S;
    }
}
__device__ __forceinline__ void gla_pass3_unit(Frame& F, int ch, int hd) {
    LAS float* cum = (LAS float*)F.lds; LAS float* qs = cum + 64 * 128; LAS float* agt = qs + 512;
    LAS bf16* Qt = (LAS bf16*)(F.lds + 40960);
    LAS bf16* Kt2 = Qt + 64 * 136;
    LAS bf16* Att = Kt2 + 64 * 136;
    LAS float* red = (LAS float*)(F.lds + 84992);
    LAS float* rstdv = red + 512;
    LAS bf16* Ot = (LAS bf16*)(F.lds + 90112);
    const int tid = F.tid, lane = F.lane, c = lane & 31, h = lane >> 5, w = F.wave;
    const bf16* VGT = WSP(bf16, WS_VGT) + ((size_t)ch * 1024 + hd * 256 + 32 * w + c) * 64;
    const bf16* STp = WSP(bf16, WS_ST) + ((size_t)(ch * 4 + hd) * 256 + 32 * w + c) * 128;
    bf16x8 bv[4], bs[8];
#pragma unroll
    for (int ss = 0; ss < 4; ++ss) bv[ss] = *(const bf16x8*)(VGT + 16 * ss + 8 * h);
#pragma unroll
    for (int ks = 0; ks < 8; ++ks) bs[ks] = *(const bf16x8*)(STp + 16 * ks + 8 * h);
    const int t_ = tid >> 3, k16 = (tid & 7) * 16;
    const size_t qoff = (size_t)(64 * ch + t_) * 512 + hd * 128 + k16;
    const u32x4 qr0 = *(const u32x4*)(WSP(bf16, WS_QG) + qoff), qr1 = *(const u32x4*)(WSP(bf16, WS_QG) + qoff + 8);
    const u32x4 kr0 = *(const u32x4*)(WSP(bf16, WS_KG) + qoff), kr1 = *(const u32x4*)(WSP(bf16, WS_KG) + qoff + 8);
    gla_cum(F, ch, hd, cum, qs, agt);
    {
        const unsigned qw[8] = {qr0.x, qr0.y, qr0.z, qr0.w, qr1.x, qr1.y, qr1.z, qr1.w}, kw[8] = {kr0.x, kr0.y, kr0.z, kr0.w, kr1.x, kr1.y, kr1.z, kr1.w};
        unsigned qo[8], ko[8];
#pragma unroll
        for (int j = 0; j < 8; ++j) { const float c0 = cum[t_ * 128 + k16 + 2 * j], c1 = cum[t_ * 128 + k16 + 2 * j + 1];
            qo[j] = pk2(bflo(qw[j]) * __expf(c0), bfhi(qw[j]) * __expf(c1)); ko[j] = pk2(bflo(kw[j]) * __expf(-c0), bfhi(kw[j]) * __expf(-c1)); }
        *(LAS u32x4*)(Qt + t_ * 136 + k16) = (u32x4){qo[0], qo[1], qo[2], qo[3]}; *(LAS u32x4*)(Qt + t_ * 136 + k16 + 8) = (u32x4){qo[4], qo[5], qo[6], qo[7]};
        *(LAS u32x4*)(Kt2 + t_ * 136 + k16) = (u32x4){ko[0], ko[1], ko[2], ko[3]}; *(LAS u32x4*)(Kt2 + t_ * 136 + k16 + 8) = (u32x4){ko[4], ko[5], ko[6], ko[7]};
    }
    __syncthreads();
    if (w < 3) {
        const int tt = (w + 1) >> 1, st = w >> 1;
        f32x16 acc;
#pragma unroll
        for (int r = 0; r < 16; ++r) acc[r] = 0.f;
#pragma unroll
        for (int ks = 0; ks < 8; ++ks) { const bf16x8 a = *(const LAS bf16x8*)(Qt + (32 * tt + c) * 136 + 16 * ks + 8 * h), bb = *(const LAS bf16x8*)(Kt2 + (32 * st + c) * 136 + 16 * ks + 8 * h);
            acc = __builtin_amdgcn_mfma_f32_32x32x16_bf16(a, bb, acc, 0, 0, 0); }
#pragma unroll
        for (int r = 0; r < 16; ++r) { const int t = 32 * tt + (r & 3) + 8 * (r >> 2) + 4 * h, s2 = 32 * st + c; Att[t * 72 + s2] = (s2 <= t) ? (bf16)f2bf(acc[r]) : (bf16)0; }
    } else if (w == 3) {
#pragma unroll
        for (int r = 0; r < 16; ++r) { const int t = (r & 3) + 8 * (r >> 2) + 4 * h; Att[t * 72 + 32 + c] = (bf16)0; }
    }
    __syncthreads();
    f32x16 acc[2];
#pragma unroll
    for (int tt = 0; tt < 2; ++tt) {
#pragma unroll
        for (int r = 0; r < 16; ++r) acc[tt][r] = 0.f;
#pragma unroll
        for (int ss = 0; ss < 4; ++ss) { if (tt == 0 && ss >= 2) continue;
            const bf16x8 a = *(const LAS bf16x8*)(Att + (32 * tt + c) * 72 + 16 * ss + 8 * h); acc[tt] = __builtin_amdgcn_mfma_f32_32x32x16_bf16(a, bv[ss], acc[tt], 0, 0, 0); }
#pragma unroll
        for (int ks = 0; ks < 8; ++ks) { const bf16x8 a = *(const LAS bf16x8*)(Qt + (32 * tt + c) * 136 + 16 * ks + 8 * h); acc[tt] = __builtin_amdgcn_mfma_f32_32x32x16_bf16(a, bs[ks], acc[tt], 0, 0, 0); }
    }
#pragma unroll
    for (int tt = 0; tt < 2; ++tt)
#pragma unroll
        for (int r = 0; r < 16; ++r) { float sq = acc[tt][r] * acc[tt][r];
            sq += __shfl_xor(sq, 1); sq += __shfl_xor(sq, 2); sq += __shfl_xor(sq, 4); sq += __shfl_xor(sq, 8); sq += __shfl_xor(sq, 16);
            if (c == 0) red[w * 64 + 32 * tt + (r & 3) + 8 * (r >> 2) + 4 * h] = sq; }
    __syncthreads();
    if (tid < 64) { float s2 = 0.f;
#pragma unroll
        for (int ww = 0; ww < 8; ++ww) s2 += red[ww * 64 + tid];
        rstdv[tid] = 1.f / sqrtf(s2 * (1.f / 256.f) + 1e-6f); }
    __syncthreads();
    {
        const float gw = F.gnw[32 * w + c];
#pragma unroll
        for (int tt = 0; tt < 2; ++tt)
#pragma unroll
            for (int r = 0; r < 16; ++r) { const int t = 32 * tt + (r & 3) + 8 * (r >> 2) + 4 * h; Ot[t * 264 + 32 * w + c] = (bf16)f2bf(acc[tt][r] * rstdv[t] * gw); }
    }
    __syncthreads();
    {
        const bf16* ZG = WSP(bf16, WS_ZG); bf16* OG = WSP(bf16, WS_OCAT) + 1024;
#pragma unroll
        for (int j = 0; j < 4; ++j) { const int pidx = tid + 512 * j, t = pidx >> 5, v8 = (pidx & 31) * 8; const size_t row = (size_t)(64 * ch + t);
            const u32x4 z = *(const u32x4*)(ZG + row * 1024 + hd * 256 + v8), o = *(const LAS u32x4*)(Ot + t * 264 + v8);
            const f32x4 a = (f32x4){bflo(o.x) * bflo(z.x), bfhi(o.x) * bfhi(z.x), bflo(o.y) * bflo(z.y), bfhi(o.y) * bfhi(z.y)};
            const f32x4 b2 = (f32x4){bflo(o.z) * bflo(z.z), bfhi(o.z) * bfhi(z.z), bflo(o.w) * bflo(z.w), bfhi(o.w) * bfhi(z.w)};
            *(u32x4*)(OG + row * 2048 + hd * 256 + v8) = pack8(a, b2); }
    }
    __syncthreads();
}
__device__ __forceinline__ void gla_sample_unit(Frame& F, int b, int hd) {
    LAS float* cumS = (LAS float*)F.lds; LAS float* qtl = cumS + 1024; LAS float* khl = qtl + 1024; LAS float* ktl = khl + 1024;
    LAS float* att = ktl + 1024; LAS float* oih = att + 64; LAS float* red = oih + 2048;
    const int tid = F.tid, lane = F.lane, w = F.wave, row0 = TP + 8 * b;
    if (tid < 128) {
        const int k = tid; float wv[16];
#pragma unroll
        for (int r = 0; r < 16; ++r) wv[r] = F.w_a2[r * 512 + hd * 128 + k];
        const float bias = F.b_a[hd * 128 + k]; float run = 0.f;
        const float* AG = WSP(float, WS_AG) + (size_t)row0 * 16;
        for (int t = 0; t < 8; ++t) { float z = bias;
#pragma unroll
            for (int r = 0; r < 16; ++r) z += AG[t * 16 + r] * wv[r];
            run += log_sigmoid(z) * (1.f / 16.f); cumS[t * 128 + k] = run; }
    }
    __syncthreads();
    for (int i = tid; i < 1024; i += 512) { const int t = i >> 7, k = i & 127; const float cu = cumS[i], cl = cumS[7 * 128 + k];
        const float q = bf2f(WSP(bf16, WS_QG)[(size_t)(row0 + t) * 512 + hd * 128 + k]), kk = bf2f(WSP(bf16, WS_KG)[(size_t)(row0 + t) * 512 + hd * 128 + k]);
        qtl[i] = q * __expf(cu); khl[i] = kk * __expf(cl - cu); ktl[i] = kk * __expf(-cu); }
    __syncthreads();
    if (tid < 64) { const int t = tid >> 3, s = tid & 7; float a = 0.f;
        if (s <= t) for (int k = 0; k < 128; ++k) a += qtl[t * 128 + k] * ktl[s * 128 + k];
        att[tid] = a; }
    __syncthreads();
    const int v = tid & 255, kh = tid >> 8;
    float vv[8], oi[8];
#pragma unroll
    for (int s = 0; s < 8; ++s) { vv[s] = WSP(float, WS_VGS)[(size_t)(8 * b + s) * 1024 + hd * 256 + v]; oi[s] = 0.f; }
    const float* S0 = F.state + ((size_t)(b * 4 + hd) * 128) * 256; float* SN = F.out + O_STS + ((size_t)(b * 4 + hd) * 128) * 256;
#pragma unroll 4
    for (int kk = 0; kk < 64; ++kk) { const int k = kh * 64 + kk; const float s0 = S0[(size_t)k * 256 + v]; float sn = __expf(cumS[7 * 128 + k]) * s0;
#pragma unroll
        for (int s = 0; s < 8; ++s) { sn += khl[s * 128 + k] * vv[s]; oi[s] += qtl[s * 128 + k] * s0; }
        SN[(size_t)k * 256 + v] = sn; }
    if (kh == 1) {
#pragma unroll
        for (int t = 0; t < 8; ++t) oih[t * 256 + v] = oi[t]; }
    __syncthreads();
    if (kh == 0) {
#pragma unroll
        for (int t = 0; t < 8; ++t) { float o = oi[t] + oih[t * 256 + v];
#pragma unroll
            for (int s = 0; s < 8; ++s) if (s <= t) o += att[t * 8 + s] * vv[s];
            oi[t] = o; } }
#pragma unroll
    for (int t = 0; t < 8; ++t) { float sq = (kh == 0) ? oi[t] * oi[t] : 0.f; sq = wave_sum(sq); if (lane == 0) red[w * 8 + t] = sq; }
    __syncthreads();
    if (kh == 0) { const float gw = F.gnw[v];
#pragma unroll
        for (int t = 0; t < 8; ++t) { const float ssum = (red[t] + red[8 + t]) + (red[16 + t] + red[24 + t]); const float rstd = 1.f / sqrtf(ssum * (1.f / 256.f) + 1e-6f);
            const size_t row = (size_t)(row0 + t);
            WSP(bf16, WS_OCAT)[row * 2048 + 1024 + hd * 256 + v] = (bf16)f2bf(oi[t] * rstd * gw * bf2f(WSP(bf16, WS_ZG)[row * 1024 + hd * 256 + v])); } }
    __syncthreads();
}


#ifdef SELF_CHECK
__device__ __forceinline__ void self_check_kc(Frame& F) {
    const int lane = F.lane;
    unsigned* errw = (unsigned*)(F.ctl + CW_Q5 + 4096);
    for (int sidx = F.gw; sidx < 4096; sidx += F.NGW) {
        unsigned hsh = (unsigned)sidx * 2654435761u; hsh ^= hsh >> 15; hsh *= 2246822519u; hsh ^= hsh >> 13;
        const int x = hsh & 1, b = (hsh >> 1) % 33, hh = (hsh >> 8) & 3, cc = (hsh >> 10) % 511, d = (hsh >> 20) & 63;
        float part = 0.f;
        for (int ee = 0; ee < 2; ++ee) {
            const int e = lane + 64 * ee; float hid = F.cmp_b1[x * 128 + e];
            for (int l = 0; l < 32; ++l) {
                const int pos = 16 * cc + l;
                const float* row = (b < 32) ? F.c_cmp + ((size_t)F.ptab[b * NPAGE + (pos >> 7)] * 128 + (pos & 127)) * 512 + x * 256 + hh * 64
                                            : F.out + O_CMPP + (size_t)pos * 512 + x * 256 + hh * 64;
                for (int dd = 0; dd < 64; ++dd) hid += (row[dd] + F.cmp_pos[(x * 32 + l) * 64 + dd]) * F.cmp_w1[(((size_t)x * 32 + l) * 64 + dd) * 128 + e];
            }
            part += silu(hid) * F.cmp_w2[((size_t)x * 128 + e) * 64 + d];
        }
        part = wave_sum(part) + F.cmp_b2[x * 64 + d];
        const float got = bf2f(WSP(bf16, WS_KC)[(size_t)x * CROWS * 64 + ((size_t)(b * 4 + hh) * 512 + cc) * 64 + d]);
        if (lane == 0 && !(fabsf(got - part) <= 0.05f * fabsf(part) + 0.02f)) atomicAdd(errw, 1u);
    }
}

__device__ __forceinline__ void self_check_nsa(Frame& F) {
    const int lane = F.lane;
    LAS float* L = (LAS float*)(F.lds + F.wave * 16384);
    LAS float* ql = L; LAS float* pc = L + 256; LAS float* impl = L + 2304; LAS float* pb = L + 2440; LAS float* res = L + 2520; LAS int* lst = (LAS int*)(L + 3300);
    unsigned* errw = (unsigned*)(F.ctl + CW_Q5 + 4096);
    const bf16* QB = WSP(bf16, WS_QB); const bf16* KC = WSP(bf16, WS_KC); const bf16* KVB = WSP(bf16, WS_KVB);
#pragma unroll 1
    for (int sidx = F.gw; sidx < 768; sidx += F.NGW) {
        unsigned hsh = (unsigned)(sidx + 77) * 2654435761u; hsh ^= hsh >> 15; hsh *= 2246822519u; hsh ^= hsh >> 13;
        const bool smp = sidx >= 512; const int kvh = hsh & 3;
        const int r = smp ? TP + (int)((hsh >> 4) % 256) : (sidx < 64 ? (int)((hsh >> 4) % 1100) : (int)((hsh >> 4) % 8192));
        const int b = smp ? (r - TP) >> 3 : 32, qi = (r - TP) & 7, qpos = smp ? TP + qi : r, cur = qpos >> 6;
        for (int i = lane; i < 256; i += 64) ql[i] = bf2f(QB[(size_t)r * 1024 + kvh * 256 + i]);
        const bf16* kc = KC + ((size_t)(b * 4 + kvh) * 512) * 64; const bf16* vc = kc + (size_t)CROWS * 64;
        int cmax = smp ? 510 : ((qpos - 31) >> 4); if (cmax > 510) cmax = 510;
#pragma unroll 1
        for (int g = 0; g < 4; ++g) {
            float mx = -1e30f;
#pragma unroll 1
            for (int j = 0; j < 8; ++j) { const int c = lane + 64 * j; float a = 0.f;
#pragma unroll 1
                for (int d = 0; d < 64; ++d) a += ql[g * 64 + d] * bf2f(kc[(size_t)c * 64 + d]);
                a = (c <= cmax) ? a : -1e30f; pc[g * 512 + c] = a; mx = fmaxf(mx, a); }
            for (int o = 1; o < 64; o <<= 1) mx = fmaxf(mx, __shfl_xor(mx, o));
            float sm = 0.f;
#pragma unroll 1
            for (int j = 0; j < 8; ++j) { const int c = lane + 64 * j; const float a = pc[g * 512 + c]; const float pv = (a > -1e29f) ? ex2(a - mx) : 0.f; pc[g * 512 + c] = pv; sm += pv; }
            sm = wave_sum(sm); const float inv = sm > 0.f ? 1.f / sm : 0.f;
#pragma unroll 1
            for (int j = 0; j < 8; ++j) pc[g * 512 + lane + 64 * j] *= inv;
            float a = 0.f;
#pragma unroll 1
            for (int c = 0; c <= cmax; ++c) a += pc[g * 512 + c] * bf2f(vc[(size_t)c * 64 + lane]);
            res[(0 * 4 + g) * 64 + lane] = a;
        }
        const int nb = smp ? 129 : 128;
#pragma unroll 1
        for (int n = lane; n < nb; n += 64) { float a = 0.f;
#pragma unroll 1
            for (int c = 4 * n - 1; c <= 4 * n + 3; ++c) if (c >= 0 && c <= 510) a += pc[c] + pc[512 + c] + pc[1024 + c] + pc[1536 + c];
            const bool forced = (n == 0) || (n <= cur && n > cur - 2); impl[n] = forced ? 1e30f : (n > cur ? -1e30f : a); }
        int nsel = 0;
#pragma unroll 1
        for (int n = 0; n < nb; ++n) { const float v = impl[n]; int rank = 0;
#pragma unroll 1
            for (int m = lane; m < nb; m += 64) { const float vm = impl[m]; rank += (vm > v || (vm == v && m < n)) ? 1 : 0; }
            rank = (int)wave_sum((float)rank); if (rank < 16 && v > -0.5e30f) { lst[nsel] = n; ++nsel; } }
#pragma unroll 1
        for (int br = 0; br < 2; ++br) {
            const int nblk = br == 0 ? nsel : 10;
#pragma unroll 1
            for (int g = 0; g < 4; ++g) {
                float mm = -1e30f, ll = 0.f, oo = 0.f;
#pragma unroll 1
                for (int bi = 0; bi < nblk; ++bi) {
                    const int pos0 = br == 0 ? 64 * lst[bi] : ((qpos - 575) & ~63) + 64 * bi;
                    const int pos = pos0 + lane;
                    const bool valid = (pos >= 0) && (pos <= qpos) && (br == 0 || pos > qpos - 512);
                    float a = -1e30f;
                    if (valid) {
                        a = 0.f;
                        if (!smp) { const bf16* kb = KVB + ((size_t)((br * 2 + 0) * 4 + kvh) * 8192 + pos) * 64;
#pragma unroll 1
                            for (int d = 0; d < 64; ++d) a += ql[g * 64 + d] * bf2f(kb[d]); }
                        else { const float* kf = (br == 0) ? ((pos < TP) ? F.c_sel + ((size_t)F.ptab[b * NPAGE + (pos >> 7)] * 128 + (pos & 127)) * 512 + kvh * 64 : F.out + O_SELS + (size_t)(b * 8 + pos - TP) * 512 + kvh * 64)
                                                          : ((pos < TP) ? F.c_win + ((size_t)b * 512 + (pos - (TP - 512))) * 512 + kvh * 64 : F.out + O_WINS + ((size_t)b * 512 + 504 + pos - TP) * 512 + kvh * 64);
#pragma unroll 1
                            for (int d = 0; d < 64; ++d) a += ql[g * 64 + d] * bf2f(f2bf(kf[d])); }
                    }
                    float mx = a; for (int o = 1; o < 64; o <<= 1) mx = fmaxf(mx, __shfl_xor(mx, o));
                    const float mn = fmaxf(mm, mx), al = ex2(mm - mn); mm = mn;
                    const float pq = (a > -1e29f) ? ex2(a - mn) : 0.f; ll = ll * al + wave_sum(pq); pb[lane] = pq;
                    float acc = 0.f;
#pragma unroll 1
                    for (int kk = 0; kk < 64; ++kk) { const int pk = pos0 + kk; const float pp = pb[kk]; if (pp != 0.f) {
                        float vv;
                        if (!smp) vv = bf2f(KVB[((size_t)((br * 2 + 1) * 4 + kvh) * 8192 + pk) * 64 + lane]);
                        else if (br == 0) vv = bf2f(f2bf(((pk < TP) ? F.c_sel + ((size_t)F.ptab[b * NPAGE + (pk >> 7)] * 128 + (pk & 127)) * 512 : F.out + O_SELS + (size_t)(b * 8 + pk - TP) * 512)[256 + kvh * 64 + lane]));
                        else vv = bf2f(f2bf(((pk < TP) ? F.c_win + ((size_t)b * 512 + (pk - (TP - 512))) * 512 : F.out + O_WINS + ((size_t)b * 512 + 504 + pk - TP) * 512)[256 + kvh * 64 + lane]));
                        acc += pp * vv; } }
                    oo = oo * al + acc;
                }
                res[((1 + br) * 4 + g) * 64 + lane] = ll > 0.f ? oo / ll : 0.f;
            }
        }
        int bad = 0;
#pragma unroll 1
        for (int g = 0; g < 4; ++g) { const int head = kvh * 4 + g; const float* gb = WSP(float, WS_GB) + (size_t)r * 48 + head * 3;
            const float ref = (gb[0] * res[(0 * 4 + g) * 64 + lane] + gb[1] * res[(1 * 4 + g) * 64 + lane] + gb[2] * res[(2 * 4 + g) * 64 + lane]) * bf2f(WSP(bf16, WS_ZN)[(size_t)r * 1024 + head * 64 + lane]);
            const float got = bf2f(WSP(bf16, WS_OCAT)[(size_t)r * 2048 + head * 64 + lane]);
            if (!(fabsf(got - ref) <= 0.06f * fabsf(ref) + 0.003f)) bad += 1; }
        bad = (int)wave_sum((float)bad);
        if (lane == 0 && bad > 8) atomicAdd(errw, 1u);
    }
}
#endif
#ifndef MK_N_LAUNCHES
#define MK_N_LAUNCHES 1
#endif
constexpr int NPH = 9;
constexpr int N_LAUNCHES = MK_N_LAUNCHES;
struct Args { const void* in[25]; float* out; unsigned char* ws; int ph_lo, ph_hi, rpt, pad; };

__global__ void __launch_bounds__(NWAVES * 64, 2) nsa_gla_fwd(Args args) {
    extern __shared__ __attribute__((aligned(16))) unsigned char lds[];
    Frame F;
    F.lds = (LAS unsigned char*)lds;
    F.MISC = (volatile LAS unsigned*)(F.lds + LDSCTL_OFF);
    F.tid = threadIdx.x; F.lane = F.tid & 63; F.wave = __builtin_amdgcn_readfirstlane(F.tid >> 6);
    F.G = gridDim.x; F.gw = blockIdx.x * NWAVES + F.wave; F.NGW = F.G * NWAVES;
    F.ws = args.ws; F.out = args.out; F.ctl = (gu32*)(args.ws + WS_CTL);
#define LOAD_INPUTS() do { \
    F.x_p = (const float*)args.in[0]; F.x_s = (const float*)args.in[1]; F.c_cmp = (const float*)args.in[2]; F.c_sel = (const float*)args.in[3]; \
    F.c_win = (const float*)args.in[4]; F.state = (const float*)args.in[5]; F.ptab = (const int*)args.in[6]; F.c_p = (const float*)args.in[7]; \
    F.c_s = (const float*)args.in[8]; F.norm_w = (const float*)args.in[9]; F.w_ada = (const float*)args.in[10]; F.b_ada = (const float*)args.in[11]; \
    F.w_in = (const float*)args.in[12]; F.cmp_pos = (const float*)args.in[13]; F.cmp_w1 = (const float*)args.in[14]; F.cmp_b1 = (const float*)args.in[15]; \
    F.cmp_w2 = (const float*)args.in[16]; F.cmp_b2 = (const float*)args.in[17]; F.w_a2 = (const float*)args.in[18]; F.b_a = (const float*)args.in[19]; \
    F.gnw = (const float*)args.in[20]; F.w_on = (const float*)args.in[21]; F.w_og = (const float*)args.in[22]; F.w_out = (const float*)args.in[23]; \
    F.fnw = (const float*)args.in[24]; } while (0)
    LOAD_INPUTS();
    for (int u = F.tid; u < (LDS_BYTES - LDSCTL_OFF) / 4; u += NWAVES * 64) ((LAS unsigned*)(F.lds + LDSCTL_OFF))[u] = 0u;
    __syncthreads();
    const int lo = args.ph_lo, hi = args.ph_hi;
    const bool use_bar = (hi - lo) > 1;
    XcdBarrier bar; bar.bar = (unsigned*)(F.ctl + CW_BAR); bar.x = 0; bar.st = nullptr;
    if (use_bar) bar = xcd_barrier_post((unsigned*)(F.ctl + CW_BAR), F.MISC + 8);
#ifndef PH_MASK
#define PH_MASK 0x1ff
#endif
#define IN(k) (((PH_MASK >> (k)) & 1) && lo <= (k) && (k) < hi)
#define SEAM(k) do { if (IN(k) && IN((k) + 1)) xcd_barrier(bar); } while (0)
    LAS unsigned char* ring = F.lds;

#ifndef DBL_MASK
#define DBL_MASK 0
#endif
#ifndef PRE_ITEMS
#define PRE_ITEMS 0
#endif
#ifndef P5_MASK
#define P5_MASK 7
#endif
#ifndef P5_DBL
#define P5_DBL 0
#endif
#define QUEUE_LOOP(word, N, BODY) for (;;) { if (F.tid == 0) F.MISC[0] = __hip_atomic_fetch_add((unsigned*)(F.ctl + (word) + 16384 * args.rpt), 1u, RLX_AGENT); __syncthreads(); \
            const int idx = (int)F.MISC[0]; __syncthreads(); if (idx >= (N)) break; BODY; }
#define PHASE0(rep) { p0_prologue(F, (rep) | args.rpt); }
#define PHASE1(rep) { p1_modnorm(F); }
#define PHASE2(rep) { const int GG = F.G; \
          \
        if (((int)blockIdx.x >> 3) & 1) { for (int pre = 0; pre < PRE_ITEMS; ++pre) { if (F.tid == 0) F.MISC[0] = __hip_atomic_fetch_add((unsigned*)(F.ctl + CW_Q5 + 3072 + 64 * (rep) + 16384 * args.rpt), 1u, RLX_AGENT); __syncthreads(); \
            const int idx = (int)F.MISC[0]; __syncthreads(); if (idx < D_TOTAL) p2_deferred_item(F, idx); } __syncthreads(); } \
        if ((int)blockIdx.x < GG) { pg8::Gemm g{WSP(const bf16, WS_H), WSP(const bf16, WS_WIN), MROWS, NINP, DM}; pg8::StaticOrder S; S.init(MROWS, NINP, GG, (int)blockIdx.x); \
            EpiIn E{F.out, F.ws}; pg8::gemm_phase<EpiIn, pg8::StaticOrder, true, true>(ring, g, S, E); __syncthreads(); } \
        QUEUE_LOOP(CW_Q5 + 3072 + 64 * (rep), D_TOTAL, p2_deferred_item(F, idx)) }
#define PHASE3X(XX) { SEpiPlain SE{WSP(bf16, WS_PART) + (size_t)(XX) * CROWS * 256, 256}; \
          wave_gemm_tiles<SEpiPlain>(F, WSP(const bf16, WS_CB) + (size_t)(XX) * CB_X, 1024, WSP(const bf16, WS_W1T) + (size_t)(XX) * 256 * 1024, 1024, 65536, 64, 8, 1024, SE); }
#define PHASE3(rep) { PHASE3X(0) PHASE3X(1) \
        QUEUE_LOOP(CW_Q5 + 2048 + 512 * (rep), 128, gla_sample_unit(F, idx >> 2, idx & 3)) \
        QUEUE_LOOP(CW_Q5 + 2048 + 64 + 512 * (rep), 512, gla_pass1_unit(F, idx >> 2, idx & 3)) }
#define PHASE4(rep) { compress_l2(F); gla_pass2(F); }
#define PHASE5(rep) { \
        if (P5_MASK & 1) { QUEUE_LOOP(CW_Q5 + 512 * (rep), 128, nsa_sample_unit(F, idx >> 2, idx & 3)) if (P5_DBL & 1) { QUEUE_LOOP(CW_Q5 + 1024, 128, nsa_sample_unit(F, idx >> 2, idx & 3)) } } \
        if (P5_MASK & 2) { QUEUE_LOOP(CW_Q5 + 64 + 512 * (rep), 512, nsa_prompt_unit(F, 127 - (idx >> 2), idx & 3)) if (P5_DBL & 2) { QUEUE_LOOP(CW_Q5 + 1024 + 64, 512, nsa_prompt_unit(F, 127 - (idx >> 2), idx & 3)) } } \
        if (P5_MASK & 4) { QUEUE_LOOP(CW_Q5 + 128 + 512 * (rep), 512, gla_pass3_unit(F, idx >> 2, idx & 3)) if (P5_DBL & 4) { QUEUE_LOOP(CW_Q5 + 1024 + 128, 512, gla_pass3_unit(F, idx >> 2, idx & 3)) } } }
#define PHASE6(rep) { { SEpiMergeCat SE{WSP(const bf16, WS_MN), WSP(const bf16, WS_MG), WSP(bf16, WS_MERGED)}; wave_gemm_tiles<SEpiMergeCat>(F, WSP(const bf16, WS_OCAT), 2048, WSP(const bf16, WS_WCAT), 2048, TP, 8, 64, 2048, SE); } \
        pg8::Gemm g{WSP(const bf16, WS_OCAT), WSP(const bf16, WS_WCAT), TP, DM, 1024, 2048, 1024}; pg8::StaticOrderZ2 S; S.init(TP, DM, F.G, (int)blockIdx.x); \
        EpiMergeZ E{WSP(const bf16, WS_MN), WSP(const bf16, WS_MG), WSP(bf16, WS_MERGED)}; pg8::gemm_phase<EpiMergeZ, pg8::StaticOrderZ2, true, true>(ring, g, S, E); }
#define PHASE7(rep) { { SEpiOut SE{F.x_s, WSP(const long long, WS_MOD), F.out, WSP(float, WS_RSS)}; wave_gemm_tiles<SEpiOut>(F, WSP(const bf16, WS_MERGED), 2048, WSP(const bf16, WS_WOUT), 2048, TP, 8, 64, 2048, SE); } \
        pg8::Gemm g{WSP(const bf16, WS_MERGED), WSP(const bf16, WS_WOUT), TP, DM, DM}; pg8::StaticOrder S; S.init(TP, DM, F.G, (int)blockIdx.x); \
        EpiOut E{F.x_p, F.x_s, WSP(const long long, WS_MOD), F.out, WSP(float, WS_RSS)}; pg8::gemm_phase<EpiOut, pg8::StaticOrder, true, true>(ring, g, S, E); }
#define PHASE8(rep) { final_norm(F); }
#define RUN(k) do { if (IN(k)) { LOAD_INPUTS(); PHASE##k(0) if ((DBL_MASK >> (k)) & 1) { if (use_bar) xcd_barrier(bar); PHASE##k(1) } } SEAM(k); } while (0)
    RUN(0); RUN(1); RUN(2); RUN(3); RUN(4); RUN(5); RUN(6); RUN(7);
    if (IN(8)) { LOAD_INPUTS(); PHASE8(0) }
#ifdef SELF_CHECK
    if (use_bar) { if (SELF_CHECK == 1) self_check_kc(F); else self_check_nsa(F); xcd_barrier(bar); if (blockIdx.x == 0 && F.tid == 0 && __hip_atomic_load((unsigned*)(F.ctl + CW_Q5 + 4096), RLX_AGENT) > (SELF_CHECK == 1 ? 0u : SELF_TOL)) F.out[O_YS] = __builtin_nanf(""); }
#endif
#undef IN
#undef SEAM
}

extern "C" void kernel_launch(void* const* d_in, const int* in_sizes, int n_in, void* d_out, int out_size, void* d_ws, size_t ws_size, hipStream_t stream) {
    static int grid = 0;
    if (grid == 0) {
        if (n_in != 25 || (size_t)out_size != O_TOTAL || ws_size < WS_END) {
            fprintf(stderr, "kernel_launch: built for 25 inputs, %zu outputs, >= %zu bytes of workspace; got n_in %d, out %d, ws %zu; nothing launched\n", (size_t)O_TOTAL, (size_t)WS_END, n_in, out_size, ws_size); grid = -1; return; }
        int dev = 0, cus = 0, per_cu = 0;
        if (hipGetDevice(&dev) != hipSuccess || hipDeviceGetAttribute(&cus, hipDeviceAttributeMultiprocessorCount, dev) != hipSuccess) { fprintf(stderr, "kernel_launch: device query failed\n"); grid = -1; return; }
        if (hipFuncSetAttribute((const void*)nsa_gla_fwd, hipFuncAttributeMaxDynamicSharedMemorySize, LDS_BYTES) != hipSuccess) { fprintf(stderr, "kernel_launch: hipFuncSetAttribute failed\n"); grid = -1; return; }
        if (hipOccupancyMaxActiveBlocksPerMultiprocessor(&per_cu, (const void*)nsa_gla_fwd, NWAVES * 64, LDS_BYTES) != hipSuccess || per_cu < 1)
            fprintf(stderr, "kernel_launch: note: occupancy query reports %d workgroups per CU\n", per_cu);
        (void)hipGetLastError();
        grid = cus;
    }
    if (grid < 0) return;
    if (hipMemsetAsync((char*)d_ws + WS_CTL, 0, CTL_ZERO_BYTES, stream) != hipSuccess || hipMemsetAsync((char*)d_ws + WS_MOD, 0, MOD_BYTES, stream) != hipSuccess) { fprintf(stderr, "kernel_launch: memset failed\n"); return; }
    Args a{};
    for (int i = 0; i < 25; ++i) a.in[i] = d_in[i];
    a.out = (float*)d_out; a.ws = (unsigned char*)d_ws;
#ifndef DBL_LAUNCH
#define DBL_LAUNCH 0
#endif
    int seq[2 * NPH + 4], rp[2 * NPH + 4], ns = 0;
    if (N_LAUNCHES == 1) { seq[ns] = -1; rp[ns++] = 0; }
    else for (int k = 0; k < NPH; ++k) {
        seq[ns] = k; rp[ns++] = 0;
        if ((DBL_LAUNCH >> k) & 1) { if (k == 8) { seq[ns] = k - 1; rp[ns++] = 1; } seq[ns] = k; rp[ns++] = 1; }
    }
    for (int li = 0; li < ns; ++li) {
        if (seq[li] < 0) { a.ph_lo = 0; a.ph_hi = NPH; } else { a.ph_lo = seq[li]; a.ph_hi = seq[li] + 1; }
        a.rpt = rp[li]; a.pad = 0;
        hipLaunchKernelGGL(nsa_gla_fwd, dim3(grid), dim3(NWAVES * 64), LDS_BYTES, stream, a);
        const hipError_t le = hipPeekAtLastError();
        if (le != hipSuccess) { fprintf(stderr, "kernel_launch: launch %d failed: %s\n", li, hipGetErrorName(le)); break; }
    }
}
```
